# Optimizing an MI355X kernel written in HIP

```python
import jax, jax.numpy as jnp
from jax import lax
import numpy as np

D_MODEL = 2048
BATCH = 2
SEQ = 4096
DEPTH = 2

N_META = 16
D_ATTN = D_MODEL // 2
N_HEADS_SB = 16
HEAD_DIM_SB = D_ATTN // N_HEADS_SB
D_POOL = D_MODEL // 4
POOL_WINDOWS = (2, 4, 8, 16)
N_POOL_GROUPS = len(POOL_WINDOWS)
POOL_GROUP_DIM = D_POOL // N_POOL_GROUPS
D_CONV = D_MODEL // 4
CONV_WIDTH = 31
D_MIX = D_ATTN + D_POOL + D_CONV
D_IN_PROJ = 3 * D_ATTN + D_POOL + 2 * D_CONV
D_FF = ((8 * D_MODEL + 3 * 256 - 1) // (3 * 256)) * 256
BLOCK_Q = 128
EPS = 1e-6

kernel_name = "hybrid_stickbreak_pool_conformer_trunk"


def rmsnorm(x, g):
    xf = x.astype(jnp.float32)
    y = xf * lax.rsqrt(jnp.mean(xf * xf, axis=-1, keepdims=True) + EPS)
    return (y * g.astype(jnp.float32)).astype(x.dtype)


def layernorm(x, g, b):
    xf = x.astype(jnp.float32)
    mu = jnp.mean(xf, axis=-1, keepdims=True)
    var = jnp.mean(jnp.square(xf - mu), axis=-1, keepdims=True)
    y = (xf - mu) * lax.rsqrt(var + EPS)
    return (y * g.astype(jnp.float32) + b.astype(jnp.float32)).astype(x.dtype)


def stick_breaking_attention(q, k, v):
    b, l, h, dh = q.shape
    pad = (-l) % BLOCK_Q
    padw = ((0, 0), (pad, 0), (0, 0), (0, 0))
    qf = jnp.pad(q.astype(jnp.float32) * (dh ** -0.5), padw)
    kf = jnp.pad(k.astype(jnp.float32), padw)
    vf = jnp.pad(v.astype(jnp.float32), padw)
    lp = l + pad
    n_blocks = lp // BLOCK_Q
    key_pos = jnp.arange(lp) - pad

    def one_block(i):
        q_blk = lax.dynamic_slice_in_dim(qf, i * BLOCK_Q, BLOCK_Q, axis=1)
        q_pos = i * BLOCK_Q + jnp.arange(BLOCK_Q) - pad
        z = jnp.einsum('bqhd,bkhd->bhqk', q_blk, kf)
        mask = (key_pos[None, :] < q_pos[:, None]) & (key_pos[None, :] >= 0)
        log_not_beta = jnp.where(mask, -jax.nn.softplus(z), 0.0)
        later = lax.cumsum(log_not_beta, axis=3, reverse=True) - log_not_beta
        weights = jnp.where(mask, jnp.exp(jax.nn.log_sigmoid(z) + later), 0.0)
        return jnp.einsum('bhqk,bkhd->bqhd', weights, vf)

    out = lax.map(one_block, jnp.arange(n_blocks))
    out = jnp.moveaxis(out, 0, 1).reshape(b, lp, h, dh)[:, pad:]
    return out.astype(v.dtype)


def multiscale_pool(u, w_pool, pool_scale):
    b, l, _ = u.shape
    uf = u.astype(jnp.float32)
    cs = jnp.pad(jnp.cumsum(uf, axis=1), ((0, 0), (1, 0), (0, 0)))
    t = jnp.arange(l)
    groups = []
    for g, w in enumerate(POOL_WINDOWS):
        lo, hi = g * POOL_GROUP_DIM, (g + 1) * POOL_GROUP_DIM
        start = jnp.maximum(t + 1 - w, 0)
        csg = cs[:, :, lo:hi]
        window_sum = csg[:, 1:] - csg[:, start]
        count = (t + 1 - start).astype(jnp.float32)[None, :, None]
        groups.append(window_sum / count - uf[:, :, lo:hi])
    pooled = jnp.stack(groups, axis=2)
    mixed = jnp.einsum('blgc,gcd->blgd', pooled, w_pool.astype(jnp.float32))
    mixed = mixed.reshape(b, l, D_POOL) * pool_scale.astype(jnp.float32)
    return mixed.astype(u.dtype)


def conformer_conv(u_glu, w_dw, b_dw, ln_g, ln_b, w_pw):
    a, gate = jnp.split(u_glu, 2, axis=-1)
    u = a * jax.nn.sigmoid(gate)
    y = lax.conv_general_dilated(
        u, w_dw[:, None, :].astype(u.dtype), window_strides=(1,),
        padding=[(CONV_WIDTH - 1, 0)],
        dimension_numbers=('NWC', 'WIO', 'NWC'),
        feature_group_count=D_CONV) + b_dw
    y = layernorm(y, ln_g, ln_b)
    y = jax.nn.silu(y)
    return y @ w_pw


def setup_inputs(seed: int = 0) -> dict:
    key = jax.random.key(seed)
    ks = jax.random.split(key, 20)
    f32 = jnp.float32

    def nrm(k, shape, scale):
        return jax.random.normal(k, shape, f32) * scale

    def gain(k, shape):
        return 1.0 + 0.05 * jax.random.normal(k, shape, f32)

    return {
        "x": nrm(ks[0], (BATCH, SEQ, D_MODEL), 1.0),
        "meta_tokens": nrm(ks[1], (N_META, D_MODEL), 1.0),
        "pre_mix_g": gain(ks[2], (DEPTH, D_MODEL)),
        "w_in": nrm(ks[3], (DEPTH, D_MODEL, D_IN_PROJ), D_MODEL ** -0.5),
        "w_pool": nrm(ks[4], (DEPTH, N_POOL_GROUPS, POOL_GROUP_DIM, POOL_GROUP_DIM), POOL_GROUP_DIM ** -0.5),
        "pool_scale": gain(ks[5], (DEPTH, D_POOL)),
        "w_dw": nrm(ks[6], (DEPTH, CONV_WIDTH, D_CONV), CONV_WIDTH ** -0.5),
        "b_dw": nrm(ks[7], (DEPTH, D_CONV), 0.02),
        "conv_ln_g": gain(ks[8], (DEPTH, D_CONV)),
        "conv_ln_b": nrm(ks[9], (DEPTH, D_CONV), 0.02),
        "w_pw": nrm(ks[10], (DEPTH, D_CONV, D_CONV), D_CONV ** -0.5),
        "mix_out_g": gain(ks[11], (DEPTH, D_MIX)),
        "w_out": nrm(ks[12], (DEPTH, D_MIX, D_MODEL), D_MIX ** -0.5),
        "post_mix_g": gain(ks[13], (DEPTH, D_MODEL)),
        "pre_ffn_g": gain(ks[14], (DEPTH, D_MODEL)),
        "w_gate": nrm(ks[15], (DEPTH, D_MODEL, D_FF), D_MODEL ** -0.5),
        "w_up": nrm(ks[16], (DEPTH, D_MODEL, D_FF), D_MODEL ** -0.5),
        "w_down": nrm(ks[17], (DEPTH, D_FF, D_MODEL), D_FF ** -0.5),
        "post_ffn_g": gain(ks[18], (DEPTH, D_MODEL)),
    }


def reference(x, meta_tokens, pre_mix_g, w_in, w_pool, pool_scale, w_dw, b_dw,
              conv_ln_g, conv_ln_b, w_pw, mix_out_g, w_out, post_mix_g,
              pre_ffn_g, w_gate, w_up, w_down, post_ffn_g):
    b = x.shape[0]
    meta = jnp.broadcast_to(meta_tokens[None].astype(x.dtype), (b, N_META, D_MODEL))
    h = jnp.concatenate([meta, x], axis=1)
    l = h.shape[1]
    splits = [D_ATTN, 2 * D_ATTN, 3 * D_ATTN, 3 * D_ATTN + D_POOL]

    for i in range(DEPTH):
        u = rmsnorm(h, pre_mix_g[i])
        proj = u @ w_in[i]
        q, k, v, u_pool, u_conv = jnp.split(proj, splits, axis=-1)
        heads = (b, l, N_HEADS_SB, HEAD_DIM_SB)
        o_attn = stick_breaking_attention(q.reshape(heads), k.reshape(heads), v.reshape(heads))
        o_attn = o_attn.reshape(b, l, D_ATTN)
        o_pool = multiscale_pool(u_pool, w_pool[i], pool_scale[i])
        o_conv = conformer_conv(u_conv, w_dw[i], b_dw[i], conv_ln_g[i], conv_ln_b[i], w_pw[i])
        g = mix_out_g[i]
        merged = jnp.concatenate([
            rmsnorm(o_attn, g[:D_ATTN]),
            rmsnorm(o_pool, g[D_ATTN:D_ATTN + D_POOL]),
            rmsnorm(o_conv, g[D_ATTN + D_POOL:]),
        ], axis=-1)
        h = h + rmsnorm(merged @ w_out[i], post_mix_g[i])

        u = rmsnorm(h, pre_ffn_g[i])
        ff = (jax.nn.silu(u @ w_gate[i]) * (u @ w_up[i])) @ w_down[i]
        h = h + rmsnorm(ff, post_ffn_g[i])

    return h[:, N_META:]
```

```cpp
#include <hip/hip_runtime.h>
#include <hip/hip_cooperative_groups.h>
#include <cstdio>
#include <cstdint>
namespace cg = cooperative_groups;
namespace pg8 {
#define PG8_LAS __attribute__((address_space(3)))
typedef unsigned short bf16_t;
typedef short bf16x8 __attribute__((ext_vector_type(8)));
typedef float f32x4 __attribute__((ext_vector_type(4)));
typedef unsigned u32x4 __attribute__((ext_vector_type(4)));
constexpr int BM = 256, BK = 64, HALF = 128, HTB = HALF * BK * 2  , STAGE_BYTES = 8 * HTB, NXCD = 8, WGM = 8;

__host__ __device__ __forceinline__ int lds_byte(int r, int c) { const int st = (r >> 4) * 2 + (c >> 5), rr = r & 15, cc = c & 31, ob = rr * 64 + cc * 2; return st * 1024 + (ob ^ (((ob >> 9) & 1) << 5)); }
__host__ __device__ __forceinline__ void stage_rc(int b, int& R, int& C) { const int st = b / 1024, sb = b % 1024, swz = sb ^ (((sb >> 9) & 1) << 5); R = (st >> 1) * 16 + swz / 64; C = (st & 1) * 32 + (swz % 64) / 2; }
__host__ __device__ __forceinline__ int perm32(int rho) { const int n = rho >> 4, i = rho & 15; return 8 * (i >> 2) + 4 * n + (i & 3); }

struct Unit { int pm, pn; };
struct Gemm { const bf16_t* A; const bf16_t* Bt; int M, N, K; };

struct StaticOrder {
    int nM, nN, nwg, G, c;
    __host__ __device__ void init(int M, int N, int G_, int c_) { nM = M / BM; nN = N / BM; nwg = nM * nN; G = G_; c = c_; }
    __host__ __device__ bool next(int i, Unit& u) const {
        const long L = (long)i * G + c; if (L >= nwg) return false;
        int wgid = (int)L; { const int q = nwg / NXCD, r = nwg % NXCD, xcd = wgid % NXCD, off = wgid / NXCD; wgid = (xcd < r ? xcd * (q + 1) : r * (q + 1) + (xcd - r) * q) + off; }
        const int nig = WGM * nN, gid = wgid / nig, fm = gid * WGM, gsz = (nM - fm) < WGM ? (nM - fm) : WGM;
        u.pm = fm + ((wgid % nig) % gsz); u.pn = (wgid % nig) / gsz; return true;
    }
    __device__ __forceinline__ void a_ready(const Unit&) const {}
    __device__ __forceinline__ void done(const Unit&) const {}
};

__device__ __forceinline__ unsigned cvt_pk_bf16(float lo, float hi) { unsigned r; asm volatile("v_cvt_pk_bf16_f32 %0, %1, %2" : "=v"(r) : "v"(lo), "v"(hi)); return r; }
typedef float f32x2 __attribute__((ext_vector_type(2)));
__device__ __forceinline__ f32x2 gelu_pk(f32x2 v) {
    const f32x2 av = __builtin_elementwise_abs(v), d = av * 0.2316418882f + 1.0f;
    f32x2 t; t.x = __builtin_amdgcn_rcpf(d.x); t.y = __builtin_amdgcn_rcpf(d.y);
    f32x2 q = t * 0.5307027145f + (-0.7265760135f); q = q * t + 0.7107068705f; q = q * t + (-0.142248368f); q = q * t + 0.127414796f; q = q * t;
    const f32x2 s = (v * v) * (-0.72134752044f);
    f32x2 e; e.x = __builtin_amdgcn_exp2f(s.x); e.y = __builtin_amdgcn_exp2f(s.y);
    const f32x2 m = v * (q * e), r = v - m;
    f32x2 o; o.x = v.x < 0.f ? m.x : r.x; o.y = v.y < 0.f ? m.y : r.y; return o;
}

template <int ACT  > struct EpiBf16 {
    static constexpr bool PERM = true, AFTER_DRAIN = false; static_assert(ACT == 0 || ACT == 1, "EpiBf16: ACT is 0 (none) or 1 (gelu_pk)");
    bf16_t* O; int ldc; const float* bias; int split_cols; size_t split_stride; float scale0;
    __device__ __forceinline__ void operator()(const f32x4 (&acc)[2][2][4][2], const Unit& u, int wr, int wc, int fr, int fq) const {
        const int row0 = u.pm * BM + wr * 64 + fr; int colt = u.pn * BM; bf16_t* base = O;
        float sc = 1.f; if (split_cols) { const int t = colt / split_cols; base += (size_t)t * split_stride; colt -= t * split_cols; if (t == 0) sc = scale0; }
        const int col0 = colt + wc * 32 + 8 * fq, bcol0 = u.pn * BM + wc * 32 + 8 * fq;
        f32x4 bv[2][2];
#pragma unroll
        for (int bj = 0; bj < 2; ++bj)
#pragma unroll
            for (int n = 0; n < 2; ++n) bv[bj][n] = bias ? *(const f32x4*)(bias + bcol0 + bj * HALF + 4 * n) : (f32x4){0.f, 0.f, 0.f, 0.f};
#pragma unroll
        for (int ai = 0; ai < 2; ++ai)
#pragma unroll
            for (int m = 0; m < 4; ++m) { bf16_t* rowp = base + (size_t)(row0 + ai * HALF + m * 16) * ldc + col0;
#pragma unroll
                for (int bj = 0; bj < 2; ++bj) { f32x4 v0 = acc[ai][bj][m][0] + bv[bj][0], v1 = acc[ai][bj][m][1] + bv[bj][1];
                    if (ACT == 1) { f32x2 a = gelu_pk((f32x2){v0[0], v0[1]}), b = gelu_pk((f32x2){v0[2], v0[3]}), c = gelu_pk((f32x2){v1[0], v1[1]}), d = gelu_pk((f32x2){v1[2], v1[3]});
                        v0 = (f32x4){a.x, a.y, b.x, b.y}; v1 = (f32x4){c.x, c.y, d.x, d.y}; }
                    v0 = v0 * sc; v1 = v1 * sc; u32x4 w; w.x = cvt_pk_bf16(v0[0], v0[1]); w.y = cvt_pk_bf16(v0[2], v0[3]); w.z = cvt_pk_bf16(v1[0], v1[1]); w.w = cvt_pk_bf16(v1[2], v1[3]);
                    *(u32x4*)(rowp + bj * HALF) = w; } }
    }
};
__device__ __forceinline__ unsigned cvtpk_rne(float lo, float hi) { typedef float f32x2_t __attribute__((ext_vector_type(2))); typedef __bf16 bf16x2_t __attribute__((ext_vector_type(2)));
    f32x2_t v = {lo, hi}; bf16x2_t b = __builtin_convertvector(v, bf16x2_t); return __builtin_bit_cast(unsigned, b); }
struct EpiF32 {
    static constexpr bool PERM = false, AFTER_DRAIN = false;
    float* O; int ldc;
    __device__ __forceinline__ void operator()(const f32x4 (&acc)[2][2][4][2], const Unit& u, int wr, int wc, int fr, int fq) const {
        const int row0 = u.pm * BM + wr * 64 + fr, col0 = u.pn * BM + wc * 32 + 4 * fq;
#pragma unroll
        for (int ai = 0; ai < 2; ++ai)
#pragma unroll
            for (int m = 0; m < 4; ++m) { float* rowp = O + (size_t)(row0 + ai * HALF + m * 16) * ldc + col0;
#pragma unroll
                for (int bj = 0; bj < 2; ++bj)
#pragma unroll
                    for (int n = 0; n < 2; ++n) *(f32x4*)(rowp + bj * HALF + n * 16) = acc[ai][bj][m][n]; }
    }
};
struct EpiSwiGLU {
    static constexpr bool PERM = true, AFTER_DRAIN = false;
    bf16_t* O; int ldc;
    __device__ __forceinline__ void operator()(const f32x4 (&acc)[2][2][4][2], const Unit& u, int wr, int wc, int fr, int fq) const {
        typedef unsigned u32x2 __attribute__((ext_vector_type(2)));
        const int row0 = u.pm * BM + wr * 64 + fr, col0 = u.pn * (BM / 2) + wc * 16 + 4 * fq;
#pragma unroll
        for (int ai = 0; ai < 2; ++ai)
#pragma unroll
            for (int m = 0; m < 4; ++m) { bf16_t* rowp = O + (size_t)(row0 + ai * HALF + m * 16) * ldc + col0;
#pragma unroll
                for (int bj = 0; bj < 2; ++bj) { const f32x4 g = acc[ai][bj][m][0], up = acc[ai][bj][m][1]; float a[4];
#pragma unroll
                    for (int e = 0; e < 4; ++e) a[e] = g[e] * __builtin_amdgcn_rcpf(1.0f + __builtin_amdgcn_exp2f(-1.4426950408889634f * g[e])) * up[e];
                    u32x2 w; w.x = cvtpk_rne(a[0], a[1]); w.y = cvtpk_rne(a[2], a[3]); *(u32x2*)(rowp + bj * (HALF / 2)) = w; } }
    }
};

template <class Epi, class Sched, bool ALIGN_EPI = false, bool SP2 = false>
__device__ __forceinline__ void gemm_phase(PG8_LAS unsigned char* lds, const Gemm g, const Sched& S, const Epi& E) {
    int tid_ = threadIdx.x; asm volatile("" : "+v"(tid_));
    const int tid = tid_, wid = __builtin_amdgcn_readfirstlane(tid >> 6), lane = tid & 63, wr = wid >> 2, wc = wid & 3, fr = lane & 15, fq = lane >> 4;
    const int K = g.K, nt = K / BK;
    unsigned voffA[2], voffB[2];
#pragma unroll
    for (int i = 0; i < 2; ++i) { int R, C; stage_rc(tid * 16 + i * 8192, R, C); const int Rb = Epi::PERM ? ((R & ~31) + perm32(R & 31)) : R;
        voffA[i] = (unsigned)(R * K + C) * 2u; voffB[i] = (unsigned)(Rb * K + C) * 2u; }
    const size_t kstep = (size_t)(BK * 2);
    const size_t hstep = (size_t)HALF * K * 2;
    const size_t tstep = 2 * hstep;
    const unsigned ldsw = (unsigned)wid * 1024u;
    const int aoff = lds_byte(wr * 64 + fr, fq * 8), boff = lds_byte(wc * 32 + fr, fq * 8);
#define PG8_SA(b, h) (((b) * 2 + (h)) * HTB)
#define PG8_SB(b, h) ((4 + (b) * 2 + (h)) * HTB)
#define PG8_STAGE(bufoff, gbase, voff) do { _Pragma("unroll") for (int _i = 0; _i < 2; ++_i) \
        __builtin_amdgcn_global_load_lds((const unsigned*)((const char*)(gbase) + (voff)[_i]), (PG8_LAS unsigned*)(lds + (bufoff) + ldsw + _i * 8192), 16, 0, 0); } while (0)
#define PG8_LDA(dst, b, h) do { _Pragma("unroll") for (int m = 0; m < 4; ++m) _Pragma("unroll") for (int k = 0; k < 2; ++k) dst[m][k] = *(const PG8_LAS bf16x8*)(lds + PG8_SA(b, h) + aoff + m * 2048 + k * 1024); } while (0)
#define PG8_LDB(dst, b, h) do { _Pragma("unroll") for (int n = 0; n < 2; ++n) _Pragma("unroll") for (int k = 0; k < 2; ++k) dst[n][k] = *(const PG8_LAS bf16x8*)(lds + PG8_SB(b, h) + boff + n * 2048 + k * 1024); } while (0)
#define PG8_MMA(ai, bj, At, Bt) do { __builtin_amdgcn_s_setprio(1); _Pragma("unroll") for (int m = 0; m < 4; ++m) _Pragma("unroll") for (int n = 0; n < 2; ++n) _Pragma("unroll") for (int k = 0; k < 2; ++k) \
        acc[ai][bj][m][n] = __builtin_amdgcn_mfma_f32_16x16x32_bf16(Bt[n][k], At[m][k], acc[ai][bj][m][n], 0, 0, 0); __builtin_amdgcn_s_setprio(0); } while (0)
#define PG8_WAIT_V(n) asm volatile("s_waitcnt vmcnt(" #n ")" ::: "memory")
#define PG8_WAIT_L(n) asm volatile("s_waitcnt lgkmcnt(" #n ")" ::: "memory")
#define PG8_BAR __builtin_amdgcn_s_barrier()
#define PG8_SCHED __builtin_amdgcn_sched_barrier(0)
    Unit cur, nxt; int ui = 0;
    if (!S.next(0, cur)) return;
    f32x4 acc[2][2][4][2];
#pragma unroll
    for (int a = 0; a < 2; ++a)
#pragma unroll
        for (int b = 0; b < 2; ++b)
#pragma unroll
            for (int m = 0; m < 4; ++m)
#pragma unroll
                for (int n = 0; n < 2; ++n) acc[a][b][m][n] = (f32x4){0.f, 0.f, 0.f, 0.f};
    bf16x8 At[4][2], B0[2][2], B1[2][2];
    const char* cA = (const char*)g.A + (size_t)cur.pm * tstep; const char* cB = (const char*)g.Bt + (size_t)cur.pn * tstep;
    S.a_ready(cur);
    if constexpr (SP2) {
        PG8_STAGE(PG8_SB(0, 0), cB, voffB); PG8_STAGE(PG8_SB(0, 1), cB + hstep, voffB); PG8_STAGE(PG8_SA(0, 0), cA, voffA); PG8_STAGE(PG8_SA(0, 1), cA + hstep, voffA);
        if (wr == 1) PG8_BAR;
        PG8_WAIT_V(2); PG8_BAR;
        PG8_STAGE(PG8_SB(1, 0), cB + kstep, voffB); PG8_STAGE(PG8_SA(1, 0), cA + kstep, voffA); PG8_STAGE(PG8_SB(1, 1), cB + hstep + kstep, voffB);
        PG8_WAIT_V(6); PG8_BAR;
    } else {
        PG8_STAGE(PG8_SB(0, 0), cB, voffB); PG8_STAGE(PG8_SA(0, 0), cA, voffA); PG8_STAGE(PG8_SB(0, 1), cB + hstep, voffB); PG8_STAGE(PG8_SA(0, 1), cA + hstep, voffA);
        if (wr == 1) PG8_BAR;
        PG8_WAIT_V(4); PG8_BAR;
        PG8_STAGE(PG8_SB(1, 0), cB + kstep, voffB); PG8_STAGE(PG8_SA(1, 0), cA + kstep, voffA); PG8_STAGE(PG8_SB(1, 1), cB + hstep + kstep, voffB);
        PG8_WAIT_V(6); PG8_BAR;
    }
    for (;;) {
        const bool has_next = S.next(ui + 1, nxt);
        const char* nA = has_next ? (const char*)g.A + (size_t)nxt.pm * tstep : cA; const char* nB = has_next ? (const char*)g.Bt + (size_t)nxt.pn * tstep : cB;
        for (int t = 0; t < nt; t += 2) {
            const bool last = (t == nt - 2);
            const char* a1 = cA + (size_t)(t + 1) * kstep;
            const char* a2 = last ? nA : cA + (size_t)(t + 2) * kstep; const char* b2 = last ? nB : cB + (size_t)(t + 2) * kstep;
            const char* a3 = a2 + kstep; const char* b3 = b2 + kstep;
            if (last && has_next) S.a_ready(nxt);
            if constexpr (SP2) {
            PG8_LDB(B0, 0, 0); PG8_LDB(B1, 0, 1); PG8_SCHED; PG8_LDA(At, 0, 0); PG8_STAGE(PG8_SA(1, 1), a1 + hstep, voffA);
            PG8_WAIT_V(8); PG8_WAIT_L(0); PG8_BAR; PG8_MMA(0, 0, At, B0); PG8_MMA(0, 1, At, B1); PG8_BAR; PG8_SCHED;
            PG8_LDA(At, 0, 1); PG8_STAGE(PG8_SB(0, 0), b2, voffB); PG8_STAGE(PG8_SB(0, 1), b2 + hstep, voffB); PG8_STAGE(PG8_SA(0, 0), a2, voffA);
            PG8_WAIT_V(8); PG8_WAIT_L(0); PG8_BAR; PG8_MMA(1, 0, At, B0); PG8_MMA(1, 1, At, B1); PG8_BAR; PG8_SCHED;
            PG8_LDB(B0, 1, 0); PG8_LDB(B1, 1, 1); PG8_SCHED; PG8_LDA(At, 1, 0); PG8_STAGE(PG8_SA(0, 1), a2 + hstep, voffA);
            PG8_WAIT_V(8); PG8_WAIT_L(0); PG8_BAR; PG8_MMA(0, 0, At, B0); PG8_MMA(0, 1, At, B1); PG8_BAR; PG8_SCHED;
            PG8_LDA(At, 1, 1); PG8_STAGE(PG8_SB(1, 0), b3, voffB); PG8_STAGE(PG8_SB(1, 1), b3 + hstep, voffB); PG8_STAGE(PG8_SA(1, 0), a3, voffA);
            PG8_WAIT_V(8); PG8_WAIT_L(0); PG8_BAR; PG8_MMA(1, 0, At, B0); PG8_MMA(1, 1, At, B1); PG8_BAR; PG8_SCHED;
            } else {
            PG8_LDB(B0, 0, 0); PG8_SCHED; PG8_LDA(At, 0, 0); PG8_STAGE(PG8_SA(1, 1), a1 + hstep, voffA);
            PG8_WAIT_L(8); PG8_BAR; PG8_WAIT_L(0); PG8_MMA(0, 0, At, B0); PG8_BAR; PG8_SCHED;
            PG8_LDB(B1, 0, 1); PG8_STAGE(PG8_SB(0, 0), b2, voffB);
            PG8_BAR; PG8_WAIT_L(0); PG8_MMA(0, 1, At, B1); PG8_BAR;
            PG8_LDA(At, 0, 1); PG8_STAGE(PG8_SA(0, 0), a2, voffA);
            PG8_BAR; PG8_WAIT_L(0); PG8_MMA(1, 0, At, B0); PG8_BAR; PG8_SCHED;
            PG8_STAGE(PG8_SB(0, 1), b2 + hstep, voffB);
            PG8_WAIT_V(6); PG8_BAR; PG8_MMA(1, 1, At, B1); PG8_BAR;
            PG8_LDB(B0, 1, 0); PG8_SCHED; PG8_LDA(At, 1, 0); PG8_STAGE(PG8_SA(0, 1), a2 + hstep, voffA);
            PG8_WAIT_L(8); PG8_BAR; PG8_WAIT_L(0); PG8_MMA(0, 0, At, B0); PG8_BAR; PG8_SCHED;
            PG8_LDB(B1, 1, 1); PG8_STAGE(PG8_SB(1, 0), b3, voffB);
            PG8_BAR; PG8_WAIT_L(0); PG8_MMA(0, 1, At, B1); PG8_BAR;
            PG8_LDA(At, 1, 1); PG8_STAGE(PG8_SA(1, 0), a3, voffA);
            PG8_BAR; PG8_WAIT_L(0); PG8_MMA(1, 0, At, B0); PG8_BAR; PG8_SCHED;
            PG8_STAGE(PG8_SB(1, 1), b3 + hstep, voffB);
            PG8_WAIT_V(6); PG8_BAR; PG8_MMA(1, 1, At, B1); PG8_BAR;
            }
        }
        if constexpr (ALIGN_EPI) { if (wr == 0) PG8_BAR; }
        if constexpr (!Epi::AFTER_DRAIN) { E(acc, cur, wr, wc, fr, fq); S.done(cur); }
        if (!has_next) break;
#pragma unroll
        for (int a = 0; a < 2; ++a)
#pragma unroll
            for (int b = 0; b < 2; ++b)
#pragma unroll
                for (int m = 0; m < 4; ++m)
#pragma unroll
                    for (int n = 0; n < 2; ++n) acc[a][b][m][n] = (f32x4){0.f, 0.f, 0.f, 0.f};
        cur = nxt; cA = nA; cB = nB; ++ui;
        if constexpr (ALIGN_EPI) { if (wr == 1) PG8_BAR; }
    }
    PG8_WAIT_V(0);
    if constexpr (!ALIGN_EPI) { if (wr == 0) PG8_BAR; }
    PG8_BAR;
    if constexpr (Epi::AFTER_DRAIN) { E.fused(acc, cur, wr, wc, fr, fq, lds, wid, lane); S.done(cur); }
#undef PG8_SA
#undef PG8_SB
#undef PG8_STAGE
#undef PG8_LDA
#undef PG8_LDB
#undef PG8_MMA
#undef PG8_WAIT_V
#undef PG8_WAIT_L
#undef PG8_BAR
#undef PG8_SCHED
}
}

#ifndef PG8_SP2
#define PG8_SP2 true
#endif
#ifndef PG8_ALIGN
#define PG8_ALIGN true
#endif
#ifndef MK_SPLIT
#define MK_SPLIT 0
#endif

constexpr int NB = 2, SEQ = 4096, DM = 2048, NMETA = 16, LSEQ = SEQ + NMETA, DEPTH = 2;
constexpr int MR = NB * SEQ;
constexpr int MV = MR + NMETA;
constexpr int MP = 33 * 256;
constexpr int DIN = 4608, DFF = 5632, DATT = 1024, DPOOL = 512, DCONV = 512, NHEAD = 16;
constexpr int C_K = 1024, C_V = 2048, C_POOL = 3072, C_CA = 3584, C_CG = 4096;
constexpr float EPS = 1e-6f, LOG2E = 1.4426950408889634f, LN2 = 0.6931471805599453f;
constexpr float SB_EXIT = -110.0f;

constexpr size_t MiB = 1u << 20;
constexpr size_t WS_WIN = 0;
constexpr size_t WS_WOUT = WS_WIN + 36 * MiB;
constexpr size_t WS_WGU = WS_WOUT + 16 * MiB;
constexpr size_t WS_WD = WS_WGU + 44 * MiB;
constexpr size_t WS_WSM = WS_WD + 22 * MiB;
constexpr size_t WS_H = WS_WSM + 2 * MiB;
constexpr size_t WS_U = WS_H + 66 * MiB;
constexpr size_t WS_OUT = WS_U + 33 * MiB;
constexpr size_t WS_PROJ = WS_OUT + 66 * MiB;
constexpr size_t WS_MERGED = WS_PROJ + (size_t)MP * DIN * 2;
constexpr size_t WS_ACT = WS_PROJ;
constexpr size_t WS_END = WS_MERGED + 33 * MiB;
static_assert((size_t)MP * DFF * 2 <= WS_END - WS_PROJ, "act overlay");

constexpr int LDS_BYTES = 147456;

#define GAS __attribute__((address_space(1)))
#define LAS __attribute__((address_space(3)))
typedef unsigned short bf16;
typedef unsigned v4u __attribute__((ext_vector_type(4)));
typedef unsigned v2u __attribute__((ext_vector_type(2)));
typedef float f32x4 __attribute__((ext_vector_type(4)));
typedef short bf16x8 __attribute__((ext_vector_type(8)));
typedef short v4i16_t __attribute__((ext_vector_type(4)));
#define LDS_WAIT() asm volatile("s_waitcnt lgkmcnt(0)" ::: "memory")

__device__ __forceinline__ unsigned cvtpk(float lo, float hi) { return pg8::cvtpk_rne(lo, hi); }
__device__ __forceinline__ float bflo(unsigned u) { return __uint_as_float(u << 16); }
__device__ __forceinline__ float bfhi(unsigned u) { return __uint_as_float(u & 0xffff0000u); }
__device__ __forceinline__ float bf2f(bf16 v) { return __uint_as_float((unsigned)v << 16); }
__device__ __forceinline__ float wave_sum(float v) {
#pragma unroll
    for (int o = 1; o < 64; o <<= 1) v += __shfl_xor(v, o);
    return v;
}
__device__ __forceinline__ float sigmoidf_(float x) { return __builtin_amdgcn_rcpf(1.0f + __builtin_amdgcn_exp2f(-LOG2E * x)); }
template <class T> __device__ __forceinline__ T* gptr(T* p) { GAS T* g = (GAS T*)p; asm volatile("" : "+s"(g)); return (T*)g; }
__device__ __forceinline__ int rowidx(int b, int pos) { return pos < NMETA ? MR + pos : b * SEQ + pos - NMETA; }
__device__ __forceinline__ f32x4 mfma16(bf16x8 a, bf16x8 b, f32x4 c) { return __builtin_amdgcn_mfma_f32_16x16x32_bf16(a, b, c, 0, 0, 0); }

struct Args {
    const float *x, *meta, *pre_mix_g, *w_in, *w_pool, *pool_scale, *w_dw, *b_dw, *conv_ln_g, *conv_ln_b, *w_pw, *mix_out_g, *w_out, *post_mix_g, *pre_ffn_g, *w_gate, *w_up, *w_down, *post_ffn_g;
    float* out; unsigned char* ws; int ph_lo, ph_hi;
};

__device__ __forceinline__ void transpose_item(const float* __restrict__ W, int K, int N, bf16* WT, int mode, LAS float* scr, int item, int lane) {
    W = gptr(W); WT = gptr(WT);
    const int nblk = N >> 6, kb = item / nblk, nb = item - kb * nblk, k0 = kb << 6, n0 = nb << 6;
    const int r4 = lane >> 4, c4 = (lane & 15) * 4;
#pragma unroll 4
    for (int i = 0; i < 16; ++i) { const int kk = 4 * i + r4; const f32x4 v = *(const f32x4*)(W + (size_t)(k0 + kk) * N + n0 + c4);
        LAS float* s = scr + kk * 65 + c4; s[0] = v.x; s[1] = v.y; s[2] = v.z; s[3] = v.w; }
    LDS_WAIT();
    const int c = lane & 7;
#pragma unroll
    for (int j = 0; j < 8; ++j) { const int n = (lane >> 3) + 8 * j; const LAS float* s = scr + (8 * c) * 65 + n;
        v4u o; o.x = cvtpk(s[0 * 65], s[1 * 65]); o.y = cvtpk(s[2 * 65], s[3 * 65]); o.z = cvtpk(s[4 * 65], s[5 * 65]); o.w = cvtpk(s[6 * 65], s[7 * 65]);
        const int ng = n0 + n; const int R = mode == 0 ? ng : ((ng >> 2) * 8 + (ng & 3) + (mode == 2 ? 4 : 0));
        *(v4u*)(WT + (size_t)R * K + k0 + 8 * c) = o; }
    LDS_WAIT();
}
#define TJOB(Wp, Kk, Nn, WTp, mode) { const int ni_ = ((Kk) / 64) * ((Nn) / 64); if (r < ni_) { transpose_item((Wp), (Kk), (Nn), (WTp), (mode), scr, r, lane); continue; } r -= ni_; }

__device__ __forceinline__ void convert_ffn_weights(const Args& A, int l, LAS float* scr, int gw, int NGW, int lane) {
    bf16* wgu = (bf16*)(A.ws + WS_WGU); bf16* wd = (bf16*)(A.ws + WS_WD);
    constexpr int NI = 3 * (DM / 64) * (DFF / 64);
    for (int it = gw; it < NI; it += NGW) { int r = it;
        TJOB(A.w_gate + (size_t)l * DM * DFF, DM, DFF, wgu, 1)
        TJOB(A.w_up + (size_t)l * DM * DFF, DM, DFF, wgu, 2)
        TJOB(A.w_down + (size_t)l * DFF * DM, DFF, DM, wd, 0)
    }
}
__device__ __forceinline__ void convert_mix_weights(const Args& A, LAS float* scr, int gw, int NGW, int lane) {
    constexpr int I_IN = (DM / 64) * (DIN / 64), I_OUT = (DM / 64) * (DM / 64), I_PW = 64, I_POOL = 16, NL = I_IN + I_OUT + I_PW + I_POOL;
    for (int it = gw; it < DEPTH * NL; it += NGW) { const int l = it / NL; int r = it - l * NL;
        if (r < I_IN) { transpose_item(A.w_in + (size_t)l * DM * DIN, DM, DIN, (bf16*)(A.ws + WS_WIN) + (size_t)l * DIN * DM, 0, scr, r, lane); continue; } r -= I_IN;
        if (r < I_OUT) { transpose_item(A.w_out + (size_t)l * DM * DM, DM, DM, (bf16*)(A.ws + WS_WOUT) + (size_t)l * DM * DM, 0, scr, r, lane); continue; } r -= I_OUT;
        if (r < I_PW) { transpose_item(A.w_pw + (size_t)l * 512 * 512, 512, 512, (bf16*)(A.ws + WS_WSM + 256 * 1024) + (size_t)l * 512 * 512, 0, scr, r, lane); continue; } r -= I_PW;
        { const int g = r >> 2; transpose_item(A.w_pool + (size_t)(l * 4 + g) * 128 * 128, 128, 128, (bf16*)(A.ws + WS_WSM) + (size_t)(l * 4 + g) * 128 * 128, 0, scr, r & 3, lane); }
    }
}

__device__ __forceinline__ float dot4(f32x4 a) { return (a.x * a.x + a.y * a.y) + (a.z * a.z + a.w * a.w); }
__device__ __forceinline__ void store_u_row(bf16* urow, const f32x4 (&hv)[8], float r, const float* g, int lane) {
#pragma unroll
    for (int j = 0; j < 8; ++j) { const f32x4 gv = ((const f32x4*)g)[lane + 64 * j]; v2u w; w.x = cvtpk(hv[j].x * r * gv.x, hv[j].y * r * gv.y); w.y = cvtpk(hv[j].z * r * gv.z, hv[j].w * r * gv.w);
        ((v2u*)urow)[lane + 64 * j] = w; }
}
__device__ __forceinline__ void init_rows(const Args& A, int gw, int NGW, int lane) {
    unsigned char* wsb = gptr(A.ws); float* h = (float*)(wsb + WS_H); bf16* u = (bf16*)(wsb + WS_U); const float* pg = gptr(A.pre_mix_g);
    for (int m = gw; m < MV; m += NGW) {
        const float* src = m < MR ? gptr(A.x) + (size_t)m * DM : gptr(A.meta) + (size_t)(m - MR) * DM;
        f32x4 hv[8]; float ss = 0.f;
#pragma unroll
        for (int j = 0; j < 8; ++j) { hv[j] = ((const f32x4*)src)[lane + 64 * j]; ss += dot4(hv[j]); ((f32x4*)(h + (size_t)m * DM))[lane + 64 * j] = hv[j]; }
        const float r = rsqrtf(wave_sum(ss) * (1.0f / DM) + EPS);
        store_u_row(u + (size_t)m * DM, hv, r, pg, lane);
    }
}
__device__ __forceinline__ void row_phase(const Args& A, const float* g1, const float* g2, float* dout, int gw, int NGW, int lane) {
    unsigned char* wsb = gptr(A.ws); float* h = (float*)(wsb + WS_H); bf16* u = (bf16*)(wsb + WS_U); const float* src = (const float*)(wsb + WS_OUT); g1 = gptr(g1); g2 = gptr(g2); dout = gptr(dout);
    for (int m = gw; m < MV; m += NGW) {
        f32x4 o[8], hv[8]; float ss = 0.f;
#pragma unroll
        for (int j = 0; j < 8; ++j) { o[j] = ((const f32x4*)(src + (size_t)m * DM))[lane + 64 * j]; hv[j] = ((const f32x4*)(h + (size_t)m * DM))[lane + 64 * j]; ss += dot4(o[j]); }
        const float r = rsqrtf(wave_sum(ss) * (1.0f / DM) + EPS);
        float ss2 = 0.f;
#pragma unroll
        for (int j = 0; j < 8; ++j) { const f32x4 gv = ((const f32x4*)g1)[lane + 64 * j]; hv[j] = hv[j] + o[j] * r * gv; ss2 += dot4(hv[j]); }
        if (dout) {
            if (m < MR) {
#pragma unroll
                for (int j = 0; j < 8; ++j) ((f32x4*)(dout + (size_t)m * DM))[lane + 64 * j] = hv[j];
            }
        } else {
#pragma unroll
            for (int j = 0; j < 8; ++j) ((f32x4*)(h + (size_t)m * DM))[lane + 64 * j] = hv[j];
            const float r2 = rsqrtf(wave_sum(ss2) * (1.0f / DM) + EPS);
            store_u_row(u + (size_t)m * DM, hv, r2, g2, lane);
        }
    }
}

constexpr int VPITCH = 128;
constexpr int ML_V = 0, ML_ST = 8 * 64 * VPITCH  , ML_RED = ML_ST + 65536, ML_Y = 0  , ML_AB = ML_Y + 16 * 516 * 4;
static_assert(ML_RED + 3 * 512 <= LDS_BYTES && ML_AB + 16 * 1040 <= ML_ST, "mixer LDS");

__device__ __forceinline__ float softplus_(float z) { const float t = __builtin_amdgcn_exp2f(-LOG2E * __builtin_fabsf(z)); return __builtin_fmaxf(z, 0.f) + LN2 * __builtin_amdgcn_logf(1.0f + t); }
__device__ __forceinline__ void split_pack(const f32x4& a, const f32x4& b, bf16x8& hi, bf16x8& lo) {
    v4u h, l;
    h.x = cvtpk(a[0], a[1]); h.y = cvtpk(a[2], a[3]); h.z = cvtpk(b[0], b[1]); h.w = cvtpk(b[2], b[3]);
    l.x = cvtpk(a[0] - bflo(h.x), a[1] - bfhi(h.x)); l.y = cvtpk(a[2] - bflo(h.y), a[3] - bfhi(h.y));
    l.z = cvtpk(b[0] - bflo(h.z), b[1] - bfhi(h.z)); l.w = cvtpk(b[2] - bflo(h.w), b[3] - bfhi(h.w));
    hi = __builtin_bit_cast(bf16x8, h); lo = __builtin_bit_cast(bf16x8, l);
}
__device__ __forceinline__ void sb_attention(const bf16* __restrict__ proj, int b, int p0, int hd, LAS unsigned char* vl, int lane, f32x4 (&o)[4]) {
    const int li = lane & 15, fq = lane >> 4;
    const int qpos = p0 + li;
    const bf16* qp = proj + (size_t)rowidx(b, qpos) * DIN + hd * 64 + fq * 8;
    const bf16x8 qf0 = *(const bf16x8*)qp, qf1 = *(const bf16x8*)(qp + 32);
    unsigned d0 = 0u, d1 = 0u;
    { const unsigned one = 0x3F80u; d0 = ((4 * fq + 0 >= li) ? one : 0u) | ((4 * fq + 1 >= li) ? (one << 16) : 0u); d1 = ((4 * fq + 2 >= li) ? one : 0u) | ((4 * fq + 3 >= li) ? (one << 16) : 0u); }
    const unsigned ONE2 = 0x3F803F80u;
    const bf16x8 F_D1 = __builtin_bit_cast(bf16x8, (v4u){d0, d1, ONE2, ONE2});
    const bf16x8 F_11 = __builtin_bit_cast(bf16x8, (v4u){ONE2, ONE2, ONE2, ONE2});
    const bf16x8 F_0D = __builtin_bit_cast(bf16x8, (v4u){0u, 0u, d0, d1});
#pragma unroll
    for (int i = 0; i < 4; ++i) o[i] = (f32x4){0.f, 0.f, 0.f, 0.f};
    float carry = 0.f;
    const int ktd = p0 >> 6;
    const unsigned trbase = (unsigned)((4 * fq + (li >> 2)) * VPITCH + (lane & 3) * 8);
    for (int kt = ktd; kt >= 0; --kt) {
        const bool diag = (kt == ktd);
        bf16x8 kf[4][2];
#pragma unroll
        for (int kb = 0; kb < 4; ++kb) { int kp = 64 * kt + 16 * kb + li; kp = kp < LSEQ ? kp : LSEQ - 1; const bf16* kr = proj + (size_t)rowidx(b, kp) * DIN + C_K + hd * 64 + fq * 8;
            kf[kb][0] = *(const bf16x8*)kr; kf[kb][1] = *(const bf16x8*)(kr + 32); }
#pragma unroll
        for (int it = 0; it < 8; ++it) { const int key = it * 8 + (lane >> 3); int kp = 64 * kt + key; kp = kp < LSEQ ? kp : LSEQ - 1;
            __builtin_amdgcn_global_load_lds((const unsigned*)(proj + (size_t)rowidx(b, kp) * DIN + C_V + hd * 64 + (lane & 7) * 8), (LAS unsigned*)(vl + it * 1024), 16, 0, 0); }
        f32x4 s[4], lnb[4];
#pragma unroll
        for (int kb = 0; kb < 4; ++kb) { s[kb] = mfma16(kf[kb][0], qf0, (f32x4){0.f, 0.f, 0.f, 0.f}); s[kb] = mfma16(kf[kb][1], qf1, s[kb]); }
#pragma unroll
        for (int kb = 0; kb < 4; ++kb)
#pragma unroll
            for (int e = 0; e < 4; ++e) { const bool m = !diag || (64 * kt + 16 * kb + 4 * fq + e < qpos); lnb[kb][e] = m ? -softplus_(s[kb][e]) : 0.f; }
        bf16x8 bh[2], bl[2];
        split_pack(lnb[0], lnb[1], bh[0], bl[0]); split_pack(lnb[2], lnb[3], bh[1], bl[1]);
        f32x4 c[4];
#pragma unroll
        for (int i = 0; i < 4; ++i) c[i] = (f32x4){carry, carry, carry, carry};
        c[0] = mfma16(F_D1, bh[0], c[0]); c[0] = mfma16(F_D1, bl[0], c[0]); c[0] = mfma16(F_11, bh[1], c[0]); c[0] = mfma16(F_11, bl[1], c[0]);
        c[1] = mfma16(F_0D, bh[0], c[1]); c[1] = mfma16(F_0D, bl[0], c[1]); c[1] = mfma16(F_11, bh[1], c[1]); c[1] = mfma16(F_11, bl[1], c[1]);
        c[2] = mfma16(F_D1, bh[1], c[2]); c[2] = mfma16(F_D1, bl[1], c[2]);
        c[3] = mfma16(F_0D, bh[1], c[3]); c[3] = mfma16(F_0D, bl[1], c[3]);
        f32x4 w[4];
#pragma unroll
        for (int kb = 0; kb < 4; ++kb)
#pragma unroll
            for (int e = 0; e < 4; ++e) { const bool m = !diag || (64 * kt + 16 * kb + 4 * fq + e < qpos); w[kb][e] = m ? __builtin_amdgcn_exp2f(LOG2E * (s[kb][e] + c[kb][e])) : 0.f; }
        carry = __shfl(c[0][0], li);
        v4u p0v, p1v;
        p0v.x = cvtpk(w[0][0], w[0][1]); p0v.y = cvtpk(w[0][2], w[0][3]); p0v.z = cvtpk(w[1][0], w[1][1]); p0v.w = cvtpk(w[1][2], w[1][3]);
        p1v.x = cvtpk(w[2][0], w[2][1]); p1v.y = cvtpk(w[2][2], w[2][3]); p1v.z = cvtpk(w[3][0], w[3][1]); p1v.w = cvtpk(w[3][2], w[3][3]);
        const bf16x8 pf0 = __builtin_bit_cast(bf16x8, p0v), pf1 = __builtin_bit_cast(bf16x8, p1v);
        asm volatile("s_waitcnt vmcnt(0)" ::: "memory");
#pragma unroll
        for (int db = 0; db < 4; ++db) {
#pragma unroll
            for (int s2 = 0; s2 < 2; ++s2) {
                const v4i16_t lo = __builtin_amdgcn_ds_read_tr16_b64_v4i16((LAS v4i16_t*)(vl + trbase + (32 * s2) * VPITCH + db * 32));
                const v4i16_t hi = __builtin_amdgcn_ds_read_tr16_b64_v4i16((LAS v4i16_t*)(vl + trbase + (32 * s2 + 16) * VPITCH + db * 32));
                const bf16x8 vf = (bf16x8){lo[0], lo[1], lo[2], lo[3], hi[0], hi[1], hi[2], hi[3]};
                o[db] = mfma16(vf, s2 == 0 ? pf0 : pf1, o[db]);
            }
        }
        if (__all(carry < SB_EXIT)) break;
    }
}

__device__ __forceinline__ void mixer_phase(const Args& A, int l, LAS unsigned char* lds, int tid, int lane, int wave) {
    unsigned char* wsb = gptr(A.ws);
    const bf16* proj = (const bf16*)(wsb + WS_PROJ); bf16* merged = (bf16*)(wsb + WS_MERGED);
    const bf16* wpool_t = (const bf16*)(wsb + WS_WSM) + (size_t)l * 4 * 128 * 128;
    const bf16* wpw_t = (const bf16*)(wsb + WS_WSM + 256 * 1024) + (size_t)l * 512 * 512;
    const float* wdw = gptr(A.w_dw) + (size_t)l * 31 * 512; const float* bdw = gptr(A.b_dw) + l * 512; const float* lng = gptr(A.conv_ln_g) + l * 512; const float* lnb_ = gptr(A.conv_ln_b) + l * 512;
    const float* psc = gptr(A.pool_scale) + l * 512; const float* mg = gptr(A.mix_out_g) + (size_t)l * DM;
    const int li = lane & 15, fq = lane >> 4;
    LAS float* Y = (LAS float*)(lds + ML_Y); LAS unsigned short* Ab = (LAS unsigned short*)(lds + ML_AB); LAS float* red = (LAS float*)(lds + ML_RED);
    LAS unsigned char* vl = lds + ML_V + wave * (64 * VPITCH); LAS unsigned char* st = lds + ML_ST + wave * 8192;
    for (int ti = blockIdx.x; ti < 513; ti += gridDim.x) {
        int b, p0; if (ti < 512) { b = ti >> 8; p0 = 16 + 16 * (ti & 255); } else { b = 0; p0 = 0; }
#pragma unroll 1
        for (int hh = 0; hh < 2; ++hh) { f32x4 o0[4];
            sb_attention(proj, b, p0, 2 * wave + hh, vl, lane, o0);
#pragma unroll
            for (int db = 0; db < 4; ++db) *(LAS f32x4*)(st + ((hh * 4 + db) * 64 + lane) * 16) = o0[db]; }
        __syncthreads();
        {
            const int c = tid; const bf16* pa = proj + C_CA + c;
            float glu[46];
#pragma unroll
            for (int r = 0; r < 46; ++r) { const int pos = p0 - 30 + r; float gv = 0.f;
                if (pos >= 0) { const size_t row = (size_t)rowidx(b, pos); const float a = bf2f(pa[row * DIN]); const float gt = bf2f(pa[row * DIN + 512]); gv = a * sigmoidf_(gt); }
                glu[r] = gv;
                if ((r & 15) == 15) __builtin_amdgcn_sched_barrier(0); }
            float y[16]; const float bias = bdw[c];
#pragma unroll
            for (int t = 0; t < 16; ++t) y[t] = bias;
#pragma unroll
            for (int j = 0; j < 31; ++j) { const float w = wdw[j * 512 + c];
#pragma unroll
                for (int t = 0; t < 16; ++t) y[t] += w * glu[t + j]; }
#pragma unroll
            for (int t = 0; t < 16; ++t) Y[t * 516 + c] = y[t];
        }
        __syncthreads();
#pragma unroll
        for (int tt = 0; tt < 2; ++tt) { const int t = 2 * wave + tt; float v[8]; float sm = 0.f;
#pragma unroll
            for (int i = 0; i < 8; ++i) { v[i] = Y[t * 516 + lane + 64 * i]; sm += v[i]; }
            const float mean = wave_sum(sm) * (1.0f / 512.0f); float q = 0.f;
#pragma unroll
            for (int i = 0; i < 8; ++i) { v[i] -= mean; q += v[i] * v[i]; }
            const float rstd = rsqrtf(wave_sum(q) * (1.0f / 512.0f) + EPS);
#pragma unroll
            for (int i = 0; i < 8; ++i) { const int c = lane + 64 * i; const float yn = v[i] * rstd * lng[c] + lnb_[c]; const float a = yn * sigmoidf_(yn); Ab[t * 520 + c] = (unsigned short)(cvtpk(a, 0.f) & 0xffffu); }
        }
        __syncthreads();
        f32x4 cacc[4];
#pragma unroll
        for (int i = 0; i < 4; ++i) cacc[i] = (f32x4){0.f, 0.f, 0.f, 0.f};
        { const bf16* wp = wpw_t + (size_t)(64 * wave + li) * 512 + 8 * fq; const LAS unsigned char* ab = (const LAS unsigned char*)Ab + li * 1040 + fq * 16;
#pragma unroll 4
            for (int ks = 0; ks < 16; ++ks) { const bf16x8 bfr = *(const LAS bf16x8*)(ab + ks * 64);
#pragma unroll
                for (int nb = 0; nb < 4; ++nb) { const bf16x8 wf = *(const bf16x8*)(wp + (size_t)nb * 16 * 512 + ks * 32); cacc[nb] = mfma16(wf, bfr, cacc[nb]); } } }
        f32x4 pacc[4];
#pragma unroll
        for (int i = 0; i < 4; ++i) pacc[i] = (f32x4){0.f, 0.f, 0.f, 0.f};
        { const int g = wave >> 1, nh = wave & 1, W = 2 << g; const int pos = p0 + li; const int cnt = (pos + 1 < W) ? pos + 1 : W; const float inv = 1.0f / (float)cnt;
            for (int ks = 0; ks < 4; ++ks) { const bf16* src = proj + C_POOL + 128 * g + 32 * ks + 8 * fq;
                float sum[8], self[8];
                { const v4u v = *(const v4u*)(src + (size_t)rowidx(b, pos) * DIN); self[0] = bflo(v.x); self[1] = bfhi(v.x); self[2] = bflo(v.y); self[3] = bfhi(v.y); self[4] = bflo(v.z); self[5] = bfhi(v.z); self[6] = bflo(v.w); self[7] = bfhi(v.w); }
#pragma unroll
                for (int e = 0; e < 8; ++e) sum[e] = self[e];
                for (int j = 1; j < W; ++j) { const int pp = pos - j;
                    if (pp >= 0) { const v4u v = *(const v4u*)(src + (size_t)rowidx(b, pp) * DIN);
                        sum[0] += bflo(v.x); sum[1] += bfhi(v.x); sum[2] += bflo(v.y); sum[3] += bfhi(v.y); sum[4] += bflo(v.z); sum[5] += bfhi(v.z); sum[6] += bflo(v.w); sum[7] += bfhi(v.w); } }
                v4u pk; pk.x = cvtpk(sum[0] * inv - self[0], sum[1] * inv - self[1]); pk.y = cvtpk(sum[2] * inv - self[2], sum[3] * inv - self[3]);
                pk.z = cvtpk(sum[4] * inv - self[4], sum[5] * inv - self[5]); pk.w = cvtpk(sum[6] * inv - self[6], sum[7] * inv - self[7]);
                const bf16x8 pf = __builtin_bit_cast(bf16x8, pk);
#pragma unroll
                for (int nb = 0; nb < 4; ++nb) { const bf16x8 wf = *(const bf16x8*)(wpool_t + (size_t)(g * 128 + 64 * nh + 16 * nb + li) * 128 + 32 * ks + 8 * fq); pacc[nb] = mfma16(wf, pf, pacc[nb]); } } }
        f32x4 oa[2][4];
#pragma unroll
        for (int hh = 0; hh < 2; ++hh)
#pragma unroll
            for (int db = 0; db < 4; ++db) oa[hh][db] = *(const LAS f32x4*)(st + ((hh * 4 + db) * 64 + lane) * 16);
        float ssa = 0.f, ssp = 0.f, ssc = 0.f;
        { const int g = wave >> 1, nh = wave & 1;
#pragma unroll
            for (int nb = 0; nb < 4; ++nb) { const f32x4 sc = *(const f32x4*)(psc + 128 * g + 64 * nh + 16 * nb + 4 * fq); pacc[nb] = pacc[nb] * sc; ssp += dot4(pacc[nb]); ssc += dot4(cacc[nb]); ssa += dot4(oa[0][nb]) + dot4(oa[1][nb]); } }
        ssa += __shfl_xor(ssa, 16); ssa += __shfl_xor(ssa, 32); ssp += __shfl_xor(ssp, 16); ssp += __shfl_xor(ssp, 32); ssc += __shfl_xor(ssc, 16); ssc += __shfl_xor(ssc, 32);
        if (lane < 16) { red[wave * 16 + lane] = ssa; red[128 + wave * 16 + lane] = ssp; red[256 + wave * 16 + lane] = ssc; }
        __syncthreads();
        float ta = 0.f, tp = 0.f, tc = 0.f;
#pragma unroll
        for (int w8 = 0; w8 < 8; ++w8) { ta += red[w8 * 16 + li]; tp += red[128 + w8 * 16 + li]; tc += red[256 + w8 * 16 + li]; }
        const float ra = rsqrtf(ta * (1.0f / DATT) + EPS), rp = rsqrtf(tp * (1.0f / DPOOL) + EPS), rc = rsqrtf(tc * (1.0f / DCONV) + EPS);
        bf16* orow = merged + (size_t)rowidx(b, p0 + li) * DM;
#pragma unroll
        for (int hh = 0; hh < 2; ++hh)
#pragma unroll
            for (int db = 0; db < 4; ++db) { const int col = (2 * wave + hh) * 64 + 16 * db + 4 * fq; const f32x4 gv = *(const f32x4*)(mg + col); const f32x4 v = oa[hh][db] * ra * gv;
                v2u w2; w2.x = cvtpk(v.x, v.y); w2.y = cvtpk(v.z, v.w); *(v2u*)(orow + col) = w2; }
        { const int g = wave >> 1, nh = wave & 1;
#pragma unroll
            for (int nb = 0; nb < 4; ++nb) { const int col = DATT + 128 * g + 64 * nh + 16 * nb + 4 * fq; const f32x4 gv = *(const f32x4*)(mg + col); const f32x4 v = pacc[nb] * rp * gv;
                v2u w2; w2.x = cvtpk(v.x, v.y); w2.y = cvtpk(v.z, v.w); *(v2u*)(orow + col) = w2; } }
#pragma unroll
        for (int nb = 0; nb < 4; ++nb) { const int col = DATT + DPOOL + 64 * wave + 16 * nb + 4 * fq; const f32x4 gv = *(const f32x4*)(mg + col); const f32x4 v = cacc[nb] * rc * gv;
            v2u w2; w2.x = cvtpk(v.x, v.y); w2.y = cvtpk(v.z, v.w); *(v2u*)(orow + col) = w2; }
        __syncthreads();
    }
}

constexpr int NPHASE = 1 + 7 * DEPTH;
#define PHASE_ENTER() int tid_ = threadIdx.x; asm volatile("" : "+v"(tid_)); const int tid = tid_, lane = tid & 63, wave = __builtin_amdgcn_readfirstlane(tid >> 6); \
    const __attribute__((address_space(4))) Args* ka_ = (const __attribute__((address_space(4))) Args*)__builtin_amdgcn_kernarg_segment_ptr(); asm volatile("" : "+s"(ka_)); Args A; __builtin_memcpy(&A, ka_, sizeof(Args)); \
    const int G = gridDim.x, gw = blockIdx.x * 8 + wave, NGW = G * 8; LAS float* scr = (LAS float*)(lds + wave * 16640); (void)tid; (void)lane; (void)gw; (void)NGW; (void)scr; (void)G;
__global__ void __launch_bounds__(512, 2) fwd_megakernel(Args args) {
    extern __shared__ __attribute__((aligned(16))) unsigned char lds_raw[];
    LAS unsigned char* lds = (LAS unsigned char*)lds_raw;
    cg::grid_group grid = cg::this_grid();
    const int lo = args.ph_lo, hi = args.ph_hi;
#define IN(k) (lo <= (k) && (k) < hi)
#define SEAM(k) do { if (IN(k) && IN((k) + 1)) grid.sync(); } while (0)
    int k = 0;
    if (IN(k)) { PHASE_ENTER(); convert_mix_weights(A, scr, gw, NGW, lane); convert_ffn_weights(A, 0, scr, gw, NGW, lane); init_rows(A, gw, NGW, lane); }
    SEAM(k); ++k;
    for (int l = 0; l < DEPTH; ++l) {
        if (IN(k)) { PHASE_ENTER(); unsigned char* wsb = gptr(A.ws); pg8::Gemm g{(const bf16*)(wsb + WS_U), (const bf16*)(wsb + WS_WIN) + (size_t)l * DIN * DM, MP, DIN, DM}; pg8::StaticOrder S; S.init(MP, DIN, G, (int)blockIdx.x);
            pg8::EpiBf16<0> E{(bf16*)(wsb + WS_PROJ), DIN, nullptr, 1024, 1024, 0.125f};
            pg8::gemm_phase<pg8::EpiBf16<0>, pg8::StaticOrder, PG8_ALIGN, PG8_SP2>(lds, g, S, E); }
        SEAM(k); ++k;
        if (IN(k)) { PHASE_ENTER(); mixer_phase(A, l, lds, tid, lane, wave); }
        SEAM(k); ++k;
        if (IN(k)) { PHASE_ENTER(); unsigned char* wsb = gptr(A.ws); pg8::Gemm g{(const bf16*)(wsb + WS_MERGED), (const bf16*)(wsb + WS_WOUT) + (size_t)l * DM * DM, MP, DM, DM}; pg8::StaticOrder S; S.init(MP, DM, G, (int)blockIdx.x);
            pg8::EpiF32 E{(float*)(wsb + WS_OUT), DM};
            pg8::gemm_phase<pg8::EpiF32, pg8::StaticOrder, PG8_ALIGN, PG8_SP2>(lds, g, S, E); }
        SEAM(k); ++k;
        if (IN(k)) { PHASE_ENTER(); row_phase(A, A.post_mix_g + (size_t)l * DM, A.pre_ffn_g + (size_t)l * DM, nullptr, gw, NGW, lane); }
        SEAM(k); ++k;
        if (IN(k)) { PHASE_ENTER(); unsigned char* wsb = gptr(A.ws); pg8::Gemm g{(const bf16*)(wsb + WS_U), (const bf16*)(wsb + WS_WGU), MP, 2 * DFF, DM}; pg8::StaticOrder S; S.init(MP, 2 * DFF, G, (int)blockIdx.x);
            pg8::EpiSwiGLU E{(bf16*)(wsb + WS_ACT), DFF};
            pg8::gemm_phase<pg8::EpiSwiGLU, pg8::StaticOrder, PG8_ALIGN, PG8_SP2>(lds, g, S, E); }
        SEAM(k); ++k;
        if (IN(k)) { PHASE_ENTER(); unsigned char* wsb = gptr(A.ws); pg8::Gemm g{(const bf16*)(wsb + WS_ACT), (const bf16*)(wsb + WS_WD), MP, DM, DFF}; pg8::StaticOrder S; S.init(MP, DM, G, (int)blockIdx.x);
            pg8::EpiF32 E{(float*)(wsb + WS_OUT), DM};
            pg8::gemm_phase<pg8::EpiF32, pg8::StaticOrder, PG8_ALIGN, PG8_SP2>(lds, g, S, E); }
        SEAM(k); ++k;
        if (IN(k)) { PHASE_ENTER();
            if (l + 1 < DEPTH) { convert_ffn_weights(A, l + 1, scr, gw, NGW, lane); row_phase(A, A.post_ffn_g + (size_t)l * DM, A.pre_mix_g + (size_t)(l + 1) * DM, nullptr, gw, NGW, lane); }
            else row_phase(A, A.post_ffn_g + (size_t)l * DM, nullptr, A.out, gw, NGW, lane);
        }
        if (l + 1 < DEPTH) { SEAM(k); } ++k;
    }
#undef IN
#undef SEAM
}

extern "C" void kernel_launch(void* const* d_in, const int* in_sizes, int n_in, void* d_out, int out_size, void* d_ws, size_t ws_size, hipStream_t stream) {
    static int grid = 0;
    if (grid == 0) {
        if (n_in != 19 || in_sizes[0] != MR * DM || out_size != MR * DM || ws_size < WS_END) { fprintf(stderr, "kernel_launch: unexpected problem (n_in %d, in0 %d, out %d, ws %zu, need %zu)\n", n_in, n_in > 0 ? in_sizes[0] : -1, out_size, ws_size, (size_t)WS_END); grid = -1; return; }
        int dev = 0, cus = 0, per_cu = 0;
        if (hipGetDevice(&dev) != hipSuccess || hipDeviceGetAttribute(&cus, hipDeviceAttributeMultiprocessorCount, dev) != hipSuccess) { grid = -1; return; }
        if (hipFuncSetAttribute((const void*)fwd_megakernel, hipFuncAttributeMaxDynamicSharedMemorySize, LDS_BYTES) != hipSuccess) { fprintf(stderr, "kernel_launch: hipFuncSetAttribute failed\n"); grid = -1; return; }
        if (hipOccupancyMaxActiveBlocksPerMultiprocessor(&per_cu, (const void*)fwd_megakernel, 512, LDS_BYTES) != hipSuccess || per_cu < 1) { fprintf(stderr, "kernel_launch: occupancy query says %d blocks per CU\n", per_cu); per_cu = 1; }
        (void)hipGetLastError();
        grid = cus;
    }
    if (grid < 0) return;
    Args a{};
    const float** ap = (const float**)&a;
    for (int i = 0; i < 19; ++i) ap[i] = (const float*)d_in[i];
    a.out = (float*)d_out; a.ws = (unsigned char*)d_ws;
#if MK_SPLIT
    for (int ph = 0; ph < NPHASE; ++ph) { a.ph_lo = ph; a.ph_hi = ph + 1; hipLaunchKernelGGL(fwd_megakernel, dim3(grid), dim3(512), LDS_BYTES, stream, a); }
#else
    a.ph_lo = 0; a.ph_hi = NPHASE;
    void* kargs[] = {(void*)&a};
    const hipError_t e = hipLaunchCooperativeKernel((const void*)fwd_megakernel, dim3(grid), dim3(512), kargs, LDS_BYTES, stream);
    if (e != hipSuccess) fprintf(stderr, "kernel_launch: cooperative launch failed: %s (grid %d)\n", hipGetErrorString(e), grid);
#endif
}
```

```cpp
#include <hip/hip_runtime.h>
#include <hip/hip_cooperative_groups.h>
#include <cstdio>
#include <cstdint>
namespace cg = cooperative_groups;
namespace pg8 {
#define PG8_LAS __attribute__((address_space(3)))
typedef unsigned short bf16_t;
typedef short bf16x8 __attribute__((ext_vector_type(8)));
typedef float f32x4 __attribute__((ext_vector_type(4)));
typedef unsigned u32x4 __attribute__((ext_vector_type(4)));
constexpr int BM = 256, BK = 64, HALF = 128, HTB = HALF * BK * 2  , STAGE_BYTES = 8 * HTB, NXCD = 8, WGM = 8;

__host__ __device__ __forceinline__ int lds_byte(int r, int c) { const int st = (r >> 4) * 2 + (c >> 5), rr = r & 15, cc = c & 31, ob = rr * 64 + cc * 2; return st * 1024 + (ob ^ (((ob >> 9) & 1) << 5)); }
__host__ __device__ __forceinline__ void stage_rc(int b, int& R, int& C) { const int st = b / 1024, sb = b % 1024, swz = sb ^ (((sb >> 9) & 1) << 5); R = (st >> 1) * 16 + swz / 64; C = (st & 1) * 32 + (swz % 64) / 2; }
__host__ __device__ __forceinline__ int perm32(int rho) { const int n = rho >> 4, i = rho & 15; return 8 * (i >> 2) + 4 * n + (i & 3); }

struct Unit { int pm, pn; };
struct Gemm { const bf16_t* A; const bf16_t* Bt; int M, N, K; };

struct StaticOrder {
    int nM, nN, nwg, G, c;
    __host__ __device__ void init(int M, int N, int G_, int c_) { nM = M / BM; nN = N / BM; nwg = nM * nN; G = G_; c = c_; }
    __host__ __device__ bool next(int i, Unit& u) const {
        const long L = (long)i * G + c; if (L >= nwg) return false;
        int wgid = (int)L; { const int q = nwg / NXCD, r = nwg % NXCD, xcd = wgid % NXCD, off = wgid / NXCD; wgid = (xcd < r ? xcd * (q + 1) : r * (q + 1) + (xcd - r) * q) + off; }
        const int nig = WGM * nN, gid = wgid / nig, fm = gid * WGM, gsz = (nM - fm) < WGM ? (nM - fm) : WGM;
        u.pm = fm + ((wgid % nig) % gsz); u.pn = (wgid % nig) / gsz; return true;
    }
    __device__ __forceinline__ void a_ready(const Unit&) const {}
    __device__ __forceinline__ void done(const Unit&) const {}
};

__device__ __forceinline__ unsigned cvt_pk_bf16(float lo, float hi) { unsigned r; asm volatile("v_cvt_pk_bf16_f32 %0, %1, %2" : "=v"(r) : "v"(lo), "v"(hi)); return r; }
typedef float f32x2 __attribute__((ext_vector_type(2)));
__device__ __forceinline__ f32x2 gelu_pk(f32x2 v) {
    const f32x2 av = __builtin_elementwise_abs(v), d = av * 0.2316418882f + 1.0f;
    f32x2 t; t.x = __builtin_amdgcn_rcpf(d.x); t.y = __builtin_amdgcn_rcpf(d.y);
    f32x2 q = t * 0.5307027145f + (-0.7265760135f); q = q * t + 0.7107068705f; q = q * t + (-0.142248368f); q = q * t + 0.127414796f; q = q * t;
    const f32x2 s = (v * v) * (-0.72134752044f);
    f32x2 e; e.x = __builtin_amdgcn_exp2f(s.x); e.y = __builtin_amdgcn_exp2f(s.y);
    const f32x2 m = v * (q * e), r = v - m;
    f32x2 o; o.x = v.x < 0.f ? m.x : r.x; o.y = v.y < 0.f ? m.y : r.y; return o;
}

template <int ACT  > struct EpiBf16 {
    static constexpr bool PERM = true, AFTER_DRAIN = false; static_assert(ACT == 0 || ACT == 1, "EpiBf16: ACT is 0 (none) or 1 (gelu_pk)");
    bf16_t* O; int ldc; const float* bias; int split_cols; size_t split_stride; float scale0;
    __device__ __forceinline__ void operator()(const f32x4 (&acc)[2][2][4][2], const Unit& u, int wr, int wc, int fr, int fq) const {
        const int row0 = u.pm * BM + wr * 64 + fr; int colt = u.pn * BM; bf16_t* base = O;
        float sc = 1.f; if (split_cols) { const int t = colt / split_cols; base += (size_t)t * split_stride; colt -= t * split_cols; if (t == 0) sc = scale0; }
        const int col0 = colt + wc * 32 + 8 * fq, bcol0 = u.pn * BM + wc * 32 + 8 * fq;
        f32x4 bv[2][2];
#pragma unroll
        for (int bj = 0; bj < 2; ++bj)
#pragma unroll
            for (int n = 0; n < 2; ++n) bv[bj][n] = bias ? *(const f32x4*)(bias + bcol0 + bj * HALF + 4 * n) : (f32x4){0.f, 0.f, 0.f, 0.f};
#pragma unroll
        for (int ai = 0; ai < 2; ++ai)
#pragma unroll
            for (int m = 0; m < 4; ++m) { bf16_t* rowp = base + (size_t)(row0 + ai * HALF + m * 16) * ldc + col0;
#pragma unroll
                for (int bj = 0; bj < 2; ++bj) { f32x4 v0 = acc[ai][bj][m][0] + bv[bj][0], v1 = acc[ai][bj][m][1] + bv[bj][1];
                    if (ACT == 1) { f32x2 a = gelu_pk((f32x2){v0[0], v0[1]}), b = gelu_pk((f32x2){v0[2], v0[3]}), c = gelu_pk((f32x2){v1[0], v1[1]}), d = gelu_pk((f32x2){v1[2], v1[3]});
                        v0 = (f32x4){a.x, a.y, b.x, b.y}; v1 = (f32x4){c.x, c.y, d.x, d.y}; }
                    v0 = v0 * sc; v1 = v1 * sc; u32x4 w; w.x = cvt_pk_bf16(v0[0], v0[1]); w.y = cvt_pk_bf16(v0[2], v0[3]); w.z = cvt_pk_bf16(v1[0], v1[1]); w.w = cvt_pk_bf16(v1[2], v1[3]);
                    *(u32x4*)(rowp + bj * HALF) = w; } }
    }
};
__device__ __forceinline__ unsigned cvtpk_rne(float lo, float hi) { typedef float f32x2_t __attribute__((ext_vector_type(2))); typedef __bf16 bf16x2_t __attribute__((ext_vector_type(2)));
    f32x2_t v = {lo, hi}; bf16x2_t b = __builtin_convertvector(v, bf16x2_t); return __builtin_bit_cast(unsigned, b); }
struct EpiF32 {
    static constexpr bool PERM = false, AFTER_DRAIN = false;
    float* O; int ldc;
    __device__ __forceinline__ void operator()(const f32x4 (&acc)[2][2][4][2], const Unit& u, int wr, int wc, int fr, int fq) const {
        const int row0 = u.pm * BM + wr * 64 + fr, col0 = u.pn * BM + wc * 32 + 4 * fq;
#pragma unroll
        for (int ai = 0; ai < 2; ++ai)
#pragma unroll
            for (int m = 0; m < 4; ++m) { float* rowp = O + (size_t)(row0 + ai * HALF + m * 16) * ldc + col0;
#pragma unroll
                for (int bj = 0; bj < 2; ++bj)
#pragma unroll
                    for (int n = 0; n < 2; ++n) *(f32x4*)(rowp + bj * HALF + n * 16) = acc[ai][bj][m][n]; }
    }
};
struct EpiSwiGLU {
    static constexpr bool PERM = true, AFTER_DRAIN = false;
    bf16_t* O; int ldc;
    __device__ __forceinline__ void operator()(const f32x4 (&acc)[2][2][4][2], const Unit& u, int wr, int wc, int fr, int fq) const {
        typedef unsigned u32x2 __attribute__((ext_vector_type(2)));
        const int row0 = u.pm * BM + wr * 64 + fr, col0 = u.pn * (BM / 2) + wc * 16 + 4 * fq;
#pragma unroll
        for (int ai = 0; ai < 2; ++ai)
#pragma unroll
            for (int m = 0; m < 4; ++m) { bf16_t* rowp = O + (size_t)(row0 + ai * HALF + m * 16) * ldc + col0;
#pragma unroll
                for (int bj = 0; bj < 2; ++bj) { const f32x4 g = acc[ai][bj][m][0], up = acc[ai][bj][m][1]; float a[4];
#pragma unroll
                    for (int e = 0; e < 4; ++e) a[e] = g[e] * __builtin_amdgcn_rcpf(1.0f + __builtin_amdgcn_exp2f(-1.4426950408889634f * g[e])) * up[e];
                    u32x2 w; w.x = cvtpk_rne(a[0], a[1]); w.y = cvtpk_rne(a[2], a[3]); *(u32x2*)(rowp + bj * (HALF / 2)) = w; } }
    }
};

template <class Epi, class Sched, bool ALIGN_EPI = false, bool SP2 = false>
__device__ __forceinline__ void gemm_phase(PG8_LAS unsigned char* lds, const Gemm g, const Sched& S, const Epi& E) {
    int tid_ = threadIdx.x; asm volatile("" : "+v"(tid_));
    const int tid = tid_, wid = __builtin_amdgcn_readfirstlane(tid >> 6), lane = tid & 63, wr = wid >> 2, wc = wid & 3, fr = lane & 15, fq = lane >> 4;
    const int K = g.K, nt = K / BK;
    unsigned voffA[2], voffB[2];
#pragma unroll
    for (int i = 0; i < 2; ++i) { int R, C; stage_rc(tid * 16 + i * 8192, R, C); const int Rb = Epi::PERM ? ((R & ~31) + perm32(R & 31)) : R;
        voffA[i] = (unsigned)(R * K + C) * 2u; voffB[i] = (unsigned)(Rb * K + C) * 2u; }
    const size_t kstep = (size_t)(BK * 2);
    const size_t hstep = (size_t)HALF * K * 2;
    const size_t tstep = 2 * hstep;
    const unsigned ldsw = (unsigned)wid * 1024u;
    const int aoff = lds_byte(wr * 64 + fr, fq * 8), boff = lds_byte(wc * 32 + fr, fq * 8);
#define PG8_SA(b, h) (((b) * 2 + (h)) * HTB)
#define PG8_SB(b, h) ((4 + (b) * 2 + (h)) * HTB)
#define PG8_STAGE(bufoff, gbase, voff) do { _Pragma("unroll") for (int _i = 0; _i < 2; ++_i) \
        __builtin_amdgcn_global_load_lds((const unsigned*)((const char*)(gbase) + (voff)[_i]), (PG8_LAS unsigned*)(lds + (bufoff) + ldsw + _i * 8192), 16, 0, 0); } while (0)
#define PG8_LDA(dst, b, h) do { _Pragma("unroll") for (int m = 0; m < 4; ++m) _Pragma("unroll") for (int k = 0; k < 2; ++k) dst[m][k] = *(const PG8_LAS bf16x8*)(lds + PG8_SA(b, h) + aoff + m * 2048 + k * 1024); } while (0)
#define PG8_LDB(dst, b, h) do { _Pragma("unroll") for (int n = 0; n < 2; ++n) _Pragma("unroll") for (int k = 0; k < 2; ++k) dst[n][k] = *(const PG8_LAS bf16x8*)(lds + PG8_SB(b, h) + boff + n * 2048 + k * 1024); } while (0)
#define PG8_MMA(ai, bj, At, Bt) do { __builtin_amdgcn_s_setprio(1); _Pragma("unroll") for (int m = 0; m < 4; ++m) _Pragma("unroll") for (int n = 0; n < 2; ++n) _Pragma("unroll") for (int k = 0; k < 2; ++k) \
        acc[ai][bj][m][n] = __builtin_amdgcn_mfma_f32_16x16x32_bf16(Bt[n][k], At[m][k], acc[ai][bj][m][n], 0, 0, 0); __builtin_amdgcn_s_setprio(0); } while (0)
#define PG8_WAIT_V(n) asm volatile("s_waitcnt vmcnt(" #n ")" ::: "memory")
#define PG8_WAIT_L(n) asm volatile("s_waitcnt lgkmcnt(" #n ")" ::: "memory")
#define PG8_BAR __builtin_amdgcn_s_barrier()
#define PG8_SCHED __builtin_amdgcn_sched_barrier(0)
    Unit cur, nxt; int ui = 0;
    if (!S.next(0, cur)) return;
    f32x4 acc[2][2][4][2];
#pragma unroll
    for (int a = 0; a < 2; ++a)
#pragma unroll
        for (int b = 0; b < 2; ++b)
#pragma unroll
            for (int m = 0; m < 4; ++m)
#pragma unroll
                for (int n = 0; n < 2; ++n) acc[a][b][m][n] = (f32x4){0.f, 0.f, 0.f, 0.f};
    bf16x8 At[4][2], B0[2][2], B1[2][2];
    const char* cA = (const char*)g.A + (size_t)cur.pm * tstep; const char* cB = (const char*)g.Bt + (size_t)cur.pn * tstep;
    S.a_ready(cur);
    if constexpr (SP2) {
        PG8_STAGE(PG8_SB(0, 0), cB, voffB); PG8_STAGE(PG8_SB(0, 1), cB + hstep, voffB); PG8_STAGE(PG8_SA(0, 0), cA, voffA); PG8_STAGE(PG8_SA(0, 1), cA + hstep, voffA);
        if (wr == 1) PG8_BAR;
        PG8_WAIT_V(2); PG8_BAR;
        PG8_STAGE(PG8_SB(1, 0), cB + kstep, voffB); PG8_STAGE(PG8_SA(1, 0), cA + kstep, voffA); PG8_STAGE(PG8_SB(1, 1), cB + hstep + kstep, voffB);
        PG8_WAIT_V(6); PG8_BAR;
    } else {
        PG8_STAGE(PG8_SB(0, 0), cB, voffB); PG8_STAGE(PG8_SA(0, 0), cA, voffA); PG8_STAGE(PG8_SB(0, 1), cB + hstep, voffB); PG8_STAGE(PG8_SA(0, 1), cA + hstep, voffA);
        if (wr == 1) PG8_BAR;
        PG8_WAIT_V(4); PG8_BAR;
        PG8_STAGE(PG8_SB(1, 0), cB + kstep, voffB); PG8_STAGE(PG8_SA(1, 0), cA + kstep, voffA); PG8_STAGE(PG8_SB(1, 1), cB + hstep + kstep, voffB);
        PG8_WAIT_V(6); PG8_BAR;
    }
    for (;;) {
        const bool has_next = S.next(ui + 1, nxt);
        const char* nA = has_next ? (const char*)g.A + (size_t)nxt.pm * tstep : cA; const char* nB = has_next ? (const char*)g.Bt + (size_t)nxt.pn * tstep : cB;
        for (int t = 0; t < nt; t += 2) {
            const bool last = (t == nt - 2);
            const char* a1 = cA + (size_t)(t + 1) * kstep;
            const char* a2 = last ? nA : cA + (size_t)(t + 2) * kstep; const char* b2 = last ? nB : cB + (size_t)(t + 2) * kstep;
            const char* a3 = a2 + kstep; const char* b3 = b2 + kstep;
            if (last && has_next) S.a_ready(nxt);
            if constexpr (SP2) {
            PG8_LDB(B0, 0, 0); PG8_LDB(B1, 0, 1); PG8_SCHED; PG8_LDA(At, 0, 0); PG8_STAGE(PG8_SA(1, 1), a1 + hstep, voffA);
            PG8_WAIT_V(8); PG8_WAIT_L(0); PG8_BAR; PG8_MMA(0, 0, At, B0); PG8_MMA(0, 1, At, B1); PG8_BAR; PG8_SCHED;
            PG8_LDA(At, 0, 1); PG8_STAGE(PG8_SB(0, 0), b2, voffB); PG8_STAGE(PG8_SB(0, 1), b2 + hstep, voffB); PG8_STAGE(PG8_SA(0, 0), a2, voffA);
            PG8_WAIT_V(8); PG8_WAIT_L(0); PG8_BAR; PG8_MMA(1, 0, At, B0); PG8_MMA(1, 1, At, B1); PG8_BAR; PG8_SCHED;
            PG8_LDB(B0, 1, 0); PG8_LDB(B1, 1, 1); PG8_SCHED; PG8_LDA(At, 1, 0); PG8_STAGE(PG8_SA(0, 1), a2 + hstep, voffA);
            PG8_WAIT_V(8); PG8_WAIT_L(0); PG8_BAR; PG8_MMA(0, 0, At, B0); PG8_MMA(0, 1, At, B1); PG8_BAR; PG8_SCHED;
            PG8_LDA(At, 1, 1); PG8_STAGE(PG8_SB(1, 0), b3, voffB); PG8_STAGE(PG8_SB(1, 1), b3 + hstep, voffB); PG8_STAGE(PG8_SA(1, 0), a3, voffA);
            PG8_WAIT_V(8); PG8_WAIT_L(0); PG8_BAR; PG8_MMA(1, 0, At, B0); PG8_MMA(1, 1, At, B1); PG8_BAR; PG8_SCHED;
            } else {
            PG8_LDB(B0, 0, 0); PG8_SCHED; PG8_LDA(At, 0, 0); PG8_STAGE(PG8_SA(1, 1), a1 + hstep, voffA);
            PG8_WAIT_L(8); PG8_BAR; PG8_WAIT_L(0); PG8_MMA(0, 0, At, B0); PG8_BAR; PG8_SCHED;
            PG8_LDB(B1, 0, 1); PG8_STAGE(PG8_SB(0, 0), b2, voffB);
            PG8_BAR; PG8_WAIT_L(0); PG8_MMA(0, 1, At, B1); PG8_BAR;
            PG8_LDA(At, 0, 1); PG8_STAGE(PG8_SA(0, 0), a2, voffA);
            PG8_BAR; PG8_WAIT_L(0); PG8_MMA(1, 0, At, B0); PG8_BAR; PG8_SCHED;
            PG8_STAGE(PG8_SB(0, 1), b2 + hstep, voffB);
            PG8_WAIT_V(6); PG8_BAR; PG8_MMA(1, 1, At, B1); PG8_BAR;
            PG8_LDB(B0, 1, 0); PG8_SCHED; PG8_LDA(At, 1, 0); PG8_STAGE(PG8_SA(0, 1), a2 + hstep, voffA);
            PG8_WAIT_L(8); PG8_BAR; PG8_WAIT_L(0); PG8_MMA(0, 0, At, B0); PG8_BAR; PG8_SCHED;
            PG8_LDB(B1, 1, 1); PG8_STAGE(PG8_SB(1, 0), b3, voffB);
            PG8_BAR; PG8_WAIT_L(0); PG8_MMA(0, 1, At, B1); PG8_BAR;
            PG8_LDA(At, 1, 1); PG8_STAGE(PG8_SA(1, 0), a3, voffA);
            PG8_BAR; PG8_WAIT_L(0); PG8_MMA(1, 0, At, B0); PG8_BAR; PG8_SCHED;
            PG8_STAGE(PG8_SB(1, 1), b3 + hstep, voffB);
            PG8_WAIT_V(6); PG8_BAR; PG8_MMA(1, 1, At, B1); PG8_BAR;
            }
        }
        if constexpr (ALIGN_EPI) { if (wr == 0) PG8_BAR; }
        if constexpr (!Epi::AFTER_DRAIN) { E(acc, cur, wr, wc, fr, fq); S.done(cur); }
        if (!has_next) break;
#pragma unroll
        for (int a = 0; a < 2; ++a)
#pragma unroll
            for (int b = 0; b < 2; ++b)
#pragma unroll
                for (int m = 0; m < 4; ++m)
#pragma unroll
                    for (int n = 0; n < 2; ++n) acc[a][b][m][n] = (f32x4){0.f, 0.f, 0.f, 0.f};
        cur = nxt; cA = nA; cB = nB; ++ui;
        if constexpr (ALIGN_EPI) { if (wr == 1) PG8_BAR; }
    }
    PG8_WAIT_V(0);
    if constexpr (!ALIGN_EPI) { if (wr == 0) PG8_BAR; }
    PG8_BAR;
    if constexpr (Epi::AFTER_DRAIN) { E.fused(acc, cur, wr, wc, fr, fq, lds, wid, lane); S.done(cur); }
#undef PG8_SA
#undef PG8_SB
#undef PG8_STAGE
#undef PG8_LDA
#undef PG8_LDB
#undef PG8_MMA
#undef PG8_WAIT_V
#undef PG8_WAIT_L
#undef PG8_BAR
#undef PG8_SCHED
}
}

#ifndef PG8_SP2
#define PG8_SP2 true
#endif
#ifndef PG8_ALIGN
#define PG8_ALIGN true
#endif
#ifndef PROBE_DUP
#define PROBE_DUP 0
#endif
#ifndef MK_SPLIT
#define MK_SPLIT 0
#endif

constexpr int NB = 2, SEQ = 4096, DM = 2048, NMETA = 16, LSEQ = SEQ + NMETA, DEPTH = 2;
constexpr int MR = NB * SEQ;
constexpr int MV = MR + NMETA;
constexpr int MP = 33 * 256;
constexpr int DIN = 4608, DFF = 5632, DATT = 1024, DPOOL = 512, DCONV = 512, NHEAD = 16;
constexpr int C_K = 1024, C_V = 2048, C_POOL = 3072, C_CA = 3584, C_CG = 4096;
constexpr float EPS = 1e-6f, LOG2E = 1.4426950408889634f, LN2 = 0.6931471805599453f;
constexpr float SB_EXIT = -110.0f;

constexpr size_t MiB = 1u << 20;
constexpr size_t WS_WIN = 0;
constexpr size_t WS_WOUT = WS_WIN + 36 * MiB;
constexpr size_t WS_WGU = WS_WOUT + 16 * MiB;
constexpr size_t WS_WD = WS_WGU + 44 * MiB;
constexpr size_t WS_WSM = WS_WD + 22 * MiB;
constexpr size_t WS_H = WS_WSM + 2 * MiB;
constexpr size_t WS_U = WS_H + 66 * MiB;
constexpr size_t WS_OUT = WS_U + 33 * MiB;
constexpr size_t WS_PROJ = WS_OUT + 66 * MiB;
constexpr size_t WS_MERGED = WS_PROJ + (size_t)MP * DIN * 2;
constexpr size_t WS_ACT = WS_PROJ;
constexpr size_t WS_END = WS_MERGED + 33 * MiB;
static_assert((size_t)MP * DFF * 2 <= WS_END - WS_PROJ, "act overlay");

constexpr int LDS_BYTES = 147456;

#define GAS __attribute__((address_space(1)))
#define LAS __attribute__((address_space(3)))
typedef unsigned short bf16;
typedef unsigned v4u __attribute__((ext_vector_type(4)));
typedef unsigned v2u __attribute__((ext_vector_type(2)));
typedef float f32x4 __attribute__((ext_vector_type(4)));
typedef short bf16x8 __attribute__((ext_vector_type(8)));
typedef short v4i16_t __attribute__((ext_vector_type(4)));
#define LDS_WAIT() asm volatile("s_waitcnt lgkmcnt(0)" ::: "memory")

__device__ __forceinline__ unsigned cvtpk(float lo, float hi) { return pg8::cvtpk_rne(lo, hi); }
__device__ __forceinline__ float bflo(unsigned u) { return __uint_as_float(u << 16); }
__device__ __forceinline__ float bfhi(unsigned u) { return __uint_as_float(u & 0xffff0000u); }
__device__ __forceinline__ float bf2f(bf16 v) { return __uint_as_float((unsigned)v << 16); }
__device__ __forceinline__ float wave_sum(float v) {
#pragma unroll
    for (int o = 1; o < 64; o <<= 1) v += __shfl_xor(v, o);
    return v;
}
__device__ __forceinline__ float sigmoidf_(float x) { return __builtin_amdgcn_rcpf(1.0f + __builtin_amdgcn_exp2f(-LOG2E * x)); }
template <class T> __device__ __forceinline__ T* gptr(T* p) { GAS T* g = (GAS T*)p; asm volatile("" : "+s"(g)); return (T*)g; }
__device__ __forceinline__ int rowidx(int b, int pos) { return pos < NMETA ? MR + pos : b * SEQ + pos - NMETA; }
__device__ __forceinline__ f32x4 mfma16(bf16x8 a, bf16x8 b, f32x4 c) { return __builtin_amdgcn_mfma_f32_16x16x32_bf16(a, b, c, 0, 0, 0); }

struct Args {
    const float *x, *meta, *pre_mix_g, *w_in, *w_pool, *pool_scale, *w_dw, *b_dw, *conv_ln_g, *conv_ln_b, *w_pw, *mix_out_g, *w_out, *post_mix_g, *pre_ffn_g, *w_gate, *w_up, *w_down, *post_ffn_g;
    float* out; unsigned char* ws; int ph_lo, ph_hi;
};

__device__ __forceinline__ void transpose_item(const float* __restrict__ W, int K, int N, bf16* WT, int mode, LAS float* scr, int item, int lane) {
    W = gptr(W); WT = gptr(WT);
    const int nblk = N >> 6, kb = item / nblk, nb = item - kb * nblk, k0 = kb << 6, n0 = nb << 6;
    const int r4 = lane >> 4, c4 = (lane & 15) * 4;
#pragma unroll 4
    for (int i = 0; i < 16; ++i) { const int kk = 4 * i + r4; const f32x4 v = *(const f32x4*)(W + (size_t)(k0 + kk) * N + n0 + c4);
        LAS float* s = scr + kk * 65 + c4; s[0] = v.x; s[1] = v.y; s[2] = v.z; s[3] = v.w; }
    LDS_WAIT();
    const int c = lane & 7;
#pragma unroll
    for (int j = 0; j < 8; ++j) { const int n = (lane >> 3) + 8 * j; const LAS float* s = scr + (8 * c) * 65 + n;
        v4u o; o.x = cvtpk(s[0 * 65], s[1 * 65]); o.y = cvtpk(s[2 * 65], s[3 * 65]); o.z = cvtpk(s[4 * 65], s[5 * 65]); o.w = cvtpk(s[6 * 65], s[7 * 65]);
        const int ng = n0 + n; const int R = mode == 0 ? ng : ((ng >> 2) * 8 + (ng & 3) + (mode == 2 ? 4 : 0));
        *(v4u*)(WT + (size_t)R * K + k0 + 8 * c) = o; }
    LDS_WAIT();
}
#define TJOB(Wp, Kk, Nn, WTp, mode) { const int ni_ = ((Kk) / 64) * ((Nn) / 64); if (r < ni_) { transpose_item((Wp), (Kk), (Nn), (WTp), (mode), scr, r, lane); continue; } r -= ni_; }

__device__ __forceinline__ void convert_ffn_weights(const Args& A, int l, LAS float* scr, int gw, int NGW, int lane) {
    bf16* wgu = (bf16*)(A.ws + WS_WGU); bf16* wd = (bf16*)(A.ws + WS_WD);
    constexpr int NI = 3 * (DM / 64) * (DFF / 64);
    for (int it = gw; it < NI; it += NGW) { int r = it;
        TJOB(A.w_gate + (size_t)l * DM * DFF, DM, DFF, wgu, 1)
        TJOB(A.w_up + (size_t)l * DM * DFF, DM, DFF, wgu, 2)
        TJOB(A.w_down + (size_t)l * DFF * DM, DFF, DM, wd, 0)
    }
}
__device__ __forceinline__ void convert_mix_weights(const Args& A, LAS float* scr, int gw, int NGW, int lane) {
    constexpr int I_IN = (DM / 64) * (DIN / 64), I_OUT = (DM / 64) * (DM / 64), I_PW = 64, I_POOL = 16, NL = I_IN + I_OUT + I_PW + I_POOL;
    for (int it = gw; it < DEPTH * NL; it += NGW) { const int l = it / NL; int r = it - l * NL;
        if (r < I_IN) { transpose_item(A.w_in + (size_t)l * DM * DIN, DM, DIN, (bf16*)(A.ws + WS_WIN) + (size_t)l * DIN * DM, 0, scr, r, lane); continue; } r -= I_IN;
        if (r < I_OUT) { transpose_item(A.w_out + (size_t)l * DM * DM, DM, DM, (bf16*)(A.ws + WS_WOUT) + (size_t)l * DM * DM, 0, scr, r, lane); continue; } r -= I_OUT;
        if (r < I_PW) { transpose_item(A.w_pw + (size_t)l * 512 * 512, 512, 512, (bf16*)(A.ws + WS_WSM + 256 * 1024) + (size_t)l * 512 * 512, 0, scr, r, lane); continue; } r -= I_PW;
        { const int g = r >> 2; transpose_item(A.w_pool + (size_t)(l * 4 + g) * 128 * 128, 128, 128, (bf16*)(A.ws + WS_WSM) + (size_t)(l * 4 + g) * 128 * 128, 0, scr, r & 3, lane); }
    }
}

__device__ __forceinline__ float dot4(f32x4 a) { return (a.x * a.x + a.y * a.y) + (a.z * a.z + a.w * a.w); }
__device__ __forceinline__ void store_u_row(bf16* urow, const f32x4 (&hv)[8], float r, const float* g, int lane) {
#pragma unroll
    for (int j = 0; j < 8; ++j) { const f32x4 gv = ((const f32x4*)g)[lane + 64 * j]; v2u w; w.x = cvtpk(hv[j].x * r * gv.x, hv[j].y * r * gv.y); w.y = cvtpk(hv[j].z * r * gv.z, hv[j].w * r * gv.w);
        ((v2u*)urow)[lane + 64 * j] = w; }
}
__device__ __forceinline__ void init_rows(const Args& A, int gw, int NGW, int lane) {
    unsigned char* wsb = gptr(A.ws); float* h = (float*)(wsb + WS_H); bf16* u = (bf16*)(wsb + WS_U); const float* pg = gptr(A.pre_mix_g);
    for (int m = gw; m < MV; m += NGW) {
        const float* src = m < MR ? gptr(A.x) + (size_t)m * DM : gptr(A.meta) + (size_t)(m - MR) * DM;
        f32x4 hv[8]; float ss = 0.f;
#pragma unroll
        for (int j = 0; j < 8; ++j) { hv[j] = ((const f32x4*)src)[lane + 64 * j]; ss += dot4(hv[j]); ((f32x4*)(h + (size_t)m * DM))[lane + 64 * j] = hv[j]; }
        const float r = rsqrtf(wave_sum(ss) * (1.0f / DM) + EPS);
        store_u_row(u + (size_t)m * DM, hv, r, pg, lane);
    }
}
__device__ __forceinline__ void row_phase(const Args& A, const float* g1, const float* g2, float* dout, int gw, int NGW, int lane) {
    unsigned char* wsb = gptr(A.ws); float* h = (float*)(wsb + WS_H); bf16* u = (bf16*)(wsb + WS_U); const float* src = (const float*)(wsb + WS_OUT); g1 = gptr(g1); g2 = gptr(g2); dout = gptr(dout);
    for (int m = gw; m < MV; m += NGW) {
        f32x4 o[8], hv[8]; float ss = 0.f;
#pragma unroll
        for (int j = 0; j < 8; ++j) { o[j] = ((const f32x4*)(src + (size_t)m * DM))[lane + 64 * j]; hv[j] = ((const f32x4*)(h + (size_t)m * DM))[lane + 64 * j]; ss += dot4(o[j]); }
        const float r = rsqrtf(wave_sum(ss) * (1.0f / DM) + EPS);
        float ss2 = 0.f;
#pragma unroll
        for (int j = 0; j < 8; ++j) { const f32x4 gv = ((const f32x4*)g1)[lane + 64 * j]; hv[j] = hv[j] + o[j] * r * gv; ss2 += dot4(hv[j]); }
        if (dout) {
            if (m < MR) {
#pragma unroll
                for (int j = 0; j < 8; ++j) ((f32x4*)(dout + (size_t)m * DM))[lane + 64 * j] = hv[j];
            }
        } else {
#pragma unroll
            for (int j = 0; j < 8; ++j) ((f32x4*)(h + (size_t)m * DM))[lane + 64 * j] = hv[j];
            const float r2 = rsqrtf(wave_sum(ss2) * (1.0f / DM) + EPS);
            store_u_row(u + (size_t)m * DM, hv, r2, g2, lane);
        }
    }
}

template <int MODE> __device__ __forceinline__ void skinny_gemm(const bf16* __restrict__ Arows, const bf16* __restrict__ Bt, int N, int K, void* O, int ldc, LAS unsigned char* lds, int lane, int wave) {
    const int li = lane & 15, fq = lane >> 4; const int nks = K >> 5;
    LAS f32x4* part = (LAS f32x4*)lds;
    for (int blk = blockIdx.x; blk < (N >> 4); blk += gridDim.x) {
        const bf16* bp = Bt + (size_t)(blk * 16 + li) * K + 8 * fq; const bf16* ap = Arows + (size_t)li * K + 8 * fq;
        f32x4 acc = (f32x4){0.f, 0.f, 0.f, 0.f};
#pragma unroll 8
        for (int ks = wave; ks < nks; ks += 8) { const bf16x8 wf = *(const bf16x8*)(bp + ks * 32); const bf16x8 af = *(const bf16x8*)(ap + ks * 32); acc = mfma16(wf, af, acc); }
        part[wave * 64 + lane] = acc;
        __syncthreads();
        if (wave == 0) {
            f32x4 v = part[lane];
#pragma unroll
            for (int w8 = 1; w8 < 8; ++w8) v = v + part[w8 * 64 + lane];
            const int n0 = blk * 16 + 4 * fq;
            if (MODE == 0) { const float sc = n0 < 1024 ? 0.125f : 1.0f; v2u w; w.x = cvtpk(v.x * sc, v.y * sc); w.y = cvtpk(v.z * sc, v.w * sc); *(v2u*)((bf16*)O + (size_t)(MR + li) * ldc + n0) = w; }
            else if (MODE == 1) { *(f32x4*)((float*)O + (size_t)(MR + li) * ldc + n0) = v; }
            else { f32x4 up; up.x = __shfl_xor(v.x, 16); up.y = __shfl_xor(v.y, 16); up.z = __shfl_xor(v.z, 16); up.w = __shfl_xor(v.w, 16);
                if ((fq & 1) == 0) { v2u w; w.x = cvtpk(v.x * sigmoidf_(v.x) * up.x, v.y * sigmoidf_(v.y) * up.y); w.y = cvtpk(v.z * sigmoidf_(v.z) * up.z, v.w * sigmoidf_(v.w) * up.w);
                    *(v2u*)((bf16*)O + (size_t)(MR + li) * ldc + blk * 8 + 4 * (fq >> 1)) = w; } }
        }
        __syncthreads();
    }
}

constexpr int VPITCH = 128;
constexpr int ML_V = 0, ML_ST = 8 * 64 * VPITCH  , ML_RED = ML_ST + 65536, ML_Y = 0  , ML_AB = ML_Y + 16 * 516 * 4;
static_assert(ML_RED + 3 * 512 <= LDS_BYTES && ML_AB + 16 * 1040 <= ML_ST, "mixer LDS");

__device__ __forceinline__ float softplus_(float z) { const float t = __builtin_amdgcn_exp2f(-LOG2E * __builtin_fabsf(z)); return __builtin_fmaxf(z, 0.f) + LN2 * __builtin_amdgcn_logf(1.0f + t); }
__device__ __forceinline__ void split_pack(const f32x4& a, const f32x4& b, bf16x8& hi, bf16x8& lo) {
    v4u h, l;
    h.x = cvtpk(a[0], a[1]); h.y = cvtpk(a[2], a[3]); h.z = cvtpk(b[0], b[1]); h.w = cvtpk(b[2], b[3]);
    l.x = cvtpk(a[0] - bflo(h.x), a[1] - bfhi(h.x)); l.y = cvtpk(a[2] - bflo(h.y), a[3] - bfhi(h.y));
    l.z = cvtpk(b[0] - bflo(h.z), b[1] - bfhi(h.z)); l.w = cvtpk(b[2] - bflo(h.w), b[3] - bfhi(h.w));
    hi = __builtin_bit_cast(bf16x8, h); lo = __builtin_bit_cast(bf16x8, l);
}
__device__ __forceinline__ void sb_attention(const bf16* __restrict__ proj, int b, int p0, int hd, LAS unsigned char* vl, int lane, f32x4 (&o)[4]) {
    const int li = lane & 15, fq = lane >> 4;
    const int qpos = p0 + li;
    const bf16* qp = proj + (size_t)rowidx(b, qpos) * DIN + hd * 64 + fq * 8;
    const bf16x8 qf0 = *(const bf16x8*)qp, qf1 = *(const bf16x8*)(qp + 32);
    unsigned d0 = 0u, d1 = 0u;
    { const unsigned one = 0x3F80u; d0 = ((4 * fq + 0 >= li) ? one : 0u) | ((4 * fq + 1 >= li) ? (one << 16) : 0u); d1 = ((4 * fq + 2 >= li) ? one : 0u) | ((4 * fq + 3 >= li) ? (one << 16) : 0u); }
    const unsigned ONE2 = 0x3F803F80u;
    const bf16x8 F_D1 = __builtin_bit_cast(bf16x8, (v4u){d0, d1, ONE2, ONE2});
    const bf16x8 F_11 = __builtin_bit_cast(bf16x8, (v4u){ONE2, ONE2, ONE2, ONE2});
    const bf16x8 F_0D = __builtin_bit_cast(bf16x8, (v4u){0u, 0u, d0, d1});
#pragma unroll
    for (int i = 0; i < 4; ++i) o[i] = (f32x4){0.f, 0.f, 0.f, 0.f};
    float carry = 0.f;
    const int ktd = p0 >> 6;
    const unsigned trbase = (unsigned)((4 * fq + (li >> 2)) * VPITCH + (lane & 3) * 8);
    bf16x8 kf[4][2];
#define SB_LOADK(KT) do { _Pragma("unroll") for (int kb = 0; kb < 4; ++kb) { int kp = 64 * (KT) + 16 * kb + li; kp = kp < LSEQ ? kp : LSEQ - 1; const bf16* kr = proj + (size_t)rowidx(b, kp) * DIN + C_K + hd * 64 + fq * 8; \
        kf[kb][0] = *(const bf16x8*)kr; kf[kb][1] = *(const bf16x8*)(kr + 32); } } while (0)
    SB_LOADK(ktd);
    for (int kt = ktd; kt >= 0; --kt) {
        const bool diag = (kt == ktd);
#pragma unroll
        for (int it = 0; it < 8; ++it) { const int key = it * 8 + (lane >> 3); int kp = 64 * kt + key; kp = kp < LSEQ ? kp : LSEQ - 1;
            __builtin_amdgcn_global_load_lds((const unsigned*)(proj + (size_t)rowidx(b, kp) * DIN + C_V + hd * 64 + (lane & 7) * 8), (LAS unsigned*)(vl + it * 1024), 16, 0, 0); }
        f32x4 s[4], lnb[4];
#pragma unroll
        for (int kb = 0; kb < 4; ++kb) { s[kb] = mfma16(kf[kb][0], qf0, (f32x4){0.f, 0.f, 0.f, 0.f}); s[kb] = mfma16(kf[kb][1], qf1, s[kb]); }
        { const int ktn = kt > 0 ? kt - 1 : 0; SB_LOADK(ktn); }
#pragma unroll
        for (int kb = 0; kb < 4; ++kb)
#pragma unroll
            for (int e = 0; e < 4; ++e) { const bool m = !diag || (64 * kt + 16 * kb + 4 * fq + e < qpos); lnb[kb][e] = m ? -softplus_(s[kb][e]) : 0.f; }
        bf16x8 bh[2], bl[2];
        split_pack(lnb[0], lnb[1], bh[0], bl[0]); split_pack(lnb[2], lnb[3], bh[1], bl[1]);
        f32x4 c[4];
#pragma unroll
        for (int i = 0; i < 4; ++i) c[i] = (f32x4){carry, carry, carry, carry};
        c[0] = mfma16(F_D1, bh[0], c[0]); c[0] = mfma16(F_D1, bl[0], c[0]); c[0] = mfma16(F_11, bh[1], c[0]); c[0] = mfma16(F_11, bl[1], c[0]);
        c[1] = mfma16(F_0D, bh[0], c[1]); c[1] = mfma16(F_0D, bl[0], c[1]); c[1] = mfma16(F_11, bh[1], c[1]); c[1] = mfma16(F_11, bl[1], c[1]);
        c[2] = mfma16(F_D1, bh[1], c[2]); c[2] = mfma16(F_D1, bl[1], c[2]);
        c[3] = mfma16(F_0D, bh[1], c[3]); c[3] = mfma16(F_0D, bl[1], c[3]);
        f32x4 w[4];
#pragma unroll
        for (int kb = 0; kb < 4; ++kb)
#pragma unroll
            for (int e = 0; e < 4; ++e) { const bool m = !diag || (64 * kt + 16 * kb + 4 * fq + e < qpos); w[kb][e] = m ? __builtin_amdgcn_exp2f(LOG2E * (s[kb][e] + c[kb][e])) : 0.f; }
        carry = __shfl(c[0][0], li);
        v4u p0v, p1v;
        p0v.x = cvtpk(w[0][0], w[0][1]); p0v.y = cvtpk(w[0][2], w[0][3]); p0v.z = cvtpk(w[1][0], w[1][1]); p0v.w = cvtpk(w[1][2], w[1][3]);
        p1v.x = cvtpk(w[2][0], w[2][1]); p1v.y = cvtpk(w[2][2], w[2][3]); p1v.z = cvtpk(w[3][0], w[3][1]); p1v.w = cvtpk(w[3][2], w[3][3]);
        const bf16x8 pf0 = __builtin_bit_cast(bf16x8, p0v), pf1 = __builtin_bit_cast(bf16x8, p1v);
        asm volatile("s_waitcnt vmcnt(0)" ::: "memory");
#pragma unroll
        for (int db = 0; db < 4; ++db) {
#pragma unroll
            for (int s2 = 0; s2 < 2; ++s2) {
                const v4i16_t lo = __builtin_amdgcn_ds_read_tr16_b64_v4i16((LAS v4i16_t*)(vl + trbase + (32 * s2) * VPITCH + db * 32));
                const v4i16_t hi = __builtin_amdgcn_ds_read_tr16_b64_v4i16((LAS v4i16_t*)(vl + trbase + (32 * s2 + 16) * VPITCH + db * 32));
                const bf16x8 vf = (bf16x8){lo[0], lo[1], lo[2], lo[3], hi[0], hi[1], hi[2], hi[3]};
                o[db] = mfma16(vf, s2 == 0 ? pf0 : pf1, o[db]);
            }
        }
        if (__all(carry < SB_EXIT)) break;
    }
#undef SB_LOADK
}

template <int W> __device__ __forceinline__ void pool_group(const bf16* __restrict__ psrc, const bf16* __restrict__ wpt, int b, int pos, f32x4 (&pacc)[4]) {
    const int cnt = (pos + 1 < W) ? pos + 1 : W; const float inv = 1.0f / (float)cnt;
    constexpr int BW = W < 8 ? W : 8;
#pragma unroll 1
    for (int ks = 0; ks < 4; ++ks) {
        bf16x8 wf[4];
#pragma unroll
        for (int nb = 0; nb < 4; ++nb) wf[nb] = *(const bf16x8*)(wpt + (size_t)nb * 16 * 128 + 32 * ks);
        float sum[8], self[8];
#pragma unroll
        for (int e = 0; e < 8; ++e) { sum[e] = 0.f; self[e] = 0.f; }
#pragma unroll
        for (int j0 = 0; j0 < W; j0 += BW) {
            v4u v[BW];
#pragma unroll
            for (int j = 0; j < BW; ++j) { const int pp = pos - j0 - j; v[j] = *(const v4u*)(psrc + (size_t)rowidx(b, pp >= 0 ? pp : 0) * DIN + 32 * ks); }
#pragma unroll
            for (int j = 0; j < BW; ++j) { const float f = (pos - j0 - j) >= 0 ? 1.0f : 0.0f;
                sum[0] += f * bflo(v[j].x); sum[1] += f * bfhi(v[j].x); sum[2] += f * bflo(v[j].y); sum[3] += f * bfhi(v[j].y);
                sum[4] += f * bflo(v[j].z); sum[5] += f * bfhi(v[j].z); sum[6] += f * bflo(v[j].w); sum[7] += f * bfhi(v[j].w); }
            if (j0 == 0) { self[0] = bflo(v[0].x); self[1] = bfhi(v[0].x); self[2] = bflo(v[0].y); self[3] = bfhi(v[0].y); self[4] = bflo(v[0].z); self[5] = bfhi(v[0].z); self[6] = bflo(v[0].w); self[7] = bfhi(v[0].w); }
            if (j0 + BW < W) __builtin_amdgcn_sched_barrier(0);
        }
        v4u pk; pk.x = cvtpk(sum[0] * inv - self[0], sum[1] * inv - self[1]); pk.y = cvtpk(sum[2] * inv - self[2], sum[3] * inv - self[3]);
        pk.z = cvtpk(sum[4] * inv - self[4], sum[5] * inv - self[5]); pk.w = cvtpk(sum[6] * inv - self[6], sum[7] * inv - self[7]);
        const bf16x8 pf = __builtin_bit_cast(bf16x8, pk);
#pragma unroll
        for (int nb = 0; nb < 4; ++nb) pacc[nb] = mfma16(wf[nb], pf, pacc[nb]);
    }
}

__device__ __forceinline__ void mixer_phase(const Args& A, int l, LAS unsigned char* lds, int tid0, int wave) {
    unsigned char* wsb = gptr(A.ws);
    const bf16* proj = (const bf16*)(wsb + WS_PROJ); bf16* merged = (bf16*)(wsb + WS_MERGED);
    const bf16* wpool_t = (const bf16*)(wsb + WS_WSM) + (size_t)l * 4 * 128 * 128;
    const bf16* wpw_t = (const bf16*)(wsb + WS_WSM + 256 * 1024) + (size_t)l * 512 * 512;
    const float* wdw = gptr(A.w_dw) + (size_t)l * 31 * 512; const float* bdw = gptr(A.b_dw) + l * 512; const float* lng = gptr(A.conv_ln_g) + l * 512; const float* lnb_ = gptr(A.conv_ln_b) + l * 512;
    const float* psc = gptr(A.pool_scale) + l * 512; const float* mg = gptr(A.mix_out_g) + (size_t)l * DM;
    LAS float* Y = (LAS float*)(lds + ML_Y); LAS unsigned short* Ab = (LAS unsigned short*)(lds + ML_AB); LAS float* red = (LAS float*)(lds + ML_RED);
    LAS unsigned char* vl = lds + ML_V + wave * (64 * VPITCH); LAS unsigned char* st = lds + ML_ST + wave * 8192;
    for (int ti = blockIdx.x; ti < 513; ti += gridDim.x) {
        int b, p0; if (ti < 512) { b = ti >> 8; p0 = 16 + 16 * (ti & 255); } else { b = 0; p0 = 0; }
        int tid_l = tid0; asm volatile("" : "+v"(tid_l));
        const int tid = tid_l, lane = tid & 63, li = lane & 15, fq = lane >> 4;
#pragma unroll 1
        for (int hh = 0; hh < 2; ++hh) { f32x4 o0[4];
            sb_attention(proj, b, p0, 2 * wave + hh, vl, lane, o0);
#pragma unroll
            for (int db = 0; db < 4; ++db) *(LAS f32x4*)(st + ((hh * 4 + db) * 64 + lane) * 16) = o0[db]; }
        __syncthreads();
        {
            const int c = tid; const bf16* pa = proj + C_CA + c;
            float glu[46];
#pragma unroll
            for (int r = 0; r < 46; ++r) { const int pos = p0 - 30 + r; float gv = 0.f;
                if (pos >= 0) { const size_t row = (size_t)rowidx(b, pos); const float a = bf2f(pa[row * DIN]); const float gt = bf2f(pa[row * DIN + 512]); gv = a * sigmoidf_(gt); }
                glu[r] = gv;
                if ((r & 15) == 15) __builtin_amdgcn_sched_barrier(0); }
            const float* wdc = wdw + c; asm volatile("" : "+v"(wdc));
            float y[16]; const float bias = bdw[c];
#pragma unroll
            for (int t = 0; t < 16; ++t) y[t] = bias;
#pragma unroll
            for (int j = 0; j < 31; ++j) { const float w = wdc[j * 512];
#pragma unroll
                for (int t = 0; t < 16; ++t) y[t] += w * glu[t + j]; }
#pragma unroll
            for (int t = 0; t < 16; ++t) Y[t * 516 + c] = y[t];
        }
        __syncthreads();
#pragma unroll
        for (int tt = 0; tt < 2; ++tt) { const int t = 2 * wave + tt; float v[8]; float sm = 0.f;
#pragma unroll
            for (int i = 0; i < 8; ++i) { v[i] = Y[t * 516 + lane + 64 * i]; sm += v[i]; }
            const float mean = wave_sum(sm) * (1.0f / 512.0f); float q = 0.f;
#pragma unroll
            for (int i = 0; i < 8; ++i) { v[i] -= mean; q += v[i] * v[i]; }
            const float rstd = rsqrtf(wave_sum(q) * (1.0f / 512.0f) + EPS);
#pragma unroll
            for (int i = 0; i < 8; ++i) { const int c = lane + 64 * i; const float yn = v[i] * rstd * lng[c] + lnb_[c]; const float a = yn * sigmoidf_(yn); Ab[t * 520 + c] = (unsigned short)(cvtpk(a, 0.f) & 0xffffu); }
        }
        __syncthreads();
        f32x4 cacc[4];
#pragma unroll
        for (int i = 0; i < 4; ++i) cacc[i] = (f32x4){0.f, 0.f, 0.f, 0.f};
        { const bf16* wp = wpw_t + (size_t)(64 * wave + li) * 512 + 8 * fq; const LAS unsigned char* ab = (const LAS unsigned char*)Ab + li * 1040 + fq * 16;
#pragma unroll 4
            for (int ks = 0; ks < 16; ++ks) { const bf16x8 bfr = *(const LAS bf16x8*)(ab + ks * 64);
#pragma unroll
                for (int nb = 0; nb < 4; ++nb) { const bf16x8 wf = *(const bf16x8*)(wp + (size_t)nb * 16 * 512 + ks * 32); cacc[nb] = mfma16(wf, bfr, cacc[nb]); } } }
        f32x4 pacc[4];
#pragma unroll
        for (int i = 0; i < 4; ++i) pacc[i] = (f32x4){0.f, 0.f, 0.f, 0.f};
        { const int g = wave >> 1, nh = wave & 1;
            const bf16* wpt = wpool_t + (size_t)(g * 128 + 64 * nh + li) * 128 + 8 * fq; const bf16* psrc = proj + C_POOL + 128 * g + 8 * fq;
            if (g == 0) pool_group<2>(psrc, wpt, b, p0 + li, pacc); else if (g == 1) pool_group<4>(psrc, wpt, b, p0 + li, pacc); else if (g == 2) pool_group<8>(psrc, wpt, b, p0 + li, pacc); else pool_group<16>(psrc, wpt, b, p0 + li, pacc); }
        f32x4 oa[2][4];
#pragma unroll
        for (int hh = 0; hh < 2; ++hh)
#pragma unroll
            for (int db = 0; db < 4; ++db) oa[hh][db] = *(const LAS f32x4*)(st + ((hh * 4 + db) * 64 + lane) * 16);
        float ssa = 0.f, ssp = 0.f, ssc = 0.f;
        { const int g = wave >> 1, nh = wave & 1;
#pragma unroll
            for (int nb = 0; nb < 4; ++nb) { const f32x4 sc = *(const f32x4*)(psc + 128 * g + 64 * nh + 16 * nb + 4 * fq); pacc[nb] = pacc[nb] * sc; ssp += dot4(pacc[nb]); ssc += dot4(cacc[nb]); ssa += dot4(oa[0][nb]) + dot4(oa[1][nb]); } }
        ssa += __shfl_xor(ssa, 16); ssa += __shfl_xor(ssa, 32); ssp += __shfl_xor(ssp, 16); ssp += __shfl_xor(ssp, 32); ssc += __shfl_xor(ssc, 16); ssc += __shfl_xor(ssc, 32);
        if (lane < 16) { red[wave * 16 + lane] = ssa; red[128 + wave * 16 + lane] = ssp; red[256 + wave * 16 + lane] = ssc; }
        __syncthreads();
        float ta = 0.f, tp = 0.f, tc = 0.f;
#pragma unroll
        for (int w8 = 0; w8 < 8; ++w8) { ta += red[w8 * 16 + li]; tp += red[128 + w8 * 16 + li]; tc += red[256 + w8 * 16 + li]; }
        const float ra = rsqrtf(ta * (1.0f / DATT) + EPS), rp = rsqrtf(tp * (1.0f / DPOOL) + EPS), rc = rsqrtf(tc * (1.0f / DCONV) + EPS);
        bf16* orow = merged + (size_t)rowidx(b, p0 + li) * DM;
#pragma unroll
        for (int hh = 0; hh < 2; ++hh)
#pragma unroll
            for (int db = 0; db < 4; ++db) { const int col = (2 * wave + hh) * 64 + 16 * db + 4 * fq; const f32x4 gv = *(const f32x4*)(mg + col); const f32x4 v = oa[hh][db] * ra * gv;
                v2u w2; w2.x = cvtpk(v.x, v.y); w2.y = cvtpk(v.z, v.w); *(v2u*)(orow + col) = w2; }
        { const int g = wave >> 1, nh = wave & 1;
#pragma unroll
            for (int nb = 0; nb < 4; ++nb) { const int col = DATT + 128 * g + 64 * nh + 16 * nb + 4 * fq; const f32x4 gv = *(const f32x4*)(mg + col); const f32x4 v = pacc[nb] * rp * gv;
                v2u w2; w2.x = cvtpk(v.x, v.y); w2.y = cvtpk(v.z, v.w); *(v2u*)(orow + col) = w2; } }
#pragma unroll
        for (int nb = 0; nb < 4; ++nb) { const int col = DATT + DPOOL + 64 * wave + 16 * nb + 4 * fq; const f32x4 gv = *(const f32x4*)(mg + col); const f32x4 v = cacc[nb] * rc * gv;
            v2u w2; w2.x = cvtpk(v.x, v.y); w2.y = cvtpk(v.z, v.w); *(v2u*)(orow + col) = w2; }
        __syncthreads();
    }
}

constexpr int NPHASE = 1 + 7 * DEPTH;
#define PHASE_ENTER() int tid_ = threadIdx.x; asm volatile("" : "+v"(tid_)); const int tid = tid_, lane = tid & 63, wave = __builtin_amdgcn_readfirstlane(tid >> 6); \
    const __attribute__((address_space(4))) Args* ka_ = (const __attribute__((address_space(4))) Args*)__builtin_amdgcn_kernarg_segment_ptr(); asm volatile("" : "+s"(ka_)); Args A; __builtin_memcpy(&A, ka_, sizeof(Args)); \
    const int G = gridDim.x, gw = blockIdx.x * 8 + wave, NGW = G * 8; LAS float* scr = (LAS float*)(lds + wave * 16640); (void)tid; (void)lane; (void)gw; (void)NGW; (void)scr; (void)G;
__global__ void __launch_bounds__(512, 2) fwd_megakernel(Args args) {
    extern __shared__ __attribute__((aligned(16))) unsigned char lds_raw[];
    LAS unsigned char* lds = (LAS unsigned char*)lds_raw;
    cg::grid_group grid = cg::this_grid();
    const int lo = args.ph_lo, hi = args.ph_hi;
#define IN(k) (lo <= (k) && (k) < hi)
#define SEAM(k) do { if (IN(k) && IN((k) + 1)) grid.sync(); } while (0)
    int k = 0;
    for (int rep = 0; rep < ((PROBE_DUP & 1) ? 2 : 1); ++rep) if (IN(k)) { PHASE_ENTER(); convert_mix_weights(A, scr, gw, NGW, lane); convert_ffn_weights(A, 0, scr, gw, NGW, lane); init_rows(A, gw, NGW, lane); }
    SEAM(k); ++k;
    for (int l = 0; l < DEPTH; ++l) {
        if (IN(k)) { PHASE_ENTER(); unsigned char* wsb = gptr(A.ws); skinny_gemm<0>((const bf16*)(wsb + WS_U) + (size_t)MR * DM, (const bf16*)(wsb + WS_WIN) + (size_t)l * DIN * DM, DIN, DM, (void*)(wsb + WS_PROJ), DIN, lds, lane, wave);
            pg8::Gemm g{(const bf16*)(wsb + WS_U), (const bf16*)(wsb + WS_WIN) + (size_t)l * DIN * DM, MR, DIN, DM}; pg8::StaticOrder S; S.init(MR, DIN, G, (int)blockIdx.x);
            pg8::EpiBf16<0> E{(bf16*)(wsb + WS_PROJ), DIN, nullptr, 1024, 1024, 0.125f};
            pg8::gemm_phase<pg8::EpiBf16<0>, pg8::StaticOrder, PG8_ALIGN, PG8_SP2>(lds, g, S, E); }
        SEAM(k); ++k;
        for (int rep = 0; rep < ((PROBE_DUP & 2) ? 2 : 1); ++rep) if (IN(k)) { PHASE_ENTER(); mixer_phase(A, l, lds, tid, wave); }
        SEAM(k); ++k;
        if (IN(k)) { PHASE_ENTER(); unsigned char* wsb = gptr(A.ws); skinny_gemm<1>((const bf16*)(wsb + WS_MERGED) + (size_t)MR * DM, (const bf16*)(wsb + WS_WOUT) + (size_t)l * DM * DM, DM, DM, (void*)(wsb + WS_OUT), DM, lds, lane, wave);
            pg8::Gemm g{(const bf16*)(wsb + WS_MERGED), (const bf16*)(wsb + WS_WOUT) + (size_t)l * DM * DM, MR, DM, DM}; pg8::StaticOrder S; S.init(MR, DM, G, (int)blockIdx.x);
            pg8::EpiF32 E{(float*)(wsb + WS_OUT), DM};
            pg8::gemm_phase<pg8::EpiF32, pg8::StaticOrder, PG8_ALIGN, PG8_SP2>(lds, g, S, E); }
        SEAM(k); ++k;
        if (IN(k)) { PHASE_ENTER(); row_phase(A, A.post_mix_g + (size_t)l * DM, A.pre_ffn_g + (size_t)l * DM, nullptr, gw, NGW, lane); }
        SEAM(k); ++k;
        if (IN(k)) { PHASE_ENTER(); unsigned char* wsb = gptr(A.ws); skinny_gemm<2>((const bf16*)(wsb + WS_U) + (size_t)MR * DM, (const bf16*)(wsb + WS_WGU), 2 * DFF, DM, (void*)(wsb + WS_ACT), DFF, lds, lane, wave);
            pg8::Gemm g{(const bf16*)(wsb + WS_U), (const bf16*)(wsb + WS_WGU), MR, 2 * DFF, DM}; pg8::StaticOrder S; S.init(MR, 2 * DFF, G, (int)blockIdx.x);
            pg8::EpiSwiGLU E{(bf16*)(wsb + WS_ACT), DFF};
            pg8::gemm_phase<pg8::EpiSwiGLU, pg8::StaticOrder, PG8_ALIGN, PG8_SP2>(lds, g, S, E); }
        SEAM(k); ++k;
        if (IN(k)) { PHASE_ENTER(); unsigned char* wsb = gptr(A.ws); skinny_gemm<1>((const bf16*)(wsb + WS_ACT) + (size_t)MR * DFF, (const bf16*)(wsb + WS_WD), DM, DFF, (void*)(wsb + WS_OUT), DM, lds, lane, wave);
            pg8::Gemm g{(const bf16*)(wsb + WS_ACT), (const bf16*)(wsb + WS_WD), MR, DM, DFF}; pg8::StaticOrder S; S.init(MR, DM, G, (int)blockIdx.x);
            pg8::EpiF32 E{(float*)(wsb + WS_OUT), DM};
            pg8::gemm_phase<pg8::EpiF32, pg8::StaticOrder, PG8_ALIGN, PG8_SP2>(lds, g, S, E); }
        SEAM(k); ++k;
        if (IN(k)) { PHASE_ENTER();
            if (l + 1 < DEPTH) { convert_ffn_weights(A, l + 1, scr, gw, NGW, lane); row_phase(A, A.post_ffn_g + (size_t)l * DM, A.pre_mix_g + (size_t)(l + 1) * DM, nullptr, gw, NGW, lane); }
            else row_phase(A, A.post_ffn_g + (size_t)l * DM, nullptr, A.out, gw, NGW, lane);
        }
        if (l + 1 < DEPTH) { SEAM(k); } ++k;
    }
#undef IN
#undef SEAM
}

extern "C" void kernel_launch(void* const* d_in, const int* in_sizes, int n_in, void* d_out, int out_size, void* d_ws, size_t ws_size, hipStream_t stream) {
    static int grid = 0;
    if (grid == 0) {
        if (n_in != 19 || in_sizes[0] != MR * DM || out_size != MR * DM || ws_size < WS_END) { fprintf(stderr, "kernel_launch: unexpected problem (n_in %d, in0 %d, out %d, ws %zu, need %zu)\n", n_in, n_in > 0 ? in_sizes[0] : -1, out_size, ws_size, (size_t)WS_END); grid = -1; return; }
        int dev = 0, cus = 0, per_cu = 0;
        if (hipGetDevice(&dev) != hipSuccess || hipDeviceGetAttribute(&cus, hipDeviceAttributeMultiprocessorCount, dev) != hipSuccess) { grid = -1; return; }
        if (hipFuncSetAttribute((const void*)fwd_megakernel, hipFuncAttributeMaxDynamicSharedMemorySize, LDS_BYTES) != hipSuccess) { fprintf(stderr, "kernel_launch: hipFuncSetAttribute failed\n"); grid = -1; return; }
        if (hipOccupancyMaxActiveBlocksPerMultiprocessor(&per_cu, (const void*)fwd_megakernel, 512, LDS_BYTES) != hipSuccess || per_cu < 1) { fprintf(stderr, "kernel_launch: occupancy query says %d blocks per CU\n", per_cu); per_cu = 1; }
        (void)hipGetLastError();
        grid = cus;
    }
    if (grid < 0) return;
    Args a{};
    const float** ap = (const float**)&a;
    for (int i = 0; i < 19; ++i) ap[i] = (const float*)d_in[i];
    a.out = (float*)d_out; a.ws = (unsigned char*)d_ws;
#if MK_SPLIT
    for (int ph = 0; ph < NPHASE; ++ph) { a.ph_lo = ph; a.ph_hi = ph + 1; hipLaunchKernelGGL(fwd_megakernel, dim3(grid), dim3(512), LDS_BYTES, stream, a); }
#else
    a.ph_lo = 0; a.ph_hi = NPHASE;
    void* kargs[] = {(void*)&a};
    const hipError_t e = hipLaunchCooperativeKernel((const void*)fwd_megakernel, dim3(grid), dim3(512), kargs, LDS_BYTES, stream);
    if (e != hipSuccess) fprintf(stderr, "kernel_launch: cooperative launch failed: %s (grid %d)\n", hipGetErrorString(e), grid);
#endif
}
```

```cpp
#include <hip/hip_runtime.h>
#include <hip/hip_cooperative_groups.h>
#include <cstdio>
#include <cstdint>
namespace cg = cooperative_groups;
namespace pg8 {
#define PG8_LAS __attribute__((address_space(3)))
typedef unsigned short bf16_t;
typedef short bf16x8 __attribute__((ext_vector_type(8)));
typedef float f32x4 __attribute__((ext_vector_type(4)));
typedef unsigned u32x4 __attribute__((ext_vector_type(4)));
constexpr int BM = 256, BK = 64, HALF = 128, HTB = HALF * BK * 2  , STAGE_BYTES = 8 * HTB, NXCD = 8, WGM = 8;

__host__ __device__ __forceinline__ int lds_byte(int r, int c) { const int st = (r >> 4) * 2 + (c >> 5), rr = r & 15, cc = c & 31, ob = rr * 64 + cc * 2; return st * 1024 + (ob ^ (((ob >> 9) & 1) << 5)); }
__host__ __device__ __forceinline__ void stage_rc(int b, int& R, int& C) { const int st = b / 1024, sb = b % 1024, swz = sb ^ (((sb >> 9) & 1) << 5); R = (st >> 1) * 16 + swz / 64; C = (st & 1) * 32 + (swz % 64) / 2; }
__host__ __device__ __forceinline__ int perm32(int rho) { const int n = rho >> 4, i = rho & 15; return 8 * (i >> 2) + 4 * n + (i & 3); }

struct Unit { int pm, pn; };
struct Gemm { const bf16_t* A; const bf16_t* Bt; int M, N, K; };

struct StaticOrder {
    int nM, nN, nwg, G, c;
    __host__ __device__ void init(int M, int N, int G_, int c_) { nM = M / BM; nN = N / BM; nwg = nM * nN; G = G_; c = c_; }
    __host__ __device__ bool next(int i, Unit& u) const {
        const long L = (long)i * G + c; if (L >= nwg) return false;
        int wgid = (int)L; { const int q = nwg / NXCD, r = nwg % NXCD, xcd = wgid % NXCD, off = wgid / NXCD; wgid = (xcd < r ? xcd * (q + 1) : r * (q + 1) + (xcd - r) * q) + off; }
        const int nig = WGM * nN, gid = wgid / nig, fm = gid * WGM, gsz = (nM - fm) < WGM ? (nM - fm) : WGM;
        u.pm = fm + ((wgid % nig) % gsz); u.pn = (wgid % nig) / gsz; return true;
    }
    __device__ __forceinline__ void a_ready(const Unit&) const {}
    __device__ __forceinline__ void done(const Unit&) const {}
};

__device__ __forceinline__ unsigned cvt_pk_bf16(float lo, float hi) { unsigned r; asm volatile("v_cvt_pk_bf16_f32 %0, %1, %2" : "=v"(r) : "v"(lo), "v"(hi)); return r; }
typedef float f32x2 __attribute__((ext_vector_type(2)));
__device__ __forceinline__ f32x2 gelu_pk(f32x2 v) {
    const f32x2 av = __builtin_elementwise_abs(v), d = av * 0.2316418882f + 1.0f;
    f32x2 t; t.x = __builtin_amdgcn_rcpf(d.x); t.y = __builtin_amdgcn_rcpf(d.y);
    f32x2 q = t * 0.5307027145f + (-0.7265760135f); q = q * t + 0.7107068705f; q = q * t + (-0.142248368f); q = q * t + 0.127414796f; q = q * t;
    const f32x2 s = (v * v) * (-0.72134752044f);
    f32x2 e; e.x = __builtin_amdgcn_exp2f(s.x); e.y = __builtin_amdgcn_exp2f(s.y);
    const f32x2 m = v * (q * e), r = v - m;
    f32x2 o; o.x = v.x < 0.f ? m.x : r.x; o.y = v.y < 0.f ? m.y : r.y; return o;
}

template <int ACT  > struct EpiBf16 {
    static constexpr bool PERM = true, AFTER_DRAIN = false; static_assert(ACT == 0 || ACT == 1, "EpiBf16: ACT is 0 (none) or 1 (gelu_pk)");
    bf16_t* O; int ldc; const float* bias; int split_cols; size_t split_stride; float scale0;
    __device__ __forceinline__ void operator()(const f32x4 (&acc)[2][2][4][2], const Unit& u, int wr, int wc, int fr, int fq) const {
        const int row0 = u.pm * BM + wr * 64 + fr; int colt = u.pn * BM; bf16_t* base = O;
        float sc = 1.f; if (split_cols) { const int t = colt / split_cols; base += (size_t)t * split_stride; colt -= t * split_cols; if (t == 0) sc = scale0; }
        const int col0 = colt + wc * 32 + 8 * fq, bcol0 = u.pn * BM + wc * 32 + 8 * fq;
        f32x4 bv[2][2];
#pragma unroll
        for (int bj = 0; bj < 2; ++bj)
#pragma unroll
            for (int n = 0; n < 2; ++n) bv[bj][n] = bias ? *(const f32x4*)(bias + bcol0 + bj * HALF + 4 * n) : (f32x4){0.f, 0.f, 0.f, 0.f};
#pragma unroll
        for (int ai = 0; ai < 2; ++ai)
#pragma unroll
            for (int m = 0; m < 4; ++m) { bf16_t* rowp = base + (size_t)(row0 + ai * HALF + m * 16) * ldc + col0;
#pragma unroll
                for (int bj = 0; bj < 2; ++bj) { f32x4 v0 = acc[ai][bj][m][0] + bv[bj][0], v1 = acc[ai][bj][m][1] + bv[bj][1];
                    if (ACT == 1) { f32x2 a = gelu_pk((f32x2){v0[0], v0[1]}), b = gelu_pk((f32x2){v0[2], v0[3]}), c = gelu_pk((f32x2){v1[0], v1[1]}), d = gelu_pk((f32x2){v1[2], v1[3]});
                        v0 = (f32x4){a.x, a.y, b.x, b.y}; v1 = (f32x4){c.x, c.y, d.x, d.y}; }
                    v0 = v0 * sc; v1 = v1 * sc; u32x4 w; w.x = cvt_pk_bf16(v0[0], v0[1]); w.y = cvt_pk_bf16(v0[2], v0[3]); w.z = cvt_pk_bf16(v1[0], v1[1]); w.w = cvt_pk_bf16(v1[2], v1[3]);
                    *(u32x4*)(rowp + bj * HALF) = w; } }
    }
};
__device__ __forceinline__ unsigned cvtpk_rne(float lo, float hi) { typedef float f32x2_t __attribute__((ext_vector_type(2))); typedef __bf16 bf16x2_t __attribute__((ext_vector_type(2)));
    f32x2_t v = {lo, hi}; bf16x2_t b = __builtin_convertvector(v, bf16x2_t); return __builtin_bit_cast(unsigned, b); }
struct EpiF32 {
    static constexpr bool PERM = false, AFTER_DRAIN = false;
    float* O; int ldc;
    __device__ __forceinline__ void operator()(const f32x4 (&acc)[2][2][4][2], const Unit& u, int wr, int wc, int fr, int fq) const {
        const int row0 = u.pm * BM + wr * 64 + fr, col0 = u.pn * BM + wc * 32 + 4 * fq;
#pragma unroll
        for (int ai = 0; ai < 2; ++ai)
#pragma unroll
            for (int m = 0; m < 4; ++m) { float* rowp = O + (size_t)(row0 + ai * HALF + m * 16) * ldc + col0;
#pragma unroll
                for (int bj = 0; bj < 2; ++bj)
#pragma unroll
                    for (int n = 0; n < 2; ++n) *(f32x4*)(rowp + bj * HALF + n * 16) = acc[ai][bj][m][n]; }
    }
};
struct EpiSwiGLU {
    static constexpr bool PERM = true, AFTER_DRAIN = false;
    bf16_t* O; int ldc;
    __device__ __forceinline__ void operator()(const f32x4 (&acc)[2][2][4][2], const Unit& u, int wr, int wc, int fr, int fq) const {
        typedef unsigned u32x2 __attribute__((ext_vector_type(2)));
        const int row0 = u.pm * BM + wr * 64 + fr, col0 = u.pn * (BM / 2) + wc * 16 + 4 * fq;
#pragma unroll
        for (int ai = 0; ai < 2; ++ai)
#pragma unroll
            for (int m = 0; m < 4; ++m) { bf16_t* rowp = O + (size_t)(row0 + ai * HALF + m * 16) * ldc + col0;
#pragma unroll
                for (int bj = 0; bj < 2; ++bj) { const f32x4 g = acc[ai][bj][m][0], up = acc[ai][bj][m][1]; float a[4];
#pragma unroll
                    for (int e = 0; e < 4; ++e) a[e] = g[e] * __builtin_amdgcn_rcpf(1.0f + __builtin_amdgcn_exp2f(-1.4426950408889634f * g[e])) * up[e];
                    u32x2 w; w.x = cvtpk_rne(a[0], a[1]); w.y = cvtpk_rne(a[2], a[3]); *(u32x2*)(rowp + bj * (HALF / 2)) = w; } }
    }
};

template <class Epi, class Sched, bool ALIGN_EPI = false, bool SP2 = false>
__device__ __forceinline__ void gemm_phase(PG8_LAS unsigned char* lds, const Gemm g, const Sched& S, const Epi& E) {
    int tid_ = threadIdx.x; asm volatile("" : "+v"(tid_));
    const int tid = tid_, wid = __builtin_amdgcn_readfirstlane(tid >> 6), lane = tid & 63, wr = wid >> 2, wc = wid & 3, fr = lane & 15, fq = lane >> 4;
    const int K = g.K, nt = K / BK;
    unsigned voffA[2], voffB[2];
#pragma unroll
    for (int i = 0; i < 2; ++i) { int R, C; stage_rc(tid * 16 + i * 8192, R, C); const int Rb = Epi::PERM ? ((R & ~31) + perm32(R & 31)) : R;
        voffA[i] = (unsigned)(R * K + C) * 2u; voffB[i] = (unsigned)(Rb * K + C) * 2u; }
    const size_t kstep = (size_t)(BK * 2);
    const size_t hstep = (size_t)HALF * K * 2;
    const size_t tstep = 2 * hstep;
    const unsigned ldsw = (unsigned)wid * 1024u;
    const int aoff = lds_byte(wr * 64 + fr, fq * 8), boff = lds_byte(wc * 32 + fr, fq * 8);
#define PG8_SA(b, h) (((b) * 2 + (h)) * HTB)
#define PG8_SB(b, h) ((4 + (b) * 2 + (h)) * HTB)
#define PG8_STAGE(bufoff, gbase, voff) do { _Pragma("unroll") for (int _i = 0; _i < 2; ++_i) \
        __builtin_amdgcn_global_load_lds((const unsigned*)((const char*)(gbase) + (voff)[_i]), (PG8_LAS unsigned*)(lds + (bufoff) + ldsw + _i * 8192), 16, 0, 0); } while (0)
#define PG8_LDA(dst, b, h) do { _Pragma("unroll") for (int m = 0; m < 4; ++m) _Pragma("unroll") for (int k = 0; k < 2; ++k) dst[m][k] = *(const PG8_LAS bf16x8*)(lds + PG8_SA(b, h) + aoff + m * 2048 + k * 1024); } while (0)
#define PG8_LDB(dst, b, h) do { _Pragma("unroll") for (int n = 0; n < 2; ++n) _Pragma("unroll") for (int k = 0; k < 2; ++k) dst[n][k] = *(const PG8_LAS bf16x8*)(lds + PG8_SB(b, h) + boff + n * 2048 + k * 1024); } while (0)
#define PG8_MMA(ai, bj, At, Bt) do { __builtin_amdgcn_s_setprio(1); _Pragma("unroll") for (int m = 0; m < 4; ++m) _Pragma("unroll") for (int n = 0; n < 2; ++n) _Pragma("unroll") for (int k = 0; k < 2; ++k) \
        acc[ai][bj][m][n] = __builtin_amdgcn_mfma_f32_16x16x32_bf16(Bt[n][k], At[m][k], acc[ai][bj][m][n], 0, 0, 0); __builtin_amdgcn_s_setprio(0); } while (0)
#define PG8_WAIT_V(n) asm volatile("s_waitcnt vmcnt(" #n ")" ::: "memory")
#define PG8_WAIT_L(n) asm volatile("s_waitcnt lgkmcnt(" #n ")" ::: "memory")
#define PG8_BAR __builtin_amdgcn_s_barrier()
#define PG8_SCHED __builtin_amdgcn_sched_barrier(0)
    Unit cur, nxt; int ui = 0;
    if (!S.next(0, cur)) return;
    f32x4 acc[2][2][4][2];
#pragma unroll
    for (int a = 0; a < 2; ++a)
#pragma unroll
        for (int b = 0; b < 2; ++b)
#pragma unroll
            for (int m = 0; m < 4; ++m)
#pragma unroll
                for (int n = 0; n < 2; ++n) acc[a][b][m][n] = (f32x4){0.f, 0.f, 0.f, 0.f};
    bf16x8 At[4][2], B0[2][2], B1[2][2];
    const char* cA = (const char*)g.A + (size_t)cur.pm * tstep; const char* cB = (const char*)g.Bt + (size_t)cur.pn * tstep;
    S.a_ready(cur);
    if constexpr (SP2) {
        PG8_STAGE(PG8_SB(0, 0), cB, voffB); PG8_STAGE(PG8_SB(0, 1), cB + hstep, voffB); PG8_STAGE(PG8_SA(0, 0), cA, voffA); PG8_STAGE(PG8_SA(0, 1), cA + hstep, voffA);
        if (wr == 1) PG8_BAR;
        PG8_WAIT_V(2); PG8_BAR;
        PG8_STAGE(PG8_SB(1, 0), cB + kstep, voffB); PG8_STAGE(PG8_SA(1, 0), cA + kstep, voffA); PG8_STAGE(PG8_SB(1, 1), cB + hstep + kstep, voffB);
        PG8_WAIT_V(6); PG8_BAR;
    } else {
        PG8_STAGE(PG8_SB(0, 0), cB, voffB); PG8_STAGE(PG8_SA(0, 0), cA, voffA); PG8_STAGE(PG8_SB(0, 1), cB + hstep, voffB); PG8_STAGE(PG8_SA(0, 1), cA + hstep, voffA);
        if (wr == 1) PG8_BAR;
        PG8_WAIT_V(4); PG8_BAR;
        PG8_STAGE(PG8_SB(1, 0), cB + kstep, voffB); PG8_STAGE(PG8_SA(1, 0), cA + kstep, voffA); PG8_STAGE(PG8_SB(1, 1), cB + hstep + kstep, voffB);
        PG8_WAIT_V(6); PG8_BAR;
    }
    for (;;) {
        const bool has_next = S.next(ui + 1, nxt);
        const char* nA = has_next ? (const char*)g.A + (size_t)nxt.pm * tstep : cA; const char* nB = has_next ? (const char*)g.Bt + (size_t)nxt.pn * tstep : cB;
        for (int t = 0; t < nt; t += 2) {
            const bool last = (t == nt - 2);
            const char* a1 = cA + (size_t)(t + 1) * kstep;
            const char* a2 = last ? nA : cA + (size_t)(t + 2) * kstep; const char* b2 = last ? nB : cB + (size_t)(t + 2) * kstep;
            const char* a3 = a2 + kstep; const char* b3 = b2 + kstep;
            if (last && has_next) S.a_ready(nxt);
            if constexpr (SP2) {
            PG8_LDB(B0, 0, 0); PG8_LDB(B1, 0, 1); PG8_SCHED; PG8_LDA(At, 0, 0); PG8_STAGE(PG8_SA(1, 1), a1 + hstep, voffA);
            PG8_WAIT_V(8); PG8_WAIT_L(0); PG8_BAR; PG8_MMA(0, 0, At, B0); PG8_MMA(0, 1, At, B1); PG8_BAR; PG8_SCHED;
            PG8_LDA(At, 0, 1); PG8_STAGE(PG8_SB(0, 0), b2, voffB); PG8_STAGE(PG8_SB(0, 1), b2 + hstep, voffB); PG8_STAGE(PG8_SA(0, 0), a2, voffA);
            PG8_WAIT_V(8); PG8_WAIT_L(0); PG8_BAR; PG8_MMA(1, 0, At, B0); PG8_MMA(1, 1, At, B1); PG8_BAR; PG8_SCHED;
            PG8_LDB(B0, 1, 0); PG8_LDB(B1, 1, 1); PG8_SCHED; PG8_LDA(At, 1, 0); PG8_STAGE(PG8_SA(0, 1), a2 + hstep, voffA);
            PG8_WAIT_V(8); PG8_WAIT_L(0); PG8_BAR; PG8_MMA(0, 0, At, B0); PG8_MMA(0, 1, At, B1); PG8_BAR; PG8_SCHED;
            PG8_LDA(At, 1, 1); PG8_STAGE(PG8_SB(1, 0), b3, voffB); PG8_STAGE(PG8_SB(1, 1), b3 + hstep, voffB); PG8_STAGE(PG8_SA(1, 0), a3, voffA);
            PG8_WAIT_V(8); PG8_WAIT_L(0); PG8_BAR; PG8_MMA(1, 0, At, B0); PG8_MMA(1, 1, At, B1); PG8_BAR; PG8_SCHED;
            } else {
            PG8_LDB(B0, 0, 0); PG8_SCHED; PG8_LDA(At, 0, 0); PG8_STAGE(PG8_SA(1, 1), a1 + hstep, voffA);
            PG8_WAIT_L(8); PG8_BAR; PG8_WAIT_L(0); PG8_MMA(0, 0, At, B0); PG8_BAR; PG8_SCHED;
            PG8_LDB(B1, 0, 1); PG8_STAGE(PG8_SB(0, 0), b2, voffB);
            PG8_BAR; PG8_WAIT_L(0); PG8_MMA(0, 1, At, B1); PG8_BAR;
            PG8_LDA(At, 0, 1); PG8_STAGE(PG8_SA(0, 0), a2, voffA);
            PG8_BAR; PG8_WAIT_L(0); PG8_MMA(1, 0, At, B0); PG8_BAR; PG8_SCHED;
            PG8_STAGE(PG8_SB(0, 1), b2 + hstep, voffB);
            PG8_WAIT_V(6); PG8_BAR; PG8_MMA(1, 1, At, B1); PG8_BAR;
            PG8_LDB(B0, 1, 0); PG8_SCHED; PG8_LDA(At, 1, 0); PG8_STAGE(PG8_SA(0, 1), a2 + hstep, voffA);
            PG8_WAIT_L(8); PG8_BAR; PG8_WAIT_L(0); PG8_MMA(0, 0, At, B0); PG8_BAR; PG8_SCHED;
            PG8_LDB(B1, 1, 1); PG8_STAGE(PG8_SB(1, 0), b3, voffB);
            PG8_BAR; PG8_WAIT_L(0); PG8_MMA(0, 1, At, B1); PG8_BAR;
            PG8_LDA(At, 1, 1); PG8_STAGE(PG8_SA(1, 0), a3, voffA);
            PG8_BAR; PG8_WAIT_L(0); PG8_MMA(1, 0, At, B0); PG8_BAR; PG8_SCHED;
            PG8_STAGE(PG8_SB(1, 1), b3 + hstep, voffB);
            PG8_WAIT_V(6); PG8_BAR; PG8_MMA(1, 1, At, B1); PG8_BAR;
            }
        }
        if constexpr (ALIGN_EPI) { if (wr == 0) PG8_BAR; }
        if constexpr (!Epi::AFTER_DRAIN) { E(acc, cur, wr, wc, fr, fq); S.done(cur); }
        if (!has_next) break;
#pragma unroll
        for (int a = 0; a < 2; ++a)
#pragma unroll
            for (int b = 0; b < 2; ++b)
#pragma unroll
                for (int m = 0; m < 4; ++m)
#pragma unroll
                    for (int n = 0; n < 2; ++n) acc[a][b][m][n] = (f32x4){0.f, 0.f, 0.f, 0.f};
        cur = nxt; cA = nA; cB = nB; ++ui;
        if constexpr (ALIGN_EPI) { if (wr == 1) PG8_BAR; }
    }
    PG8_WAIT_V(0);
    if constexpr (!ALIGN_EPI) { if (wr == 0) PG8_BAR; }
    PG8_BAR;
    if constexpr (Epi::AFTER_DRAIN) { E.fused(acc, cur, wr, wc, fr, fq, lds, wid, lane); S.done(cur); }
#undef PG8_SA
#undef PG8_SB
#undef PG8_STAGE
#undef PG8_LDA
#undef PG8_LDB
#undef PG8_MMA
#undef PG8_WAIT_V
#undef PG8_WAIT_L
#undef PG8_BAR
#undef PG8_SCHED
}
}

#ifndef PG8_SP2
#define PG8_SP2 true
#endif
#ifndef PG8_ALIGN
#define PG8_ALIGN true
#endif
#ifndef PROBE_DUP
#define PROBE_DUP 0
#endif
#ifndef MK_SPLIT
#define MK_SPLIT 0
#endif

constexpr int NB = 2, SEQ = 4096, DM = 2048, NMETA = 16, LSEQ = SEQ + NMETA, DEPTH = 2;
constexpr int MR = NB * SEQ;
constexpr int MV = MR + NMETA;
constexpr int MP = 33 * 256;
constexpr int DIN = 4608, DFF = 5632, DATT = 1024, DPOOL = 512, DCONV = 512, NHEAD = 16;
constexpr int C_K = 1024, C_V = 2048, C_POOL = 3072, C_CA = 3584, C_CG = 4096;
constexpr float EPS = 1e-6f, LOG2E = 1.4426950408889634f, LN2 = 0.6931471805599453f;
constexpr float SB_EXIT = -110.0f;

constexpr size_t MiB = 1u << 20;
constexpr size_t WS_WIN = 0;
constexpr size_t WS_WOUT = WS_WIN + 36 * MiB;
constexpr size_t WS_WGU = WS_WOUT + 16 * MiB;
constexpr size_t WS_WD = WS_WGU + 44 * MiB;
constexpr size_t WS_WSM = WS_WD + 22 * MiB;
constexpr size_t WS_H = WS_WSM + 2 * MiB;
constexpr size_t WS_U = WS_H + 66 * MiB;
constexpr size_t WS_OUT = WS_U + 33 * MiB;
constexpr size_t WS_PROJ = WS_OUT + 66 * MiB;
constexpr size_t WS_MERGED = WS_PROJ + (size_t)MP * DIN * 2;
constexpr size_t WS_ACT = WS_PROJ;
constexpr size_t WS_CTL = WS_MERGED + 33 * MiB;
constexpr size_t CTL_BYTES = 65536;
constexpr size_t WS_END = WS_CTL + 1 * MiB;
static_assert((size_t)MP * DFF * 2 <= WS_END - WS_PROJ, "act overlay");

constexpr int LDS_BYTES = 147456;

#define GAS __attribute__((address_space(1)))
#define LAS __attribute__((address_space(3)))
typedef unsigned short bf16;
typedef unsigned v4u __attribute__((ext_vector_type(4)));
typedef unsigned v2u __attribute__((ext_vector_type(2)));
typedef float f32x4 __attribute__((ext_vector_type(4)));
typedef short bf16x8 __attribute__((ext_vector_type(8)));
typedef short v4i16_t __attribute__((ext_vector_type(4)));
#define LDS_WAIT() asm volatile("s_waitcnt lgkmcnt(0)" ::: "memory")

__device__ __forceinline__ unsigned cvtpk(float lo, float hi) { return pg8::cvtpk_rne(lo, hi); }
__device__ __forceinline__ float bflo(unsigned u) { return __uint_as_float(u << 16); }
__device__ __forceinline__ float bfhi(unsigned u) { return __uint_as_float(u & 0xffff0000u); }
__device__ __forceinline__ float bf2f(bf16 v) { return __uint_as_float((unsigned)v << 16); }
__device__ __forceinline__ float wave_sum(float v) {
#pragma unroll
    for (int o = 1; o < 64; o <<= 1) v += __shfl_xor(v, o);
    return v;
}
__device__ __forceinline__ float sigmoidf_(float x) { return __builtin_amdgcn_rcpf(1.0f + __builtin_amdgcn_exp2f(-LOG2E * x)); }
template <class T> __device__ __forceinline__ T* gptr(T* p) { GAS T* g = (GAS T*)p; asm volatile("" : "+s"(g)); return (T*)g; }
__device__ __forceinline__ int rowidx(int b, int pos) { return pos < NMETA ? MR + pos : b * SEQ + pos - NMETA; }
__device__ __forceinline__ f32x4 mfma16(bf16x8 a, bf16x8 b, f32x4 c) { return __builtin_amdgcn_mfma_f32_16x16x32_bf16(a, b, c, 0, 0, 0); }

struct Args {
    const float *x, *meta, *pre_mix_g, *w_in, *w_pool, *pool_scale, *w_dw, *b_dw, *conv_ln_g, *conv_ln_b, *w_pw, *mix_out_g, *w_out, *post_mix_g, *pre_ffn_g, *w_gate, *w_up, *w_down, *post_ffn_g;
    float* out; unsigned char* ws; int ph_lo, ph_hi;
};

__device__ __forceinline__ void transpose_item(const float* __restrict__ W, int K, int N, bf16* WT, int mode, LAS float* scr, int item, int lane) {
    W = gptr(W); WT = gptr(WT);
    const int nblk = N >> 6, kb = item / nblk, nb = item - kb * nblk, k0 = kb << 6, n0 = nb << 6;
    const int r4 = lane >> 4, c4 = (lane & 15) * 4;
#pragma unroll 4
    for (int i = 0; i < 16; ++i) { const int kk = 4 * i + r4; const f32x4 v = *(const f32x4*)(W + (size_t)(k0 + kk) * N + n0 + c4);
        LAS float* s = scr + kk * 65 + c4; s[0] = v.x; s[1] = v.y; s[2] = v.z; s[3] = v.w; }
    LDS_WAIT();
    const int c = lane & 7;
#pragma unroll
    for (int j = 0; j < 8; ++j) { const int n = (lane >> 3) + 8 * j; const LAS float* s = scr + (8 * c) * 65 + n;
        v4u o; o.x = cvtpk(s[0 * 65], s[1 * 65]); o.y = cvtpk(s[2 * 65], s[3 * 65]); o.z = cvtpk(s[4 * 65], s[5 * 65]); o.w = cvtpk(s[6 * 65], s[7 * 65]);
        const int ng = n0 + n; const int R = mode == 0 ? ng : ((ng >> 2) * 8 + (ng & 3) + (mode == 2 ? 4 : 0));
        *(v4u*)(WT + (size_t)R * K + k0 + 8 * c) = o; }
    LDS_WAIT();
}
#define TJOB(Wp, Kk, Nn, WTp, mode) { const int ni_ = ((Kk) / 64) * ((Nn) / 64); if (r < ni_) { transpose_item((Wp), (Kk), (Nn), (WTp), (mode), scr, r, lane); continue; } r -= ni_; }

__device__ __forceinline__ void convert_ffn_weights(const Args& A, int l, LAS float* scr, int gw, int NGW, int lane) {
    bf16* wgu = (bf16*)(A.ws + WS_WGU); bf16* wd = (bf16*)(A.ws + WS_WD);
    constexpr int NI = 3 * (DM / 64) * (DFF / 64);
    for (int it = gw; it < NI; it += NGW) { int r = it;
        TJOB(A.w_gate + (size_t)l * DM * DFF, DM, DFF, wgu, 1)
        TJOB(A.w_up + (size_t)l * DM * DFF, DM, DFF, wgu, 2)
        TJOB(A.w_down + (size_t)l * DFF * DM, DFF, DM, wd, 0)
    }
}
__device__ __forceinline__ void convert_mix_weights(const Args& A, LAS float* scr, int gw, int NGW, int lane) {
    constexpr int I_IN = (DM / 64) * (DIN / 64), I_OUT = (DM / 64) * (DM / 64), I_PW = 64, I_POOL = 16, NL = I_IN + I_OUT + I_PW + I_POOL;
    for (int it = gw; it < DEPTH * NL; it += NGW) { const int l = it / NL; int r = it - l * NL;
        if (r < I_IN) { transpose_item(A.w_in + (size_t)l * DM * DIN, DM, DIN, (bf16*)(A.ws + WS_WIN) + (size_t)l * DIN * DM, 0, scr, r, lane); continue; } r -= I_IN;
        if (r < I_OUT) { transpose_item(A.w_out + (size_t)l * DM * DM, DM, DM, (bf16*)(A.ws + WS_WOUT) + (size_t)l * DM * DM, 0, scr, r, lane); continue; } r -= I_OUT;
        if (r < I_PW) { transpose_item(A.w_pw + (size_t)l * 512 * 512, 512, 512, (bf16*)(A.ws + WS_WSM + 256 * 1024) + (size_t)l * 512 * 512, 0, scr, r, lane); continue; } r -= I_PW;
        { const int g = r >> 2; transpose_item(A.w_pool + (size_t)(l * 4 + g) * 128 * 128, 128, 128, (bf16*)(A.ws + WS_WSM) + (size_t)(l * 4 + g) * 128 * 128, 0, scr, r & 3, lane); }
    }
}

__device__ __forceinline__ float dot4(f32x4 a) { return (a.x * a.x + a.y * a.y) + (a.z * a.z + a.w * a.w); }
__device__ __forceinline__ void store_u_row(bf16* urow, const f32x4 (&hv)[8], float r, const float* g, int lane) {
#pragma unroll
    for (int j = 0; j < 8; ++j) { const f32x4 gv = ((const f32x4*)g)[lane + 64 * j]; v2u w; w.x = cvtpk(hv[j].x * r * gv.x, hv[j].y * r * gv.y); w.y = cvtpk(hv[j].z * r * gv.z, hv[j].w * r * gv.w);
        ((v2u*)urow)[lane + 64 * j] = w; }
}
__device__ __forceinline__ void init_rows(const Args& A, int gw, int NGW, int lane) {
    unsigned char* wsb = gptr(A.ws); float* h = (float*)(wsb + WS_H); bf16* u = (bf16*)(wsb + WS_U); const float* pg = gptr(A.pre_mix_g);
    for (int m = gw; m < MV; m += NGW) {
        const float* src = m < MR ? gptr(A.x) + (size_t)m * DM : gptr(A.meta) + (size_t)(m - MR) * DM;
        f32x4 hv[8]; float ss = 0.f;
#pragma unroll
        for (int j = 0; j < 8; ++j) { hv[j] = ((const f32x4*)src)[lane + 64 * j]; ss += dot4(hv[j]); ((f32x4*)(h + (size_t)m * DM))[lane + 64 * j] = hv[j]; }
        const float r = rsqrtf(wave_sum(ss) * (1.0f / DM) + EPS);
        store_u_row(u + (size_t)m * DM, hv, r, pg, lane);
    }
}
__device__ __forceinline__ void row_phase(const Args& A, const float* g1, const float* g2, float* dout, int gw, int NGW, int lane) {
    unsigned char* wsb = gptr(A.ws); float* h = (float*)(wsb + WS_H); bf16* u = (bf16*)(wsb + WS_U); const float* src = (const float*)(wsb + WS_OUT); g1 = gptr(g1); g2 = gptr(g2); dout = gptr(dout);
    for (int m = gw; m < MV; m += NGW) {
        f32x4 o[8], hv[8]; float ss = 0.f;
#pragma unroll
        for (int j = 0; j < 8; ++j) { o[j] = ((const f32x4*)(src + (size_t)m * DM))[lane + 64 * j]; hv[j] = ((const f32x4*)(h + (size_t)m * DM))[lane + 64 * j]; ss += dot4(o[j]); }
        const float r = rsqrtf(wave_sum(ss) * (1.0f / DM) + EPS);
        float ss2 = 0.f;
#pragma unroll
        for (int j = 0; j < 8; ++j) { const f32x4 gv = ((const f32x4*)g1)[lane + 64 * j]; hv[j] = hv[j] + o[j] * r * gv; ss2 += dot4(hv[j]); }
        if (dout) {
            if (m < MR) {
#pragma unroll
                for (int j = 0; j < 8; ++j) ((f32x4*)(dout + (size_t)m * DM))[lane + 64 * j] = hv[j];
            }
        } else {
#pragma unroll
            for (int j = 0; j < 8; ++j) ((f32x4*)(h + (size_t)m * DM))[lane + 64 * j] = hv[j];
            const float r2 = rsqrtf(wave_sum(ss2) * (1.0f / DM) + EPS);
            store_u_row(u + (size_t)m * DM, hv, r2, g2, lane);
        }
    }
}

template <int MODE> __device__ __forceinline__ void skinny_gemm(const bf16* __restrict__ Arows, const bf16* __restrict__ Bt, int N, int K, void* O, int ldc, LAS unsigned char* lds, int lane, int wave) {
    const int li = lane & 15, fq = lane >> 4; const int nks = K >> 5;
    LAS f32x4* part = (LAS f32x4*)lds;
    for (int blk = blockIdx.x; blk < (N >> 4); blk += gridDim.x) {
        const bf16* bp = Bt + (size_t)(blk * 16 + li) * K + 8 * fq; const bf16* ap = Arows + (size_t)li * K + 8 * fq;
        f32x4 acc = (f32x4){0.f, 0.f, 0.f, 0.f};
#pragma unroll 8
        for (int ks = wave; ks < nks; ks += 8) { const bf16x8 wf = *(const bf16x8*)(bp + ks * 32); const bf16x8 af = *(const bf16x8*)(ap + ks * 32); acc = mfma16(wf, af, acc); }
        part[wave * 64 + lane] = acc;
        __syncthreads();
        if (wave == 0) {
            f32x4 v = part[lane];
#pragma unroll
            for (int w8 = 1; w8 < 8; ++w8) v = v + part[w8 * 64 + lane];
            const int n0 = blk * 16 + 4 * fq;
            if (MODE == 0) { const float sc = n0 < 1024 ? 0.125f : 1.0f; v2u w; w.x = cvtpk(v.x * sc, v.y * sc); w.y = cvtpk(v.z * sc, v.w * sc); *(v2u*)((bf16*)O + (size_t)(MR + li) * ldc + n0) = w; }
            else if (MODE == 1) { *(f32x4*)((float*)O + (size_t)(MR + li) * ldc + n0) = v; }
            else { f32x4 up; up.x = __shfl_xor(v.x, 16); up.y = __shfl_xor(v.y, 16); up.z = __shfl_xor(v.z, 16); up.w = __shfl_xor(v.w, 16);
                if ((fq & 1) == 0) { v2u w; w.x = cvtpk(v.x * sigmoidf_(v.x) * up.x, v.y * sigmoidf_(v.y) * up.y); w.y = cvtpk(v.z * sigmoidf_(v.z) * up.z, v.w * sigmoidf_(v.w) * up.w);
                    *(v2u*)((bf16*)O + (size_t)(MR + li) * ldc + blk * 8 + 4 * (fq >> 1)) = w; } }
        }
        __syncthreads();
    }
}

constexpr int VPITCH = 128;
constexpr int ML_V = 0, ML_ST = 8 * 64 * VPITCH  , ML_RED = ML_ST + 65536, ML_Y = 0  , ML_AB = ML_Y + 16 * 516 * 4;
static_assert(ML_RED + 3 * 512 <= LDS_BYTES && ML_AB + 16 * 1040 <= ML_ST, "mixer LDS");

__device__ __forceinline__ float softplus_(float z) { const float t = __builtin_amdgcn_exp2f(-LOG2E * __builtin_fabsf(z)); return __builtin_fmaxf(z, 0.f) + LN2 * __builtin_amdgcn_logf(1.0f + t); }
__device__ __forceinline__ void split_pack(const f32x4& a, const f32x4& b, bf16x8& hi, bf16x8& lo) {
    v4u h, l;
    h.x = cvtpk(a[0], a[1]); h.y = cvtpk(a[2], a[3]); h.z = cvtpk(b[0], b[1]); h.w = cvtpk(b[2], b[3]);
    l.x = cvtpk(a[0] - bflo(h.x), a[1] - bfhi(h.x)); l.y = cvtpk(a[2] - bflo(h.y), a[3] - bfhi(h.y));
    l.z = cvtpk(b[0] - bflo(h.z), b[1] - bfhi(h.z)); l.w = cvtpk(b[2] - bflo(h.w), b[3] - bfhi(h.w));
    hi = __builtin_bit_cast(bf16x8, h); lo = __builtin_bit_cast(bf16x8, l);
}
__device__ __forceinline__ void sb_attention(const bf16* __restrict__ proj, int b, int p0, int hd, LAS unsigned char* vl, int lane, f32x4 (&o)[4]) {
    const int li = lane & 15, fq = lane >> 4;
    const int qpos = p0 + li;
    const bf16* qp = proj + (size_t)rowidx(b, qpos) * DIN + hd * 64 + fq * 8;
    const bf16x8 qf0 = *(const bf16x8*)qp, qf1 = *(const bf16x8*)(qp + 32);
    unsigned d0 = 0u, d1 = 0u;
    { const unsigned one = 0x3F80u; d0 = ((4 * fq + 0 >= li) ? one : 0u) | ((4 * fq + 1 >= li) ? (one << 16) : 0u); d1 = ((4 * fq + 2 >= li) ? one : 0u) | ((4 * fq + 3 >= li) ? (one << 16) : 0u); }
    const unsigned ONE2 = 0x3F803F80u;
    const bf16x8 F_D1 = __builtin_bit_cast(bf16x8, (v4u){d0, d1, ONE2, ONE2});
    const bf16x8 F_11 = __builtin_bit_cast(bf16x8, (v4u){ONE2, ONE2, ONE2, ONE2});
    const bf16x8 F_0D = __builtin_bit_cast(bf16x8, (v4u){0u, 0u, d0, d1});
#pragma unroll
    for (int i = 0; i < 4; ++i) o[i] = (f32x4){0.f, 0.f, 0.f, 0.f};
    float carry = 0.f;
    const int ktd = p0 >> 6;
    const unsigned trbase = (unsigned)((4 * fq + (li >> 2)) * VPITCH + (lane & 3) * 8);
    bf16x8 kf[4][2];
#define SB_LOADK(KT) do { _Pragma("unroll") for (int kb = 0; kb < 4; ++kb) { int kp = 64 * (KT) + 16 * kb + li; kp = kp < LSEQ ? kp : LSEQ - 1; const bf16* kr = proj + (size_t)rowidx(b, kp) * DIN + C_K + hd * 64 + fq * 8; \
        kf[kb][0] = *(const bf16x8*)kr; kf[kb][1] = *(const bf16x8*)(kr + 32); } } while (0)
    SB_LOADK(ktd);
    for (int kt = ktd; kt >= 0; --kt) {
        const bool diag = (kt == ktd);
#pragma unroll
        for (int it = 0; it < 8; ++it) { const int key = it * 8 + (lane >> 3); int kp = 64 * kt + key; kp = kp < LSEQ ? kp : LSEQ - 1;
            __builtin_amdgcn_global_load_lds((const unsigned*)(proj + (size_t)rowidx(b, kp) * DIN + C_V + hd * 64 + (lane & 7) * 8), (LAS unsigned*)(vl + it * 1024), 16, 0, 0); }
        f32x4 s[4], lnb[4];
#pragma unroll
        for (int kb = 0; kb < 4; ++kb) { s[kb] = mfma16(kf[kb][0], qf0, (f32x4){0.f, 0.f, 0.f, 0.f}); s[kb] = mfma16(kf[kb][1], qf1, s[kb]); }
        { const int ktn = kt > 0 ? kt - 1 : 0; SB_LOADK(ktn); }
#pragma unroll
        for (int kb = 0; kb < 4; ++kb)
#pragma unroll
            for (int e = 0; e < 4; ++e) { const bool m = !diag || (64 * kt + 16 * kb + 4 * fq + e < qpos); lnb[kb][e] = m ? -softplus_(s[kb][e]) : 0.f; }
        bf16x8 bh[2], bl[2];
        split_pack(lnb[0], lnb[1], bh[0], bl[0]); split_pack(lnb[2], lnb[3], bh[1], bl[1]);
        f32x4 c[4];
#pragma unroll
        for (int i = 0; i < 4; ++i) c[i] = (f32x4){carry, carry, carry, carry};
        c[0] = mfma16(F_D1, bh[0], c[0]); c[0] = mfma16(F_D1, bl[0], c[0]); c[0] = mfma16(F_11, bh[1], c[0]); c[0] = mfma16(F_11, bl[1], c[0]);
        c[1] = mfma16(F_0D, bh[0], c[1]); c[1] = mfma16(F_0D, bl[0], c[1]); c[1] = mfma16(F_11, bh[1], c[1]); c[1] = mfma16(F_11, bl[1], c[1]);
        c[2] = mfma16(F_D1, bh[1], c[2]); c[2] = mfma16(F_D1, bl[1], c[2]);
        c[3] = mfma16(F_0D, bh[1], c[3]); c[3] = mfma16(F_0D, bl[1], c[3]);
        f32x4 w[4];
#pragma unroll
        for (int kb = 0; kb < 4; ++kb)
#pragma unroll
            for (int e = 0; e < 4; ++e) { const bool m = !diag || (64 * kt + 16 * kb + 4 * fq + e < qpos); w[kb][e] = m ? __builtin_amdgcn_exp2f(LOG2E * (s[kb][e] + c[kb][e])) : 0.f; }
        carry = __shfl(c[0][0], li);
        v4u p0v, p1v;
        p0v.x = cvtpk(w[0][0], w[0][1]); p0v.y = cvtpk(w[0][2], w[0][3]); p0v.z = cvtpk(w[1][0], w[1][1]); p0v.w = cvtpk(w[1][2], w[1][3]);
        p1v.x = cvtpk(w[2][0], w[2][1]); p1v.y = cvtpk(w[2][2], w[2][3]); p1v.z = cvtpk(w[3][0], w[3][1]); p1v.w = cvtpk(w[3][2], w[3][3]);
        const bf16x8 pf0 = __builtin_bit_cast(bf16x8, p0v), pf1 = __builtin_bit_cast(bf16x8, p1v);
        asm volatile("s_waitcnt vmcnt(0)" ::: "memory");
#pragma unroll
        for (int db = 0; db < 4; ++db) {
#pragma unroll
            for (int s2 = 0; s2 < 2; ++s2) {
                const v4i16_t lo = __builtin_amdgcn_ds_read_tr16_b64_v4i16((LAS v4i16_t*)(vl + trbase + (32 * s2) * VPITCH + db * 32));
                const v4i16_t hi = __builtin_amdgcn_ds_read_tr16_b64_v4i16((LAS v4i16_t*)(vl + trbase + (32 * s2 + 16) * VPITCH + db * 32));
                const bf16x8 vf = (bf16x8){lo[0], lo[1], lo[2], lo[3], hi[0], hi[1], hi[2], hi[3]};
                o[db] = mfma16(vf, s2 == 0 ? pf0 : pf1, o[db]);
            }
        }
        if (__all(carry < SB_EXIT)) break;
    }
#undef SB_LOADK
}

template <int W> __device__ __forceinline__ void pool_group(const bf16* __restrict__ psrc, const bf16* __restrict__ wpt, int b, int pos, f32x4 (&pacc)[4]) {
    const int cnt = (pos + 1 < W) ? pos + 1 : W; const float inv = 1.0f / (float)cnt;
    constexpr int BW = W < 8 ? W : 8;
#pragma unroll 1
    for (int ks = 0; ks < 4; ++ks) {
        bf16x8 wf[4];
#pragma unroll
        for (int nb = 0; nb < 4; ++nb) wf[nb] = *(const bf16x8*)(wpt + (size_t)nb * 16 * 128 + 32 * ks);
        float sum[8], self[8];
#pragma unroll
        for (int e = 0; e < 8; ++e) { sum[e] = 0.f; self[e] = 0.f; }
#pragma unroll
        for (int j0 = 0; j0 < W; j0 += BW) {
            v4u v[BW];
#pragma unroll
            for (int j = 0; j < BW; ++j) { const int pp = pos - j0 - j; v[j] = *(const v4u*)(psrc + (size_t)rowidx(b, pp >= 0 ? pp : 0) * DIN + 32 * ks); }
#pragma unroll
            for (int j = 0; j < BW; ++j) { const float f = (pos - j0 - j) >= 0 ? 1.0f : 0.0f;
                sum[0] += f * bflo(v[j].x); sum[1] += f * bfhi(v[j].x); sum[2] += f * bflo(v[j].y); sum[3] += f * bfhi(v[j].y);
                sum[4] += f * bflo(v[j].z); sum[5] += f * bfhi(v[j].z); sum[6] += f * bflo(v[j].w); sum[7] += f * bfhi(v[j].w); }
            if (j0 == 0) { self[0] = bflo(v[0].x); self[1] = bfhi(v[0].x); self[2] = bflo(v[0].y); self[3] = bfhi(v[0].y); self[4] = bflo(v[0].z); self[5] = bfhi(v[0].z); self[6] = bflo(v[0].w); self[7] = bfhi(v[0].w); }
            if (j0 + BW < W) __builtin_amdgcn_sched_barrier(0);
        }
        v4u pk; pk.x = cvtpk(sum[0] * inv - self[0], sum[1] * inv - self[1]); pk.y = cvtpk(sum[2] * inv - self[2], sum[3] * inv - self[3]);
        pk.z = cvtpk(sum[4] * inv - self[4], sum[5] * inv - self[5]); pk.w = cvtpk(sum[6] * inv - self[6], sum[7] * inv - self[7]);
        const bf16x8 pf = __builtin_bit_cast(bf16x8, pk);
#pragma unroll
        for (int nb = 0; nb < 4; ++nb) pacc[nb] = mfma16(wf[nb], pf, pacc[nb]);
    }
}

__device__ __forceinline__ void mixer_phase(const Args& A, int l, LAS unsigned char* lds, int tid0, int wave) {
    unsigned char* wsb = gptr(A.ws);
    const bf16* proj = (const bf16*)(wsb + WS_PROJ); bf16* merged = (bf16*)(wsb + WS_MERGED);
    const bf16* wpool_t = (const bf16*)(wsb + WS_WSM) + (size_t)l * 4 * 128 * 128;
    const bf16* wpw_t = (const bf16*)(wsb + WS_WSM + 256 * 1024) + (size_t)l * 512 * 512;
    const float* wdw = gptr(A.w_dw) + (size_t)l * 31 * 512; const float* bdw = gptr(A.b_dw) + l * 512; const float* lng = gptr(A.conv_ln_g) + l * 512; const float* lnb_ = gptr(A.conv_ln_b) + l * 512;
    const float* psc = gptr(A.pool_scale) + l * 512; const float* mg = gptr(A.mix_out_g) + (size_t)l * DM;
    LAS float* Y = (LAS float*)(lds + ML_Y); LAS unsigned short* Ab = (LAS unsigned short*)(lds + ML_AB); LAS float* red = (LAS float*)(lds + ML_RED);
    LAS unsigned char* vl = lds + ML_V + wave * (64 * VPITCH); LAS unsigned char* st = lds + ML_ST + wave * 8192;
    for (int ui = blockIdx.x; ui < 513; ui += gridDim.x) {
        int ti = ui;
        if (gridDim.x == 256 && ui < 512) { const int w = ui & 255, rnd = ui >> 8; ti = 256 * (w >> 7) + (rnd == 0 ? 128 : 0) + (w & 127); }
        int b, p0; if (ti < 512) { b = ti >> 8; p0 = 16 + 16 * (ti & 255); } else { b = 0; p0 = 0; }
        int tid_l = tid0; asm volatile("" : "+v"(tid_l));
        const int tid = tid_l, lane = tid & 63, li = lane & 15, fq = lane >> 4;
#pragma unroll 1
        for (int hh = 0; hh < 2; ++hh) { f32x4 o0[4];
            sb_attention(proj, b, p0, 2 * wave + hh, vl, lane, o0);
#pragma unroll
            for (int db = 0; db < 4; ++db) *(LAS f32x4*)(st + ((hh * 4 + db) * 64 + lane) * 16) = o0[db]; }
        __syncthreads();
        {
            const int c = tid; const bf16* pa = proj + C_CA + c;
            float glu[46];
#pragma unroll
            for (int r = 0; r < 46; ++r) { const int pos = p0 - 30 + r; float gv = 0.f;
                if (pos >= 0) { const size_t row = (size_t)rowidx(b, pos); const float a = bf2f(pa[row * DIN]); const float gt = bf2f(pa[row * DIN + 512]); gv = a * sigmoidf_(gt); }
                glu[r] = gv;
                if ((r & 15) == 15) __builtin_amdgcn_sched_barrier(0); }
            const float* wdc = wdw + c; asm volatile("" : "+v"(wdc));
            float y[16]; const float bias = bdw[c];
#pragma unroll
            for (int t = 0; t < 16; ++t) y[t] = bias;
#pragma unroll
            for (int j = 0; j < 31; ++j) { const float w = wdc[j * 512];
#pragma unroll
                for (int t = 0; t < 16; ++t) y[t] += w * glu[t + j]; }
#pragma unroll
            for (int t = 0; t < 16; ++t) Y[t * 516 + c] = y[t];
        }
        __syncthreads();
#pragma unroll
        for (int tt = 0; tt < 2; ++tt) { const int t = 2 * wave + tt; float v[8]; float sm = 0.f;
#pragma unroll
            for (int i = 0; i < 8; ++i) { v[i] = Y[t * 516 + lane + 64 * i]; sm += v[i]; }
            const float mean = wave_sum(sm) * (1.0f / 512.0f); float q = 0.f;
#pragma unroll
            for (int i = 0; i < 8; ++i) { v[i] -= mean; q += v[i] * v[i]; }
            const float rstd = rsqrtf(wave_sum(q) * (1.0f / 512.0f) + EPS);
#pragma unroll
            for (int i = 0; i < 8; ++i) { const int c = lane + 64 * i; const float yn = v[i] * rstd * lng[c] + lnb_[c]; const float a = yn * sigmoidf_(yn); Ab[t * 520 + c] = (unsigned short)(cvtpk(a, 0.f) & 0xffffu); }
        }
        __syncthreads();
        f32x4 cacc[4];
#pragma unroll
        for (int i = 0; i < 4; ++i) cacc[i] = (f32x4){0.f, 0.f, 0.f, 0.f};
        { const bf16* wp = wpw_t + (size_t)(64 * wave + li) * 512 + 8 * fq; const LAS unsigned char* ab = (const LAS unsigned char*)Ab + li * 1040 + fq * 16;
#pragma unroll 4
            for (int ks = 0; ks < 16; ++ks) { const bf16x8 bfr = *(const LAS bf16x8*)(ab + ks * 64);
#pragma unroll
                for (int nb = 0; nb < 4; ++nb) { const bf16x8 wf = *(const bf16x8*)(wp + (size_t)nb * 16 * 512 + ks * 32); cacc[nb] = mfma16(wf, bfr, cacc[nb]); } } }
        f32x4 pacc[4];
#pragma unroll
        for (int i = 0; i < 4; ++i) pacc[i] = (f32x4){0.f, 0.f, 0.f, 0.f};
        { const int g = wave >> 1, nh = wave & 1;
            const bf16* wpt = wpool_t + (size_t)(g * 128 + 64 * nh + li) * 128 + 8 * fq; const bf16* psrc = proj + C_POOL + 128 * g + 8 * fq;
            if (g == 0) pool_group<2>(psrc, wpt, b, p0 + li, pacc); else if (g == 1) pool_group<4>(psrc, wpt, b, p0 + li, pacc); else if (g == 2) pool_group<8>(psrc, wpt, b, p0 + li, pacc); else pool_group<16>(psrc, wpt, b, p0 + li, pacc); }
        f32x4 oa[2][4];
#pragma unroll
        for (int hh = 0; hh < 2; ++hh)
#pragma unroll
            for (int db = 0; db < 4; ++db) oa[hh][db] = *(const LAS f32x4*)(st + ((hh * 4 + db) * 64 + lane) * 16);
        float ssa = 0.f, ssp = 0.f, ssc = 0.f;
        { const int g = wave >> 1, nh = wave & 1;
#pragma unroll
            for (int nb = 0; nb < 4; ++nb) { const f32x4 sc = *(const f32x4*)(psc + 128 * g + 64 * nh + 16 * nb + 4 * fq); pacc[nb] = pacc[nb] * sc; ssp += dot4(pacc[nb]); ssc += dot4(cacc[nb]); ssa += dot4(oa[0][nb]) + dot4(oa[1][nb]); } }
        ssa += __shfl_xor(ssa, 16); ssa += __shfl_xor(ssa, 32); ssp += __shfl_xor(ssp, 16); ssp += __shfl_xor(ssp, 32); ssc += __shfl_xor(ssc, 16); ssc += __shfl_xor(ssc, 32);
        if (lane < 16) { red[wave * 16 + lane] = ssa; red[128 + wave * 16 + lane] = ssp; red[256 + wave * 16 + lane] = ssc; }
        __syncthreads();
        float ta = 0.f, tp = 0.f, tc = 0.f;
#pragma unroll
        for (int w8 = 0; w8 < 8; ++w8) { ta += red[w8 * 16 + li]; tp += red[128 + w8 * 16 + li]; tc += red[256 + w8 * 16 + li]; }
        const float ra = rsqrtf(ta * (1.0f / DATT) + EPS), rp = rsqrtf(tp * (1.0f / DPOOL) + EPS), rc = rsqrtf(tc * (1.0f / DCONV) + EPS);
        bf16* orow = merged + (size_t)rowidx(b, p0 + li) * DM;
#pragma unroll
        for (int hh = 0; hh < 2; ++hh)
#pragma unroll
            for (int db = 0; db < 4; ++db) { const int col = (2 * wave + hh) * 64 + 16 * db + 4 * fq; const f32x4 gv = *(const f32x4*)(mg + col); const f32x4 v = oa[hh][db] * ra * gv;
                v2u w2; w2.x = cvtpk(v.x, v.y); w2.y = cvtpk(v.z, v.w); *(v2u*)(orow + col) = w2; }
        { const int g = wave >> 1, nh = wave & 1;
#pragma unroll
            for (int nb = 0; nb < 4; ++nb) { const int col = DATT + 128 * g + 64 * nh + 16 * nb + 4 * fq; const f32x4 gv = *(const f32x4*)(mg + col); const f32x4 v = pacc[nb] * rp * gv;
                v2u w2; w2.x = cvtpk(v.x, v.y); w2.y = cvtpk(v.z, v.w); *(v2u*)(orow + col) = w2; } }
#pragma unroll
        for (int nb = 0; nb < 4; ++nb) { const int col = DATT + DPOOL + 64 * wave + 16 * nb + 4 * fq; const f32x4 gv = *(const f32x4*)(mg + col); const f32x4 v = cacc[nb] * rc * gv;
            v2u w2; w2.x = cvtpk(v.x, v.y); w2.y = cvtpk(v.z, v.w); *(v2u*)(orow + col) = w2; }
        __syncthreads();
    }
}

#define XB_TMO      128
#define XB_XCNT(j)  (256  + 64 * (j))
#define XB_XSUB(j)  (1280 + 64 * (j))
#define XB_XGEN(j)  (2304 + 64 * (j))
#define XB_TOP      3328
#define XB_TOPGEN   3392
#define XCD_BAR_WORDS 3456
#define XB_SPIN_CAP (1u << 18)

__device__ __forceinline__ unsigned xb_ld(unsigned* p)              { return __hip_atomic_load(p, __ATOMIC_RELAXED, __HIP_MEMORY_SCOPE_AGENT); }
__device__ __forceinline__ unsigned xb_add(unsigned* p, unsigned v) { return __hip_atomic_fetch_add(p, v, __ATOMIC_RELAXED, __HIP_MEMORY_SCOPE_AGENT); }
__device__ __forceinline__ unsigned xb_xcc_id() { return (unsigned)__builtin_amdgcn_s_getreg((3 << 11) | 20) & 0xFu; }
#define XB_SPIN(cond, bar) do { unsigned _sp = 0; while (cond) { __builtin_amdgcn_s_sleep(1); \
    if ((++_sp & 255u) == 0u) { if (xb_ld(&(bar)[XB_TMO])) break; if (_sp > XB_SPIN_CAP) { atomicAdd(&(bar)[XB_TMO], 1u); break; } } } } while (0)

struct XcdBarrier {
    unsigned* bar; unsigned x;
    volatile LAS unsigned* st;
};

__device__ __forceinline__ XcdBarrier xcd_barrier_post(unsigned* bar, volatile LAS unsigned* st) {
    XcdBarrier b; b.bar = bar; b.x = xb_xcc_id(); b.st = st;
    if (threadIdx.x == 0) (void)xb_add(&bar[XB_XCNT(b.x)], 1u);
    return b;
}
__device__ __forceinline__ void xcd_barrier_complete(unsigned* bar, unsigned x, unsigned& nloc, unsigned& nx) {
    const unsigned G = gridDim.x * gridDim.y * gridDim.z;
    unsigned sum, cnt, mine, sp = 0u;
    for (;;) {
        sum = 0u; cnt = 0u; mine = 0u;
#pragma unroll
        for (unsigned j = 0; j < 16; ++j) { const unsigned c = xb_ld(&bar[XB_XCNT(j)]); sum += c; cnt += (c > 0u) ? 1u : 0u; mine = (j == x) ? c : mine; }
        if (sum == G) break;
        __builtin_amdgcn_s_sleep(1);
        if ((++sp & 255u) == 0u) { if (xb_ld(&bar[XB_TMO])) break; if (sp > XB_SPIN_CAP) { atomicAdd(&bar[XB_TMO], 1u); break; } }
    }
    nloc = mine > 0u ? mine : 1u; nx = cnt > 0u ? cnt : 1u;
}

__device__ __forceinline__ void xcd_barrier(const XcdBarrier& b) {
    asm volatile("s_waitcnt vmcnt(0)" ::: "memory");
    __syncthreads();
    if (threadIdx.x == 0) {
        unsigned* bar = b.bar;
        __builtin_amdgcn_s_waitcnt(0);
        unsigned nloc = b.st[0], nx = b.st[1];
        if (nloc == 0u) { xcd_barrier_complete(bar, b.x, nloc, nx); b.st[0] = nloc; b.st[1] = nx; }
        const unsigned old = xb_add(&bar[XB_XSUB(b.x)], 1u);
        const unsigned gen = old / nloc;
        if (old + 1u == (gen + 1u) * nloc) {
            __builtin_amdgcn_fence(__ATOMIC_RELEASE, "agent");
            asm volatile("s_waitcnt vmcnt(0)" ::: "memory");
            const unsigned og = xb_add(&bar[XB_TOP], 1u);
            const unsigned tg = og / nx;
            if (og + 1u == (tg + 1u) * nx) xb_add(&bar[XB_TOPGEN], 1u);
            else XB_SPIN(xb_ld(&bar[XB_TOPGEN]) == tg, bar);
            __builtin_amdgcn_fence(__ATOMIC_ACQUIRE, "agent");
            xb_add(&bar[XB_XGEN(b.x)], 1u);
            asm volatile("s_waitcnt vmcnt(0)" ::: "memory");
        } else {
            XB_SPIN(xb_ld(&bar[XB_XGEN(b.x)]) == gen, bar);
            __builtin_amdgcn_fence(__ATOMIC_ACQUIRE, "agent");
            asm volatile("s_waitcnt vmcnt(0)" ::: "memory");
        }
    }
    __syncthreads();
}

constexpr int NPHASE = 1 + 7 * DEPTH;
#define PHASE_ENTER() int tid_ = threadIdx.x; asm volatile("" : "+v"(tid_)); const int tid = tid_, lane = tid & 63, wave = __builtin_amdgcn_readfirstlane(tid >> 6); \
    const __attribute__((address_space(4))) Args* ka_ = (const __attribute__((address_space(4))) Args*)__builtin_amdgcn_kernarg_segment_ptr(); asm volatile("" : "+s"(ka_)); Args A; __builtin_memcpy(&A, ka_, sizeof(Args)); \
    const int G = gridDim.x, gw = blockIdx.x * 8 + wave, NGW = G * 8; LAS float* scr = (LAS float*)(lds + wave * 16640); (void)tid; (void)lane; (void)gw; (void)NGW; (void)scr; (void)G;
__global__ void __launch_bounds__(512, 2) fwd_megakernel(Args args) {
    extern __shared__ __attribute__((aligned(16))) unsigned char lds_raw[];
    LAS unsigned char* lds = (LAS unsigned char*)lds_raw;
    cg::grid_group grid = cg::this_grid();
    const int lo = args.ph_lo, hi = args.ph_hi;
    volatile LAS unsigned* bst = (volatile LAS unsigned*)(lds + LDS_BYTES - 64);
    if (threadIdx.x < 16) bst[threadIdx.x] = 0u;
    __syncthreads();
    XcdBarrier bar = xcd_barrier_post((unsigned*)(args.ws + WS_CTL), bst);
#if !MK_SPLIT
    grid.sync();
#endif
#define IN(k) (lo <= (k) && (k) < hi)
#define SEAM(k) do { if (IN(k) && IN((k) + 1)) xcd_barrier(bar); } while (0)
    int k = 0;
    for (int rep = 0; rep < ((PROBE_DUP & 1) ? 2 : 1); ++rep) if (IN(k)) { if (rep) xcd_barrier(bar); PHASE_ENTER(); convert_mix_weights(A, scr, gw, NGW, lane); convert_ffn_weights(A, 0, scr, gw, NGW, lane); init_rows(A, gw, NGW, lane); }
    SEAM(k); ++k;
    for (int l = 0; l < DEPTH; ++l) {
        for (int rep = 0; rep < ((PROBE_DUP & 4) ? 2 : 1); ++rep) if (IN(k)) { if (rep) xcd_barrier(bar); PHASE_ENTER(); unsigned char* wsb = gptr(A.ws);
            pg8::Gemm g{(const bf16*)(wsb + WS_U), (const bf16*)(wsb + WS_WIN) + (size_t)l * DIN * DM, MR, DIN, DM}; pg8::StaticOrder S; S.init(MR, DIN, G, (int)blockIdx.x);
            pg8::EpiBf16<0> E{(bf16*)(wsb + WS_PROJ), DIN, nullptr, 1024, 1024, 0.125f};
            pg8::gemm_phase<pg8::EpiBf16<0>, pg8::StaticOrder, PG8_ALIGN, PG8_SP2>(lds, g, S, E);
            __syncthreads(); skinny_gemm<0>((const bf16*)(wsb + WS_U) + (size_t)MR * DM, (const bf16*)(wsb + WS_WIN) + (size_t)l * DIN * DM, DIN, DM, (void*)(wsb + WS_PROJ), DIN, lds, lane, wave);
        }
        SEAM(k); ++k;
        for (int rep = 0; rep < ((PROBE_DUP & 2) ? 2 : 1); ++rep) if (IN(k)) { if (rep) xcd_barrier(bar); PHASE_ENTER(); mixer_phase(A, l, lds, tid, wave); }
        SEAM(k); ++k;
        for (int rep = 0; rep < ((PROBE_DUP & 16) ? 2 : 1); ++rep) if (IN(k)) { if (rep) xcd_barrier(bar); PHASE_ENTER(); unsigned char* wsb = gptr(A.ws);
            pg8::Gemm g{(const bf16*)(wsb + WS_MERGED), (const bf16*)(wsb + WS_WOUT) + (size_t)l * DM * DM, MR, DM, DM}; pg8::StaticOrder S; S.init(MR, DM, G, (int)blockIdx.x);
            pg8::EpiF32 E{(float*)(wsb + WS_OUT), DM};
            pg8::gemm_phase<pg8::EpiF32, pg8::StaticOrder, PG8_ALIGN, PG8_SP2>(lds, g, S, E);
            __syncthreads(); skinny_gemm<1>((const bf16*)(wsb + WS_MERGED) + (size_t)MR * DM, (const bf16*)(wsb + WS_WOUT) + (size_t)l * DM * DM, DM, DM, (void*)(wsb + WS_OUT), DM, lds, lane, wave);
        }
        SEAM(k); ++k;
        if (IN(k)) { PHASE_ENTER(); row_phase(A, A.post_mix_g + (size_t)l * DM, A.pre_ffn_g + (size_t)l * DM, nullptr, gw, NGW, lane); }
        SEAM(k); ++k;
        for (int rep = 0; rep < ((PROBE_DUP & 32) ? 2 : 1); ++rep) if (IN(k)) { if (rep) xcd_barrier(bar); PHASE_ENTER(); unsigned char* wsb = gptr(A.ws);
            pg8::Gemm g{(const bf16*)(wsb + WS_U), (const bf16*)(wsb + WS_WGU), MR, 2 * DFF, DM}; pg8::StaticOrder S; S.init(MR, 2 * DFF, G, (int)blockIdx.x);
            pg8::EpiSwiGLU E{(bf16*)(wsb + WS_ACT), DFF};
            pg8::gemm_phase<pg8::EpiSwiGLU, pg8::StaticOrder, PG8_ALIGN, PG8_SP2>(lds, g, S, E);
            __syncthreads(); skinny_gemm<2>((const bf16*)(wsb + WS_U) + (size_t)MR * DM, (const bf16*)(wsb + WS_WGU), 2 * DFF, DM, (void*)(wsb + WS_ACT), DFF, lds, lane, wave);
        }
        SEAM(k); ++k;
        for (int rep = 0; rep < ((PROBE_DUP & 8) ? 2 : 1); ++rep) if (IN(k)) { if (rep) xcd_barrier(bar); PHASE_ENTER(); unsigned char* wsb = gptr(A.ws);
            pg8::Gemm g{(const bf16*)(wsb + WS_ACT), (const bf16*)(wsb + WS_WD), MR, DM, DFF}; pg8::StaticOrder S; S.init(MR, DM, G, (int)blockIdx.x);
            pg8::EpiF32 E{(float*)(wsb + WS_OUT), DM};
            pg8::gemm_phase<pg8::EpiF32, pg8::StaticOrder, PG8_ALIGN, PG8_SP2>(lds, g, S, E);
            __syncthreads(); skinny_gemm<1>((const bf16*)(wsb + WS_ACT) + (size_t)MR * DFF, (const bf16*)(wsb + WS_WD), DM, DFF, (void*)(wsb + WS_OUT), DM, lds, lane, wave);
        }
        SEAM(k); ++k;
        if (IN(k)) { PHASE_ENTER();
            if (l + 1 < DEPTH) { convert_ffn_weights(A, l + 1, scr, gw, NGW, lane); row_phase(A, A.post_ffn_g + (size_t)l * DM, A.pre_mix_g + (size_t)(l + 1) * DM, nullptr, gw, NGW, lane); }
            else row_phase(A, A.post_ffn_g + (size_t)l * DM, nullptr, A.out, gw, NGW, lane);
        }
        if (l + 1 < DEPTH) { SEAM(k); } ++k;
    }
#undef IN
#undef SEAM
}

extern "C" void kernel_launch(void* const* d_in, const int* in_sizes, int n_in, void* d_out, int out_size, void* d_ws, size_t ws_size, hipStream_t stream) {
    static int grid = 0;
    if (grid == 0) {
        if (n_in != 19 || in_sizes[0] != MR * DM || out_size != MR * DM || ws_size < WS_END) { fprintf(stderr, "kernel_launch: unexpected problem (n_in %d, in0 %d, out %d, ws %zu, need %zu)\n", n_in, n_in > 0 ? in_sizes[0] : -1, out_size, ws_size, (size_t)WS_END); grid = -1; return; }
        int dev = 0, cus = 0, per_cu = 0;
        if (hipGetDevice(&dev) != hipSuccess || hipDeviceGetAttribute(&cus, hipDeviceAttributeMultiprocessorCount, dev) != hipSuccess) { grid = -1; return; }
        if (hipFuncSetAttribute((const void*)fwd_megakernel, hipFuncAttributeMaxDynamicSharedMemorySize, LDS_BYTES) != hipSuccess) { fprintf(stderr, "kernel_launch: hipFuncSetAttribute failed\n"); grid = -1; return; }
        if (hipOccupancyMaxActiveBlocksPerMultiprocessor(&per_cu, (const void*)fwd_megakernel, 512, LDS_BYTES) != hipSuccess || per_cu < 1) { fprintf(stderr, "kernel_launch: occupancy query says %d blocks per CU\n", per_cu); per_cu = 1; }
        (void)hipGetLastError();
        grid = cus;
    }
    if (grid < 0) return;
    if (hipMemsetAsync((unsigned char*)d_ws + WS_CTL, 0, CTL_BYTES, stream) != hipSuccess) { fprintf(stderr, "kernel_launch: hipMemsetAsync failed\n"); return; }
    Args a{};
    const float** ap = (const float**)&a;
    for (int i = 0; i < 19; ++i) ap[i] = (const float*)d_in[i];
    a.out = (float*)d_out; a.ws = (unsigned char*)d_ws;
#if MK_SPLIT
    for (int ph = 0; ph < NPHASE; ++ph) { a.ph_lo = ph; a.ph_hi = ph + 1; hipLaunchKernelGGL(fwd_megakernel, dim3(grid), dim3(512), LDS_BYTES, stream, a); }
#else
    a.ph_lo = 0; a.ph_hi = NPHASE;
    void* kargs[] = {(void*)&a};
    const hipError_t e = hipLaunchCooperativeKernel((const void*)fwd_megakernel, dim3(grid), dim3(512), kargs, LDS_BYTES, stream);
    if (e != hipSuccess) fprintf(stderr, "kernel_launch: cooperative launch failed: %s (grid %d)\n", hipGetErrorString(e), grid);
#endif
}
```

```cpp
#include <hip/hip_runtime.h>
#include <hip/hip_cooperative_groups.h>
#include <cstdio>
#include <cstdint>
namespace cg = cooperative_groups;
namespace pg8 {
#define PG8_LAS __attribute__((address_space(3)))
typedef unsigned short bf16_t;
typedef short bf16x8 __attribute__((ext_vector_type(8)));
typedef float f32x4 __attribute__((ext_vector_type(4)));
typedef unsigned u32x4 __attribute__((ext_vector_type(4)));
constexpr int BM = 256, BK = 64, HALF = 128, HTB = HALF * BK * 2  , STAGE_BYTES = 8 * HTB, NXCD = 8, WGM = 8;

__host__ __device__ __forceinline__ int lds_byte(int r, int c) { const int st = (r >> 4) * 2 + (c >> 5), rr = r & 15, cc = c & 31, ob = rr * 64 + cc * 2; return st * 1024 + (ob ^ (((ob >> 9) & 1) << 5)); }
__host__ __device__ __forceinline__ void stage_rc(int b, int& R, int& C) { const int st = b / 1024, sb = b % 1024, swz = sb ^ (((sb >> 9) & 1) << 5); R = (st >> 1) * 16 + swz / 64; C = (st & 1) * 32 + (swz % 64) / 2; }
__host__ __device__ __forceinline__ int perm32(int rho) { const int n = rho >> 4, i = rho & 15; return 8 * (i >> 2) + 4 * n + (i & 3); }

struct Unit { int pm, pn; };
struct Gemm { const bf16_t* A; const bf16_t* Bt; int M, N, K; };

struct StaticOrder {
    int nM, nN, nwg, G, c;
    __host__ __device__ void init(int M, int N, int G_, int c_) { nM = M / BM; nN = N / BM; nwg = nM * nN; G = G_; c = c_; }
    __host__ __device__ bool next(int i, Unit& u) const {
        const long L = (long)i * G + c; if (L >= nwg) return false;
        int wgid = (int)L; { const int q = nwg / NXCD, r = nwg % NXCD, xcd = wgid % NXCD, off = wgid / NXCD; wgid = (xcd < r ? xcd * (q + 1) : r * (q + 1) + (xcd - r) * q) + off; }
        const int nig = WGM * nN, gid = wgid / nig, fm = gid * WGM, gsz = (nM - fm) < WGM ? (nM - fm) : WGM;
        u.pm = fm + ((wgid % nig) % gsz); u.pn = (wgid % nig) / gsz; return true;
    }
    __device__ __forceinline__ void a_ready(const Unit&) const {}
    __device__ __forceinline__ void done(const Unit&) const {}
};

__device__ __forceinline__ unsigned cvt_pk_bf16(float lo, float hi) { unsigned r; asm volatile("v_cvt_pk_bf16_f32 %0, %1, %2" : "=v"(r) : "v"(lo), "v"(hi)); return r; }
typedef float f32x2 __attribute__((ext_vector_type(2)));
__device__ __forceinline__ f32x2 gelu_pk(f32x2 v) {
    const f32x2 av = __builtin_elementwise_abs(v), d = av * 0.2316418882f + 1.0f;
    f32x2 t; t.x = __builtin_amdgcn_rcpf(d.x); t.y = __builtin_amdgcn_rcpf(d.y);
    f32x2 q = t * 0.5307027145f + (-0.7265760135f); q = q * t + 0.7107068705f; q = q * t + (-0.142248368f); q = q * t + 0.127414796f; q = q * t;
    const f32x2 s = (v * v) * (-0.72134752044f);
    f32x2 e; e.x = __builtin_amdgcn_exp2f(s.x); e.y = __builtin_amdgcn_exp2f(s.y);
    const f32x2 m = v * (q * e), r = v - m;
    f32x2 o; o.x = v.x < 0.f ? m.x : r.x; o.y = v.y < 0.f ? m.y : r.y; return o;
}

template <int ACT  > struct EpiBf16 {
    static constexpr bool PERM = true, AFTER_DRAIN = false; static_assert(ACT == 0 || ACT == 1, "EpiBf16: ACT is 0 (none) or 1 (gelu_pk)");
    bf16_t* O; int ldc; const float* bias; int split_cols; size_t split_stride; float scale0;
    __device__ __forceinline__ void operator()(const f32x4 (&acc)[2][2][4][2], const Unit& u, int wr, int wc, int fr, int fq) const {
        const int row0 = u.pm * BM + wr * 64 + fr; int colt = u.pn * BM; bf16_t* base = O;
        float sc = 1.f; if (split_cols) { const int t = colt / split_cols; base += (size_t)t * split_stride; colt -= t * split_cols; if (t == 0) sc = scale0; }
        const int col0 = colt + wc * 32 + 8 * fq, bcol0 = u.pn * BM + wc * 32 + 8 * fq;
        f32x4 bv[2][2];
#pragma unroll
        for (int bj = 0; bj < 2; ++bj)
#pragma unroll
            for (int n = 0; n < 2; ++n) bv[bj][n] = bias ? *(const f32x4*)(bias + bcol0 + bj * HALF + 4 * n) : (f32x4){0.f, 0.f, 0.f, 0.f};
#pragma unroll
        for (int ai = 0; ai < 2; ++ai)
#pragma unroll
            for (int m = 0; m < 4; ++m) { bf16_t* rowp = base + (size_t)(row0 + ai * HALF + m * 16) * ldc + col0;
#pragma unroll
                for (int bj = 0; bj < 2; ++bj) { f32x4 v0 = acc[ai][bj][m][0] + bv[bj][0], v1 = acc[ai][bj][m][1] + bv[bj][1];
                    if (ACT == 1) { f32x2 a = gelu_pk((f32x2){v0[0], v0[1]}), b = gelu_pk((f32x2){v0[2], v0[3]}), c = gelu_pk((f32x2){v1[0], v1[1]}), d = gelu_pk((f32x2){v1[2], v1[3]});
                        v0 = (f32x4){a.x, a.y, b.x, b.y}; v1 = (f32x4){c.x, c.y, d.x, d.y}; }
                    v0 = v0 * sc; v1 = v1 * sc; u32x4 w; w.x = cvt_pk_bf16(v0[0], v0[1]); w.y = cvt_pk_bf16(v0[2], v0[3]); w.z = cvt_pk_bf16(v1[0], v1[1]); w.w = cvt_pk_bf16(v1[2], v1[3]);
                    *(u32x4*)(rowp + bj * HALF) = w; } }
    }
};
__device__ __forceinline__ unsigned cvtpk_rne(float lo, float hi) { typedef float f32x2_t __attribute__((ext_vector_type(2))); typedef __bf16 bf16x2_t __attribute__((ext_vector_type(2)));
    f32x2_t v = {lo, hi}; bf16x2_t b = __builtin_convertvector(v, bf16x2_t); return __builtin_bit_cast(unsigned, b); }
struct EpiF32 {
    static constexpr bool PERM = false, AFTER_DRAIN = false;
    float* O; int ldc;
    __device__ __forceinline__ void operator()(const f32x4 (&acc)[2][2][4][2], const Unit& u, int wr, int wc, int fr, int fq) const {
        const int row0 = u.pm * BM + wr * 64 + fr, col0 = u.pn * BM + wc * 32 + 4 * fq;
#pragma unroll
        for (int ai = 0; ai < 2; ++ai)
#pragma unroll
            for (int m = 0; m < 4; ++m) { float* rowp = O + (size_t)(row0 + ai * HALF + m * 16) * ldc + col0;
#pragma unroll
                for (int bj = 0; bj < 2; ++bj)
#pragma unroll
                    for (int n = 0; n < 2; ++n) *(f32x4*)(rowp + bj * HALF + n * 16) = acc[ai][bj][m][n]; }
    }
};
struct EpiSwiGLU {
    static constexpr bool PERM = true, AFTER_DRAIN = false;
    bf16_t* O; int ldc;
    __device__ __forceinline__ void operator()(const f32x4 (&acc)[2][2][4][2], const Unit& u, int wr, int wc, int fr, int fq) const {
        typedef unsigned u32x2 __attribute__((ext_vector_type(2)));
        const int row0 = u.pm * BM + wr * 64 + fr, col0 = u.pn * (BM / 2) + wc * 16 + 4 * fq;
#pragma unroll
        for (int ai = 0; ai < 2; ++ai)
#pragma unroll
            for (int m = 0; m < 4; ++m) { bf16_t* rowp = O + (size_t)(row0 + ai * HALF + m * 16) * ldc + col0;
#pragma unroll
                for (int bj = 0; bj < 2; ++bj) { const f32x4 g = acc[ai][bj][m][0], up = acc[ai][bj][m][1]; float a[4];
#pragma unroll
                    for (int e = 0; e < 4; ++e) a[e] = g[e] * __builtin_amdgcn_rcpf(1.0f + __builtin_amdgcn_exp2f(-1.4426950408889634f * g[e])) * up[e];
                    u32x2 w; w.x = cvtpk_rne(a[0], a[1]); w.y = cvtpk_rne(a[2], a[3]); *(u32x2*)(rowp + bj * (HALF / 2)) = w; } }
    }
};

template <class Epi, class Sched, bool ALIGN_EPI = false, bool SP2 = false>
__device__ __forceinline__ void gemm_phase(PG8_LAS unsigned char* lds, const Gemm g, const Sched& S, const Epi& E) {
    int tid_ = threadIdx.x; asm volatile("" : "+v"(tid_));
    const int tid = tid_, wid = __builtin_amdgcn_readfirstlane(tid >> 6), lane = tid & 63, wr = wid >> 2, wc = wid & 3, fr = lane & 15, fq = lane >> 4;
    const int K = g.K, nt = K / BK;
    unsigned voffA[2], voffB[2];
#pragma unroll
    for (int i = 0; i < 2; ++i) { int R, C; stage_rc(tid * 16 + i * 8192, R, C); const int Rb = Epi::PERM ? ((R & ~31) + perm32(R & 31)) : R;
        voffA[i] = (unsigned)(R * K + C) * 2u; voffB[i] = (unsigned)(Rb * K + C) * 2u; }
    const size_t kstep = (size_t)(BK * 2);
    const size_t hstep = (size_t)HALF * K * 2;
    const size_t tstep = 2 * hstep;
    const unsigned ldsw = (unsigned)wid * 1024u;
    const int aoff = lds_byte(wr * 64 + fr, fq * 8), boff = lds_byte(wc * 32 + fr, fq * 8);
#define PG8_SA(b, h) (((b) * 2 + (h)) * HTB)
#define PG8_SB(b, h) ((4 + (b) * 2 + (h)) * HTB)
#define PG8_STAGE(bufoff, gbase, voff) do { _Pragma("unroll") for (int _i = 0; _i < 2; ++_i) \
        __builtin_amdgcn_global_load_lds((const unsigned*)((const char*)(gbase) + (voff)[_i]), (PG8_LAS unsigned*)(lds + (bufoff) + ldsw + _i * 8192), 16, 0, 0); } while (0)
#define PG8_LDA(dst, b, h) do { _Pragma("unroll") for (int m = 0; m < 4; ++m) _Pragma("unroll") for (int k = 0; k < 2; ++k) dst[m][k] = *(const PG8_LAS bf16x8*)(lds + PG8_SA(b, h) + aoff + m * 2048 + k * 1024); } while (0)
#define PG8_LDB(dst, b, h) do { _Pragma("unroll") for (int n = 0; n < 2; ++n) _Pragma("unroll") for (int k = 0; k < 2; ++k) dst[n][k] = *(const PG8_LAS bf16x8*)(lds + PG8_SB(b, h) + boff + n * 2048 + k * 1024); } while (0)
#define PG8_MMA(ai, bj, At, Bt) do { __builtin_amdgcn_s_setprio(1); _Pragma("unroll") for (int m = 0; m < 4; ++m) _Pragma("unroll") for (int n = 0; n < 2; ++n) _Pragma("unroll") for (int k = 0; k < 2; ++k) \
        acc[ai][bj][m][n] = __builtin_amdgcn_mfma_f32_16x16x32_bf16(Bt[n][k], At[m][k], acc[ai][bj][m][n], 0, 0, 0); __builtin_amdgcn_s_setprio(0); } while (0)
#define PG8_WAIT_V(n) asm volatile("s_waitcnt vmcnt(" #n ")" ::: "memory")
#define PG8_WAIT_L(n) asm volatile("s_waitcnt lgkmcnt(" #n ")" ::: "memory")
#define PG8_BAR __builtin_amdgcn_s_barrier()
#define PG8_SCHED __builtin_amdgcn_sched_barrier(0)
    Unit cur, nxt; int ui = 0;
    if (!S.next(0, cur)) return;
    f32x4 acc[2][2][4][2];
#pragma unroll
    for (int a = 0; a < 2; ++a)
#pragma unroll
        for (int b = 0; b < 2; ++b)
#pragma unroll
            for (int m = 0; m < 4; ++m)
#pragma unroll
                for (int n = 0; n < 2; ++n) acc[a][b][m][n] = (f32x4){0.f, 0.f, 0.f, 0.f};
    bf16x8 At[4][2], B0[2][2], B1[2][2];
    const char* cA = (const char*)g.A + (size_t)cur.pm * tstep; const char* cB = (const char*)g.Bt + (size_t)cur.pn * tstep;
    S.a_ready(cur);
    if constexpr (SP2) {
        PG8_STAGE(PG8_SB(0, 0), cB, voffB); PG8_STAGE(PG8_SB(0, 1), cB + hstep, voffB); PG8_STAGE(PG8_SA(0, 0), cA, voffA); PG8_STAGE(PG8_SA(0, 1), cA + hstep, voffA);
        if (wr == 1) PG8_BAR;
        PG8_WAIT_V(2); PG8_BAR;
        PG8_STAGE(PG8_SB(1, 0), cB + kstep, voffB); PG8_STAGE(PG8_SA(1, 0), cA + kstep, voffA); PG8_STAGE(PG8_SB(1, 1), cB + hstep + kstep, voffB);
        PG8_WAIT_V(6); PG8_BAR;
    } else {
        PG8_STAGE(PG8_SB(0, 0), cB, voffB); PG8_STAGE(PG8_SA(0, 0), cA, voffA); PG8_STAGE(PG8_SB(0, 1), cB + hstep, voffB); PG8_STAGE(PG8_SA(0, 1), cA + hstep, voffA);
        if (wr == 1) PG8_BAR;
        PG8_WAIT_V(4); PG8_BAR;
        PG8_STAGE(PG8_SB(1, 0), cB + kstep, voffB); PG8_STAGE(PG8_SA(1, 0), cA + kstep, voffA); PG8_STAGE(PG8_SB(1, 1), cB + hstep + kstep, voffB);
        PG8_WAIT_V(6); PG8_BAR;
    }
    for (;;) {
        const bool has_next = S.next(ui + 1, nxt);
        const char* nA = has_next ? (const char*)g.A + (size_t)nxt.pm * tstep : cA; const char* nB = has_next ? (const char*)g.Bt + (size_t)nxt.pn * tstep : cB;
        for (int t = 0; t < nt; t += 2) {
            const bool last = (t == nt - 2);
            const char* a1 = cA + (size_t)(t + 1) * kstep;
            const char* a2 = last ? nA : cA + (size_t)(t + 2) * kstep; const char* b2 = last ? nB : cB + (size_t)(t + 2) * kstep;
            const char* a3 = a2 + kstep; const char* b3 = b2 + kstep;
            if (last && has_next) S.a_ready(nxt);
            if constexpr (SP2) {
            PG8_LDB(B0, 0, 0); PG8_LDB(B1, 0, 1); PG8_SCHED; PG8_LDA(At, 0, 0); PG8_STAGE(PG8_SA(1, 1), a1 + hstep, voffA);
            PG8_WAIT_V(8); PG8_WAIT_L(0); PG8_BAR; PG8_MMA(0, 0, At, B0); PG8_MMA(0, 1, At, B1); PG8_BAR; PG8_SCHED;
            PG8_LDA(At, 0, 1); PG8_STAGE(PG8_SB(0, 0), b2, voffB); PG8_STAGE(PG8_SB(0, 1), b2 + hstep, voffB); PG8_STAGE(PG8_SA(0, 0), a2, voffA);
            PG8_WAIT_V(8); PG8_WAIT_L(0); PG8_BAR; PG8_MMA(1, 0, At, B0); PG8_MMA(1, 1, At, B1); PG8_BAR; PG8_SCHED;
            PG8_LDB(B0, 1, 0); PG8_LDB(B1, 1, 1); PG8_SCHED; PG8_LDA(At, 1, 0); PG8_STAGE(PG8_SA(0, 1), a2 + hstep, voffA);
            PG8_WAIT_V(8); PG8_WAIT_L(0); PG8_BAR; PG8_MMA(0, 0, At, B0); PG8_MMA(0, 1, At, B1); PG8_BAR; PG8_SCHED;
            PG8_LDA(At, 1, 1); PG8_STAGE(PG8_SB(1, 0), b3, voffB); PG8_STAGE(PG8_SB(1, 1), b3 + hstep, voffB); PG8_STAGE(PG8_SA(1, 0), a3, voffA);
            PG8_WAIT_V(8); PG8_WAIT_L(0); PG8_BAR; PG8_MMA(1, 0, At, B0); PG8_MMA(1, 1, At, B1); PG8_BAR; PG8_SCHED;
            } else {
            PG8_LDB(B0, 0, 0); PG8_SCHED; PG8_LDA(At, 0, 0); PG8_STAGE(PG8_SA(1, 1), a1 + hstep, voffA);
            PG8_WAIT_L(8); PG8_BAR; PG8_WAIT_L(0); PG8_MMA(0, 0, At, B0); PG8_BAR; PG8_SCHED;
            PG8_LDB(B1, 0, 1); PG8_STAGE(PG8_SB(0, 0), b2, voffB);
            PG8_BAR; PG8_WAIT_L(0); PG8_MMA(0, 1, At, B1); PG8_BAR;
            PG8_LDA(At, 0, 1); PG8_STAGE(PG8_SA(0, 0), a2, voffA);
            PG8_BAR; PG8_WAIT_L(0); PG8_MMA(1, 0, At, B0); PG8_BAR; PG8_SCHED;
            PG8_STAGE(PG8_SB(0, 1), b2 + hstep, voffB);
            PG8_WAIT_V(6); PG8_BAR; PG8_MMA(1, 1, At, B1); PG8_BAR;
            PG8_LDB(B0, 1, 0); PG8_SCHED; PG8_LDA(At, 1, 0); PG8_STAGE(PG8_SA(0, 1), a2 + hstep, voffA);
            PG8_WAIT_L(8); PG8_BAR; PG8_WAIT_L(0); PG8_MMA(0, 0, At, B0); PG8_BAR; PG8_SCHED;
            PG8_LDB(B1, 1, 1); PG8_STAGE(PG8_SB(1, 0), b3, voffB);
            PG8_BAR; PG8_WAIT_L(0); PG8_MMA(0, 1, At, B1); PG8_BAR;
            PG8_LDA(At, 1, 1); PG8_STAGE(PG8_SA(1, 0), a3, voffA);
            PG8_BAR; PG8_WAIT_L(0); PG8_MMA(1, 0, At, B0); PG8_BAR; PG8_SCHED;
            PG8_STAGE(PG8_SB(1, 1), b3 + hstep, voffB);
            PG8_WAIT_V(6); PG8_BAR; PG8_MMA(1, 1, At, B1); PG8_BAR;
            }
        }
        if constexpr (ALIGN_EPI) { if (wr == 0) PG8_BAR; }
        if constexpr (!Epi::AFTER_DRAIN) { E(acc, cur, wr, wc, fr, fq); S.done(cur); }
        if (!has_next) break;
#pragma unroll
        for (int a = 0; a < 2; ++a)
#pragma unroll
            for (int b = 0; b < 2; ++b)
#pragma unroll
                for (int m = 0; m < 4; ++m)
#pragma unroll
                    for (int n = 0; n < 2; ++n) acc[a][b][m][n] = (f32x4){0.f, 0.f, 0.f, 0.f};
        cur = nxt; cA = nA; cB = nB; ++ui;
        if constexpr (ALIGN_EPI) { if (wr == 1) PG8_BAR; }
    }
    PG8_WAIT_V(0);
    if constexpr (!ALIGN_EPI) { if (wr == 0) PG8_BAR; }
    PG8_BAR;
    if constexpr (Epi::AFTER_DRAIN) { E.fused(acc, cur, wr, wc, fr, fq, lds, wid, lane); S.done(cur); }
#undef PG8_SA
#undef PG8_SB
#undef PG8_STAGE
#undef PG8_LDA
#undef PG8_LDB
#undef PG8_MMA
#undef PG8_WAIT_V
#undef PG8_WAIT_L
#undef PG8_BAR
#undef PG8_SCHED
}
}

#ifndef PG8_SP2
#define PG8_SP2 true
#endif
#ifndef PG8_ALIGN
#define PG8_ALIGN true
#endif
#ifndef PROBE_DUP
#define PROBE_DUP 0
#endif
#ifndef MK_SPLIT
#define MK_SPLIT 0
#endif

constexpr int NB = 2, SEQ = 4096, DM = 2048, NMETA = 16, LSEQ = SEQ + NMETA, DEPTH = 2;
constexpr int MR = NB * SEQ;
constexpr int MV = MR + NMETA;
constexpr int MP = 33 * 256;
constexpr int DIN = 4608, DFF = 5632, DATT = 1024, DPOOL = 512, DCONV = 512, NHEAD = 16;
constexpr int C_K = 1024, C_V = 2048, C_POOL = 3072, C_CA = 3584, C_CG = 4096;
constexpr float EPS = 1e-6f, LOG2E = 1.4426950408889634f, LN2 = 0.6931471805599453f;
constexpr float SB_EXIT = -110.0f;

constexpr size_t MiB = 1u << 20;
constexpr size_t WS_WIN = 0;
constexpr size_t WS_WOUT = WS_WIN + 36 * MiB;
constexpr size_t WS_WGU = WS_WOUT + 16 * MiB;
constexpr size_t WS_WD = WS_WGU + 44 * MiB;
constexpr size_t WS_WSM = WS_WD + 22 * MiB;
constexpr size_t WS_H = WS_WSM + 2 * MiB;
constexpr size_t WS_U = WS_H + 66 * MiB;
constexpr size_t WS_OUT = WS_U + 33 * MiB;
constexpr size_t WS_PROJ = WS_OUT + 66 * MiB;
constexpr size_t WS_MERGED = WS_PROJ + (size_t)MP * DIN * 2;
constexpr size_t WS_ACT = WS_PROJ;
constexpr size_t WS_CTL = WS_MERGED + 33 * MiB;
constexpr size_t CTL_BYTES = 65536;
constexpr size_t WS_END = WS_CTL + 1 * MiB;
static_assert((size_t)MP * DFF * 2 <= WS_END - WS_PROJ, "act overlay");

constexpr int LDS_BYTES = 147456;

#define GAS __attribute__((address_space(1)))
#define LAS __attribute__((address_space(3)))
typedef unsigned short bf16;
typedef unsigned v4u __attribute__((ext_vector_type(4)));
typedef unsigned v2u __attribute__((ext_vector_type(2)));
typedef float f32x4 __attribute__((ext_vector_type(4)));
typedef short bf16x8 __attribute__((ext_vector_type(8)));
typedef short v4i16_t __attribute__((ext_vector_type(4)));
#define LDS_WAIT() asm volatile("s_waitcnt lgkmcnt(0)" ::: "memory")

__device__ __forceinline__ unsigned cvtpk(float lo, float hi) { return pg8::cvtpk_rne(lo, hi); }
__device__ __forceinline__ float bflo(unsigned u) { return __uint_as_float(u << 16); }
__device__ __forceinline__ float bfhi(unsigned u) { return __uint_as_float(u & 0xffff0000u); }
__device__ __forceinline__ float bf2f(bf16 v) { return __uint_as_float((unsigned)v << 16); }
__device__ __forceinline__ float wave_sum(float v) {
#pragma unroll
    for (int o = 1; o < 64; o <<= 1) v += __shfl_xor(v, o);
    return v;
}
__device__ __forceinline__ float sigmoidf_(float x) { return __builtin_amdgcn_rcpf(1.0f + __builtin_amdgcn_exp2f(-LOG2E * x)); }
template <class T> __device__ __forceinline__ T* gptr(T* p) { GAS T* g = (GAS T*)p; asm volatile("" : "+s"(g)); return (T*)g; }
__device__ __forceinline__ int rowidx(int b, int pos) { return pos < NMETA ? MR + pos : b * SEQ + pos - NMETA; }
__device__ __forceinline__ f32x4 mfma16(bf16x8 a, bf16x8 b, f32x4 c) { return __builtin_amdgcn_mfma_f32_16x16x32_bf16(a, b, c, 0, 0, 0); }

struct Args {
    const float *x, *meta, *pre_mix_g, *w_in, *w_pool, *pool_scale, *w_dw, *b_dw, *conv_ln_g, *conv_ln_b, *w_pw, *mix_out_g, *w_out, *post_mix_g, *pre_ffn_g, *w_gate, *w_up, *w_down, *post_ffn_g;
    float* out; unsigned char* ws; int ph_lo, ph_hi;
};

__device__ __forceinline__ void transpose_item(const float* __restrict__ W, int K, int N, bf16* WT, int mode, LAS float* scr, int item, int lane) {
    W = gptr(W); WT = gptr(WT);
    const int nblk = N >> 6, kb = item / nblk, nb = item - kb * nblk, k0 = kb << 6, n0 = nb << 6;
    const int r4 = lane >> 4, c4 = (lane & 15) * 4;
#pragma unroll 4
    for (int i = 0; i < 16; ++i) { const int kk = 4 * i + r4; const f32x4 v = *(const f32x4*)(W + (size_t)(k0 + kk) * N + n0 + c4);
        LAS float* s = scr + kk * 65 + c4; s[0] = v.x; s[1] = v.y; s[2] = v.z; s[3] = v.w; }
    LDS_WAIT();
    const int c = lane & 7;
#pragma unroll
    for (int j = 0; j < 8; ++j) { const int n = (lane >> 3) + 8 * j; const LAS float* s = scr + (8 * c) * 65 + n;
        v4u o; o.x = cvtpk(s[0 * 65], s[1 * 65]); o.y = cvtpk(s[2 * 65], s[3 * 65]); o.z = cvtpk(s[4 * 65], s[5 * 65]); o.w = cvtpk(s[6 * 65], s[7 * 65]);
        const int ng = n0 + n; const int R = mode == 0 ? ng : ((ng >> 2) * 8 + (ng & 3) + (mode == 2 ? 4 : 0));
        *(v4u*)(WT + (size_t)R * K + k0 + 8 * c) = o; }
    LDS_WAIT();
}
#define TJOB(Wp, Kk, Nn, WTp, mode) { const int ni_ = ((Kk) / 64) * ((Nn) / 64); if (r < ni_) { transpose_item((Wp), (Kk), (Nn), (WTp), (mode), scr, r, lane); continue; } r -= ni_; }

__device__ __forceinline__ void convert_ffn_weights(const Args& A, int l, LAS float* scr, int gw, int NGW, int lane) {
    bf16* wgu = (bf16*)(A.ws + WS_WGU); bf16* wd = (bf16*)(A.ws + WS_WD);
    constexpr int NI = 3 * (DM / 64) * (DFF / 64);
    for (int it = gw; it < NI; it += NGW) { int r = it;
        TJOB(A.w_gate + (size_t)l * DM * DFF, DM, DFF, wgu, 1)
        TJOB(A.w_up + (size_t)l * DM * DFF, DM, DFF, wgu, 2)
        TJOB(A.w_down + (size_t)l * DFF * DM, DFF, DM, wd, 0)
    }
}
__device__ __forceinline__ void convert_mix_weights(const Args& A, LAS float* scr, int gw, int NGW, int lane) {
    constexpr int I_IN = (DM / 64) * (DIN / 64), I_OUT = (DM / 64) * (DM / 64), I_PW = 64, I_POOL = 16, NL = I_IN + I_OUT + I_PW + I_POOL;
    for (int it = gw; it < DEPTH * NL; it += NGW) { const int l = it / NL; int r = it - l * NL;
        if (r < I_IN) { transpose_item(A.w_in + (size_t)l * DM * DIN, DM, DIN, (bf16*)(A.ws + WS_WIN) + (size_t)l * DIN * DM, 0, scr, r, lane); continue; } r -= I_IN;
        if (r < I_OUT) { transpose_item(A.w_out + (size_t)l * DM * DM, DM, DM, (bf16*)(A.ws + WS_WOUT) + (size_t)l * DM * DM, 0, scr, r, lane); continue; } r -= I_OUT;
        if (r < I_PW) { transpose_item(A.w_pw + (size_t)l * 512 * 512, 512, 512, (bf16*)(A.ws + WS_WSM + 256 * 1024) + (size_t)l * 512 * 512, 0, scr, r, lane); continue; } r -= I_PW;
        { const int g = r >> 2; transpose_item(A.w_pool + (size_t)(l * 4 + g) * 128 * 128, 128, 128, (bf16*)(A.ws + WS_WSM) + (size_t)(l * 4 + g) * 128 * 128, 0, scr, r & 3, lane); }
    }
}

__device__ __forceinline__ float dot4(f32x4 a) { return (a.x * a.x + a.y * a.y) + (a.z * a.z + a.w * a.w); }
__device__ __forceinline__ void store_u_row(bf16* urow, const f32x4 (&hv)[8], float r, const float* g, int lane) {
#pragma unroll
    for (int j = 0; j < 8; ++j) { const f32x4 gv = ((const f32x4*)g)[lane + 64 * j]; v2u w; w.x = cvtpk(hv[j].x * r * gv.x, hv[j].y * r * gv.y); w.y = cvtpk(hv[j].z * r * gv.z, hv[j].w * r * gv.w);
        ((v2u*)urow)[lane + 64 * j] = w; }
}
__device__ __forceinline__ void init_rows(const Args& A, int gw, int NGW, int lane) {
    unsigned char* wsb = gptr(A.ws); float* h = (float*)(wsb + WS_H); bf16* u = (bf16*)(wsb + WS_U); const float* pg = gptr(A.pre_mix_g);
    for (int m = gw; m < MV; m += NGW) {
        const float* src = m < MR ? gptr(A.x) + (size_t)m * DM : gptr(A.meta) + (size_t)(m - MR) * DM;
        f32x4 hv[8]; float ss = 0.f;
#pragma unroll
        for (int j = 0; j < 8; ++j) { hv[j] = ((const f32x4*)src)[lane + 64 * j]; ss += dot4(hv[j]); ((f32x4*)(h + (size_t)m * DM))[lane + 64 * j] = hv[j]; }
        const float r = rsqrtf(wave_sum(ss) * (1.0f / DM) + EPS);
        store_u_row(u + (size_t)m * DM, hv, r, pg, lane);
    }
}
__device__ __forceinline__ void row_phase(const Args& A, const float* g1, const float* g2, float* dout, int nrows, int gw, int NGW, int lane) {
    unsigned char* wsb = gptr(A.ws); float* h = (float*)(wsb + WS_H); bf16* u = (bf16*)(wsb + WS_U); const float* src = (const float*)(wsb + WS_OUT); g1 = gptr(g1); g2 = gptr(g2); dout = gptr(dout);
    for (int m = gw; m < nrows; m += NGW) {
        f32x4 o[8], hv[8]; float ss = 0.f;
#pragma unroll
        for (int j = 0; j < 8; ++j) { o[j] = ((const f32x4*)(src + (size_t)m * DM))[lane + 64 * j]; hv[j] = ((const f32x4*)(h + (size_t)m * DM))[lane + 64 * j]; ss += dot4(o[j]); }
        const float r = rsqrtf(wave_sum(ss) * (1.0f / DM) + EPS);
        float ss2 = 0.f;
#pragma unroll
        for (int j = 0; j < 8; ++j) { const f32x4 gv = ((const f32x4*)g1)[lane + 64 * j]; hv[j] = hv[j] + o[j] * r * gv; ss2 += dot4(hv[j]); }
        if (dout) {
            if (m < MR) {
#pragma unroll
                for (int j = 0; j < 8; ++j) ((f32x4*)(dout + (size_t)m * DM))[lane + 64 * j] = hv[j];
            }
        } else {
#pragma unroll
            for (int j = 0; j < 8; ++j) ((f32x4*)(h + (size_t)m * DM))[lane + 64 * j] = hv[j];
            const float r2 = rsqrtf(wave_sum(ss2) * (1.0f / DM) + EPS);
            store_u_row(u + (size_t)m * DM, hv, r2, g2, lane);
        }
    }
}

template <int MODE> __device__ __forceinline__ void skinny_gemm(const bf16* __restrict__ Arows, const bf16* __restrict__ Bt, int N, int K, void* O, int ldc, LAS unsigned char* lds, int lane, int wave) {
    const int li = lane & 15, fq = lane >> 4; const int nks = K >> 5;
    LAS f32x4* part = (LAS f32x4*)lds;
    for (int blk = blockIdx.x; blk < (N >> 4); blk += gridDim.x) {
        const bf16* bp = Bt + (size_t)(blk * 16 + li) * K + 8 * fq; const bf16* ap = Arows + (size_t)li * K + 8 * fq;
        f32x4 acc = (f32x4){0.f, 0.f, 0.f, 0.f};
#pragma unroll 8
        for (int ks = wave; ks < nks; ks += 8) { const bf16x8 wf = *(const bf16x8*)(bp + ks * 32); const bf16x8 af = *(const bf16x8*)(ap + ks * 32); acc = mfma16(wf, af, acc); }
        part[wave * 64 + lane] = acc;
        __syncthreads();
        if (wave == 0) {
            f32x4 v = part[lane];
#pragma unroll
            for (int w8 = 1; w8 < 8; ++w8) v = v + part[w8 * 64 + lane];
            const int n0 = blk * 16 + 4 * fq;
            if (MODE == 0) { const float sc = n0 < 1024 ? 0.125f : 1.0f; v2u w; w.x = cvtpk(v.x * sc, v.y * sc); w.y = cvtpk(v.z * sc, v.w * sc); *(v2u*)((bf16*)O + (size_t)(MR + li) * ldc + n0) = w; }
            else if (MODE == 1) { *(f32x4*)((float*)O + (size_t)(MR + li) * ldc + n0) = v; }
            else { f32x4 up; up.x = __shfl_xor(v.x, 16); up.y = __shfl_xor(v.y, 16); up.z = __shfl_xor(v.z, 16); up.w = __shfl_xor(v.w, 16);
                if ((fq & 1) == 0) { v2u w; w.x = cvtpk(v.x * sigmoidf_(v.x) * up.x, v.y * sigmoidf_(v.y) * up.y); w.y = cvtpk(v.z * sigmoidf_(v.z) * up.z, v.w * sigmoidf_(v.w) * up.w);
                    *(v2u*)((bf16*)O + (size_t)(MR + li) * ldc + blk * 8 + 4 * (fq >> 1)) = w; } }
        }
        __syncthreads();
    }
}

constexpr int VPITCH = 128;
constexpr int ML_V = 0, ML_ST = 8 * 64 * VPITCH  , ML_RED = ML_ST + 65536, ML_Y = 0  , ML_AB = ML_Y + 16 * 516 * 4;
static_assert(ML_RED + 3 * 512 <= LDS_BYTES && ML_AB + 16 * 1040 <= ML_ST, "mixer LDS");

__device__ __forceinline__ float softplus_(float z) { const float t = __builtin_amdgcn_exp2f(-LOG2E * __builtin_fabsf(z)); return __builtin_fmaxf(z, 0.f) + LN2 * __builtin_amdgcn_logf(1.0f + t); }
__device__ __forceinline__ void split_pack(const f32x4& a, const f32x4& b, bf16x8& hi, bf16x8& lo) {
    v4u h, l;
    h.x = cvtpk(a[0], a[1]); h.y = cvtpk(a[2], a[3]); h.z = cvtpk(b[0], b[1]); h.w = cvtpk(b[2], b[3]);
    l.x = cvtpk(a[0] - bflo(h.x), a[1] - bfhi(h.x)); l.y = cvtpk(a[2] - bflo(h.y), a[3] - bfhi(h.y));
    l.z = cvtpk(b[0] - bflo(h.z), b[1] - bfhi(h.z)); l.w = cvtpk(b[2] - bflo(h.w), b[3] - bfhi(h.w));
    hi = __builtin_bit_cast(bf16x8, h); lo = __builtin_bit_cast(bf16x8, l);
}
__device__ __forceinline__ void sb_attention(const bf16* __restrict__ proj, int b, int p0, int hd, LAS unsigned char* vl, int lane, f32x4 (&o)[4]) {
    const int li = lane & 15, fq = lane >> 4;
    const int qpos = p0 + li;
    const bf16* qp = proj + (size_t)rowidx(b, qpos) * DIN + hd * 64 + fq * 8;
    const bf16x8 qf0 = *(const bf16x8*)qp, qf1 = *(const bf16x8*)(qp + 32);
    unsigned d0 = 0u, d1 = 0u;
    { const unsigned one = 0x3F80u; d0 = ((4 * fq + 0 >= li) ? one : 0u) | ((4 * fq + 1 >= li) ? (one << 16) : 0u); d1 = ((4 * fq + 2 >= li) ? one : 0u) | ((4 * fq + 3 >= li) ? (one << 16) : 0u); }
    const unsigned ONE2 = 0x3F803F80u;
    const bf16x8 F_D1 = __builtin_bit_cast(bf16x8, (v4u){d0, d1, ONE2, ONE2});
    const bf16x8 F_11 = __builtin_bit_cast(bf16x8, (v4u){ONE2, ONE2, ONE2, ONE2});
    const bf16x8 F_0D = __builtin_bit_cast(bf16x8, (v4u){0u, 0u, d0, d1});
#pragma unroll
    for (int i = 0; i < 4; ++i) o[i] = (f32x4){0.f, 0.f, 0.f, 0.f};
    float carry = 0.f;
    const int ktd = p0 >> 6;
    const unsigned trbase = (unsigned)((4 * fq + (li >> 2)) * VPITCH + (lane & 3) * 8);
    bf16x8 kf[4][2];
#define SB_LOADK(KT) do { _Pragma("unroll") for (int kb = 0; kb < 4; ++kb) { int kp = 64 * (KT) + 16 * kb + li; kp = kp < LSEQ ? kp : LSEQ - 1; const bf16* kr = proj + (size_t)rowidx(b, kp) * DIN + C_K + hd * 64 + fq * 8; \
        kf[kb][0] = *(const bf16x8*)kr; kf[kb][1] = *(const bf16x8*)(kr + 32); } } while (0)
    SB_LOADK(ktd);
    for (int kt = ktd; kt >= 0; --kt) {
        const bool diag = (kt == ktd);
#pragma unroll
        for (int it = 0; it < 8; ++it) { const int key = it * 8 + (lane >> 3); int kp = 64 * kt + key; kp = kp < LSEQ ? kp : LSEQ - 1;
            __builtin_amdgcn_global_load_lds((const unsigned*)(proj + (size_t)rowidx(b, kp) * DIN + C_V + hd * 64 + (lane & 7) * 8), (LAS unsigned*)(vl + it * 1024), 16, 0, 0); }
        f32x4 s[4], lnb[4];
#pragma unroll
        for (int kb = 0; kb < 4; ++kb) { s[kb] = mfma16(kf[kb][0], qf0, (f32x4){0.f, 0.f, 0.f, 0.f}); s[kb] = mfma16(kf[kb][1], qf1, s[kb]); }
        { const int ktn = kt > 0 ? kt - 1 : 0; SB_LOADK(ktn); }
#pragma unroll
        for (int kb = 0; kb < 4; ++kb)
#pragma unroll
            for (int e = 0; e < 4; ++e) { const bool m = !diag || (64 * kt + 16 * kb + 4 * fq + e < qpos); lnb[kb][e] = m ? -softplus_(s[kb][e]) : 0.f; }
        bf16x8 bh[2], bl[2];
        split_pack(lnb[0], lnb[1], bh[0], bl[0]); split_pack(lnb[2], lnb[3], bh[1], bl[1]);
        f32x4 c[4];
#pragma unroll
        for (int i = 0; i < 4; ++i) c[i] = (f32x4){carry, carry, carry, carry};
        c[0] = mfma16(F_D1, bh[0], c[0]); c[0] = mfma16(F_D1, bl[0], c[0]); c[0] = mfma16(F_11, bh[1], c[0]); c[0] = mfma16(F_11, bl[1], c[0]);
        c[1] = mfma16(F_0D, bh[0], c[1]); c[1] = mfma16(F_0D, bl[0], c[1]); c[1] = mfma16(F_11, bh[1], c[1]); c[1] = mfma16(F_11, bl[1], c[1]);
        c[2] = mfma16(F_D1, bh[1], c[2]); c[2] = mfma16(F_D1, bl[1], c[2]);
        c[3] = mfma16(F_0D, bh[1], c[3]); c[3] = mfma16(F_0D, bl[1], c[3]);
        f32x4 w[4];
#pragma unroll
        for (int kb = 0; kb < 4; ++kb)
#pragma unroll
            for (int e = 0; e < 4; ++e) { const bool m = !diag || (64 * kt + 16 * kb + 4 * fq + e < qpos); w[kb][e] = m ? __builtin_amdgcn_exp2f(LOG2E * (s[kb][e] + c[kb][e])) : 0.f; }
        carry = __shfl(c[0][0], li);
        v4u p0v, p1v;
        p0v.x = cvtpk(w[0][0], w[0][1]); p0v.y = cvtpk(w[0][2], w[0][3]); p0v.z = cvtpk(w[1][0], w[1][1]); p0v.w = cvtpk(w[1][2], w[1][3]);
        p1v.x = cvtpk(w[2][0], w[2][1]); p1v.y = cvtpk(w[2][2], w[2][3]); p1v.z = cvtpk(w[3][0], w[3][1]); p1v.w = cvtpk(w[3][2], w[3][3]);
        const bf16x8 pf0 = __builtin_bit_cast(bf16x8, p0v), pf1 = __builtin_bit_cast(bf16x8, p1v);
        asm volatile("s_waitcnt vmcnt(0)" ::: "memory");
#pragma unroll
        for (int db = 0; db < 4; ++db) {
#pragma unroll
            for (int s2 = 0; s2 < 2; ++s2) {
                const v4i16_t lo = __builtin_amdgcn_ds_read_tr16_b64_v4i16((LAS v4i16_t*)(vl + trbase + (32 * s2) * VPITCH + db * 32));
                const v4i16_t hi = __builtin_amdgcn_ds_read_tr16_b64_v4i16((LAS v4i16_t*)(vl + trbase + (32 * s2 + 16) * VPITCH + db * 32));
                const bf16x8 vf = (bf16x8){lo[0], lo[1], lo[2], lo[3], hi[0], hi[1], hi[2], hi[3]};
                o[db] = mfma16(vf, s2 == 0 ? pf0 : pf1, o[db]);
            }
        }
        if (__all(carry < SB_EXIT)) break;
    }
#undef SB_LOADK
}

template <int W> __device__ __forceinline__ void pool_group(const bf16* __restrict__ psrc, const bf16* __restrict__ wpt, int b, int pos, f32x4 (&pacc)[4]) {
    const int cnt = (pos + 1 < W) ? pos + 1 : W; const float inv = 1.0f / (float)cnt;
    constexpr int BW = W < 8 ? W : 8;
#pragma unroll 1
    for (int ks = 0; ks < 4; ++ks) {
        bf16x8 wf[4];
#pragma unroll
        for (int nb = 0; nb < 4; ++nb) wf[nb] = *(const bf16x8*)(wpt + (size_t)nb * 16 * 128 + 32 * ks);
        float sum[8], self[8];
#pragma unroll
        for (int e = 0; e < 8; ++e) { sum[e] = 0.f; self[e] = 0.f; }
#pragma unroll
        for (int j0 = 0; j0 < W; j0 += BW) {
            v4u v[BW];
#pragma unroll
            for (int j = 0; j < BW; ++j) { const int pp = pos - j0 - j; v[j] = *(const v4u*)(psrc + (size_t)rowidx(b, pp >= 0 ? pp : 0) * DIN + 32 * ks); }
#pragma unroll
            for (int j = 0; j < BW; ++j) { const float f = (pos - j0 - j) >= 0 ? 1.0f : 0.0f;
                sum[0] += f * bflo(v[j].x); sum[1] += f * bfhi(v[j].x); sum[2] += f * bflo(v[j].y); sum[3] += f * bfhi(v[j].y);
                sum[4] += f * bflo(v[j].z); sum[5] += f * bfhi(v[j].z); sum[6] += f * bflo(v[j].w); sum[7] += f * bfhi(v[j].w); }
            if (j0 == 0) { self[0] = bflo(v[0].x); self[1] = bfhi(v[0].x); self[2] = bflo(v[0].y); self[3] = bfhi(v[0].y); self[4] = bflo(v[0].z); self[5] = bfhi(v[0].z); self[6] = bflo(v[0].w); self[7] = bfhi(v[0].w); }
            if (j0 + BW < W) __builtin_amdgcn_sched_barrier(0);
        }
        v4u pk; pk.x = cvtpk(sum[0] * inv - self[0], sum[1] * inv - self[1]); pk.y = cvtpk(sum[2] * inv - self[2], sum[3] * inv - self[3]);
        pk.z = cvtpk(sum[4] * inv - self[4], sum[5] * inv - self[5]); pk.w = cvtpk(sum[6] * inv - self[6], sum[7] * inv - self[7]);
        const bf16x8 pf = __builtin_bit_cast(bf16x8, pk);
#pragma unroll
        for (int nb = 0; nb < 4; ++nb) pacc[nb] = mfma16(wf[nb], pf, pacc[nb]);
    }
}

__device__ __forceinline__ void mixer_phase(const Args& A, int l, LAS unsigned char* lds, int tid0, int wave) {
    unsigned char* wsb = gptr(A.ws);
    const bf16* proj = (const bf16*)(wsb + WS_PROJ); bf16* merged = (bf16*)(wsb + WS_MERGED);
    const bf16* wpool_t = (const bf16*)(wsb + WS_WSM) + (size_t)l * 4 * 128 * 128;
    const bf16* wpw_t = (const bf16*)(wsb + WS_WSM + 256 * 1024) + (size_t)l * 512 * 512;
    const float* wdw = gptr(A.w_dw) + (size_t)l * 31 * 512; const float* bdw = gptr(A.b_dw) + l * 512; const float* lng = gptr(A.conv_ln_g) + l * 512; const float* lnb_ = gptr(A.conv_ln_b) + l * 512;
    const float* psc = gptr(A.pool_scale) + l * 512; const float* mg = gptr(A.mix_out_g) + (size_t)l * DM;
    LAS float* Y = (LAS float*)(lds + ML_Y); LAS unsigned short* Ab = (LAS unsigned short*)(lds + ML_AB); LAS float* red = (LAS float*)(lds + ML_RED);
    LAS unsigned char* vl = lds + ML_V + wave * (64 * VPITCH); LAS unsigned char* st = lds + ML_ST + wave * 8192;
    const int nunits = (l + 1 < DEPTH) ? 513 : 512;
    for (int ui = blockIdx.x; ui < nunits; ui += gridDim.x) {
        int ti = ui;
        if (gridDim.x == 256 && ui < 512) { const int w = ui & 255, rnd = ui >> 8; ti = 256 * (w >> 7) + (rnd == 0 ? 128 : 0) + (w & 127); }
        int b, p0; if (ti < 512) { b = ti >> 8; p0 = 16 + 16 * (ti & 255); } else { b = 0; p0 = 0; }
        int tid_l = tid0; asm volatile("" : "+v"(tid_l));
        const int tid = tid_l, lane = tid & 63, li = lane & 15, fq = lane >> 4;
#pragma unroll 1
        for (int hh = 0; hh < 2; ++hh) { f32x4 o0[4];
            sb_attention(proj, b, p0, 2 * wave + hh, vl, lane, o0);
#pragma unroll
            for (int db = 0; db < 4; ++db) *(LAS f32x4*)(st + ((hh * 4 + db) * 64 + lane) * 16) = o0[db]; }
        __syncthreads();
        {
            const int c = tid; const bf16* pa = proj + C_CA + c;
            float glu[46];
#pragma unroll
            for (int r = 0; r < 46; ++r) { const int pos = p0 - 30 + r; float gv = 0.f;
                if (pos >= 0) { const size_t row = (size_t)rowidx(b, pos); const float a = bf2f(pa[row * DIN]); const float gt = bf2f(pa[row * DIN + 512]); gv = a * sigmoidf_(gt); }
                glu[r] = gv;
                if ((r & 15) == 15) __builtin_amdgcn_sched_barrier(0); }
            const float* wdc = wdw + c; asm volatile("" : "+v"(wdc));
            float y[16]; const float bias = bdw[c];
#pragma unroll
            for (int t = 0; t < 16; ++t) y[t] = bias;
#pragma unroll
            for (int j = 0; j < 31; ++j) { const float w = wdc[j * 512];
#pragma unroll
                for (int t = 0; t < 16; ++t) y[t] += w * glu[t + j]; }
#pragma unroll
            for (int t = 0; t < 16; ++t) Y[t * 516 + c] = y[t];
        }
        __syncthreads();
#pragma unroll
        for (int tt = 0; tt < 2; ++tt) { const int t = 2 * wave + tt; float v[8]; float sm = 0.f;
#pragma unroll
            for (int i = 0; i < 8; ++i) { v[i] = Y[t * 516 + lane + 64 * i]; sm += v[i]; }
            const float mean = wave_sum(sm) * (1.0f / 512.0f); float q = 0.f;
#pragma unroll
            for (int i = 0; i < 8; ++i) { v[i] -= mean; q += v[i] * v[i]; }
            const float rstd = rsqrtf(wave_sum(q) * (1.0f / 512.0f) + EPS);
#pragma unroll
            for (int i = 0; i < 8; ++i) { const int c = lane + 64 * i; const float yn = v[i] * rstd * lng[c] + lnb_[c]; const float a = yn * sigmoidf_(yn); Ab[t * 520 + c] = (unsigned short)(cvtpk(a, 0.f) & 0xffffu); }
        }
        __syncthreads();
        f32x4 cacc[4];
#pragma unroll
        for (int i = 0; i < 4; ++i) cacc[i] = (f32x4){0.f, 0.f, 0.f, 0.f};
        { const bf16* wp = wpw_t + (size_t)(64 * wave + li) * 512 + 8 * fq; const LAS unsigned char* ab = (const LAS unsigned char*)Ab + li * 1040 + fq * 16;
#pragma unroll 4
            for (int ks = 0; ks < 16; ++ks) { const bf16x8 bfr = *(const LAS bf16x8*)(ab + ks * 64);
#pragma unroll
                for (int nb = 0; nb < 4; ++nb) { const bf16x8 wf = *(const bf16x8*)(wp + (size_t)nb * 16 * 512 + ks * 32); cacc[nb] = mfma16(wf, bfr, cacc[nb]); } } }
        f32x4 pacc[4];
#pragma unroll
        for (int i = 0; i < 4; ++i) pacc[i] = (f32x4){0.f, 0.f, 0.f, 0.f};
        { const int g = wave >> 1, nh = wave & 1;
            const bf16* wpt = wpool_t + (size_t)(g * 128 + 64 * nh + li) * 128 + 8 * fq; const bf16* psrc = proj + C_POOL + 128 * g + 8 * fq;
            if (g == 0) pool_group<2>(psrc, wpt, b, p0 + li, pacc); else if (g == 1) pool_group<4>(psrc, wpt, b, p0 + li, pacc); else if (g == 2) pool_group<8>(psrc, wpt, b, p0 + li, pacc); else pool_group<16>(psrc, wpt, b, p0 + li, pacc); }
        f32x4 oa[2][4];
#pragma unroll
        for (int hh = 0; hh < 2; ++hh)
#pragma unroll
            for (int db = 0; db < 4; ++db) oa[hh][db] = *(const LAS f32x4*)(st + ((hh * 4 + db) * 64 + lane) * 16);
        float ssa = 0.f, ssp = 0.f, ssc = 0.f;
        { const int g = wave >> 1, nh = wave & 1;
#pragma unroll
            for (int nb = 0; nb < 4; ++nb) { const f32x4 sc = *(const f32x4*)(psc + 128 * g + 64 * nh + 16 * nb + 4 * fq); pacc[nb] = pacc[nb] * sc; ssp += dot4(pacc[nb]); ssc += dot4(cacc[nb]); ssa += dot4(oa[0][nb]) + dot4(oa[1][nb]); } }
        ssa += __shfl_xor(ssa, 16); ssa += __shfl_xor(ssa, 32); ssp += __shfl_xor(ssp, 16); ssp += __shfl_xor(ssp, 32); ssc += __shfl_xor(ssc, 16); ssc += __shfl_xor(ssc, 32);
        if (lane < 16) { red[wave * 16 + lane] = ssa; red[128 + wave * 16 + lane] = ssp; red[256 + wave * 16 + lane] = ssc; }
        __syncthreads();
        float ta = 0.f, tp = 0.f, tc = 0.f;
#pragma unroll
        for (int w8 = 0; w8 < 8; ++w8) { ta += red[w8 * 16 + li]; tp += red[128 + w8 * 16 + li]; tc += red[256 + w8 * 16 + li]; }
        const float ra = rsqrtf(ta * (1.0f / DATT) + EPS), rp = rsqrtf(tp * (1.0f / DPOOL) + EPS), rc = rsqrtf(tc * (1.0f / DCONV) + EPS);
        bf16* orow = merged + (size_t)rowidx(b, p0 + li) * DM;
#pragma unroll
        for (int hh = 0; hh < 2; ++hh)
#pragma unroll
            for (int db = 0; db < 4; ++db) { const int col = (2 * wave + hh) * 64 + 16 * db + 4 * fq; const f32x4 gv = *(const f32x4*)(mg + col); const f32x4 v = oa[hh][db] * ra * gv;
                v2u w2; w2.x = cvtpk(v.x, v.y); w2.y = cvtpk(v.z, v.w); *(v2u*)(orow + col) = w2; }
        { const int g = wave >> 1, nh = wave & 1;
#pragma unroll
            for (int nb = 0; nb < 4; ++nb) { const int col = DATT + 128 * g + 64 * nh + 16 * nb + 4 * fq; const f32x4 gv = *(const f32x4*)(mg + col); const f32x4 v = pacc[nb] * rp * gv;
                v2u w2; w2.x = cvtpk(v.x, v.y); w2.y = cvtpk(v.z, v.w); *(v2u*)(orow + col) = w2; } }
#pragma unroll
        for (int nb = 0; nb < 4; ++nb) { const int col = DATT + DPOOL + 64 * wave + 16 * nb + 4 * fq; const f32x4 gv = *(const f32x4*)(mg + col); const f32x4 v = cacc[nb] * rc * gv;
            v2u w2; w2.x = cvtpk(v.x, v.y); w2.y = cvtpk(v.z, v.w); *(v2u*)(orow + col) = w2; }
        __syncthreads();
    }
}

#define XB_TMO      128
#define XB_XCNT(j)  (256  + 64 * (j))
#define XB_XSUB(j)  (1280 + 64 * (j))
#define XB_XGEN(j)  (2304 + 64 * (j))
#define XB_TOP      3328
#define XB_TOPGEN   3392
#define XCD_BAR_WORDS 3456
#define XB_SPIN_CAP (1u << 18)

__device__ __forceinline__ unsigned xb_ld(unsigned* p)              { return __hip_atomic_load(p, __ATOMIC_RELAXED, __HIP_MEMORY_SCOPE_AGENT); }
__device__ __forceinline__ unsigned xb_add(unsigned* p, unsigned v) { return __hip_atomic_fetch_add(p, v, __ATOMIC_RELAXED, __HIP_MEMORY_SCOPE_AGENT); }
__device__ __forceinline__ unsigned xb_xcc_id() { return (unsigned)__builtin_amdgcn_s_getreg((3 << 11) | 20) & 0xFu; }
#define XB_SPIN(cond, bar) do { unsigned _sp = 0; while (cond) { __builtin_amdgcn_s_sleep(1); \
    if ((++_sp & 255u) == 0u) { if (xb_ld(&(bar)[XB_TMO])) break; if (_sp > XB_SPIN_CAP) { atomicAdd(&(bar)[XB_TMO], 1u); break; } } } } while (0)

struct XcdBarrier {
    unsigned* bar; unsigned x;
    volatile LAS unsigned* st;
};

__device__ __forceinline__ XcdBarrier xcd_barrier_post(unsigned* bar, volatile LAS unsigned* st) {
    XcdBarrier b; b.bar = bar; b.x = xb_xcc_id(); b.st = st;
    if (threadIdx.x == 0) (void)xb_add(&bar[XB_XCNT(b.x)], 1u);
    return b;
}
__device__ __forceinline__ void xcd_barrier_complete(unsigned* bar, unsigned x, unsigned& nloc, unsigned& nx) {
    const unsigned G = gridDim.x * gridDim.y * gridDim.z;
    unsigned sum, cnt, mine, sp = 0u;
    for (;;) {
        sum = 0u; cnt = 0u; mine = 0u;
#pragma unroll
        for (unsigned j = 0; j < 16; ++j) { const unsigned c = xb_ld(&bar[XB_XCNT(j)]); sum += c; cnt += (c > 0u) ? 1u : 0u; mine = (j == x) ? c : mine; }
        if (sum == G) break;
        __builtin_amdgcn_s_sleep(1);
        if ((++sp & 255u) == 0u) { if (xb_ld(&bar[XB_TMO])) break; if (sp > XB_SPIN_CAP) { atomicAdd(&bar[XB_TMO], 1u); break; } }
    }
    nloc = mine > 0u ? mine : 1u; nx = cnt > 0u ? cnt : 1u;
}

__device__ __forceinline__ void xcd_barrier(const XcdBarrier& b) {
    asm volatile("s_waitcnt vmcnt(0)" ::: "memory");
    __syncthreads();
    if (threadIdx.x == 0) {
        unsigned* bar = b.bar;
        __builtin_amdgcn_s_waitcnt(0);
        unsigned nloc = b.st[0], nx = b.st[1];
        if (nloc == 0u) { xcd_barrier_complete(bar, b.x, nloc, nx); b.st[0] = nloc; b.st[1] = nx; }
        const unsigned old = xb_add(&bar[XB_XSUB(b.x)], 1u);
        const unsigned gen = old / nloc;
        if (old + 1u == (gen + 1u) * nloc) {
            __builtin_amdgcn_fence(__ATOMIC_RELEASE, "agent");
            asm volatile("s_waitcnt vmcnt(0)" ::: "memory");
            const unsigned og = xb_add(&bar[XB_TOP], 1u);
            const unsigned tg = og / nx;
            if (og + 1u == (tg + 1u) * nx) xb_add(&bar[XB_TOPGEN], 1u);
            else XB_SPIN(xb_ld(&bar[XB_TOPGEN]) == tg, bar);
            __builtin_amdgcn_fence(__ATOMIC_ACQUIRE, "agent");
            xb_add(&bar[XB_XGEN(b.x)], 1u);
            asm volatile("s_waitcnt vmcnt(0)" ::: "memory");
        } else {
            XB_SPIN(xb_ld(&bar[XB_XGEN(b.x)]) == gen, bar);
            __builtin_amdgcn_fence(__ATOMIC_ACQUIRE, "agent");
            asm volatile("s_waitcnt vmcnt(0)" ::: "memory");
        }
    }
    __syncthreads();
}

constexpr int NPHASE = 1 + 7 * DEPTH;
#define PHASE_ENTER() int tid_ = threadIdx.x; asm volatile("" : "+v"(tid_)); const int tid = tid_, lane = tid & 63, wave = __builtin_amdgcn_readfirstlane(tid >> 6); \
    const __attribute__((address_space(4))) Args* ka_ = (const __attribute__((address_space(4))) Args*)__builtin_amdgcn_kernarg_segment_ptr(); asm volatile("" : "+s"(ka_)); Args A; __builtin_memcpy(&A, ka_, sizeof(Args)); \
    const int G = gridDim.x, gw = blockIdx.x * 8 + wave, NGW = G * 8; LAS float* scr = (LAS float*)(lds + wave * 16640); (void)tid; (void)lane; (void)gw; (void)NGW; (void)scr; (void)G;
__global__ void __launch_bounds__(512, 2) fwd_megakernel(Args args) {
    extern __shared__ __attribute__((aligned(16))) unsigned char lds_raw[];
    LAS unsigned char* lds = (LAS unsigned char*)lds_raw;
    cg::grid_group grid = cg::this_grid();
    const int lo = args.ph_lo, hi = args.ph_hi;
    volatile LAS unsigned* bst = (volatile LAS unsigned*)(lds + LDS_BYTES - 64);
    if (threadIdx.x < 16) bst[threadIdx.x] = 0u;
    __syncthreads();
    XcdBarrier bar = xcd_barrier_post((unsigned*)(args.ws + WS_CTL), bst);
#if !MK_SPLIT
    grid.sync();
#endif
#define IN(k) (lo <= (k) && (k) < hi)
#define SEAM(k) do { if (IN(k) && IN((k) + 1)) xcd_barrier(bar); } while (0)
    int k = 0;
    for (int rep = 0; rep < ((PROBE_DUP & 1) ? 2 : 1); ++rep) if (IN(k)) { if (rep) xcd_barrier(bar); PHASE_ENTER(); convert_mix_weights(A, scr, gw, NGW, lane); convert_ffn_weights(A, 0, scr, gw, NGW, lane); init_rows(A, gw, NGW, lane); }
    SEAM(k); ++k;
    for (int l = 0; l < DEPTH; ++l) {
        for (int rep = 0; rep < ((PROBE_DUP & 4) ? 2 : 1); ++rep) if (IN(k)) { if (rep) xcd_barrier(bar); PHASE_ENTER(); unsigned char* wsb = gptr(A.ws);
            pg8::Gemm g{(const bf16*)(wsb + WS_U), (const bf16*)(wsb + WS_WIN) + (size_t)l * DIN * DM, MR, DIN, DM}; pg8::StaticOrder S; S.init(MR, DIN, G, (int)blockIdx.x);
            pg8::EpiBf16<0> E{(bf16*)(wsb + WS_PROJ), DIN, nullptr, 1024, 1024, 0.125f};
            pg8::gemm_phase<pg8::EpiBf16<0>, pg8::StaticOrder, PG8_ALIGN, PG8_SP2>(lds, g, S, E);
            __syncthreads(); skinny_gemm<0>((const bf16*)(wsb + WS_U) + (size_t)MR * DM, (const bf16*)(wsb + WS_WIN) + (size_t)l * DIN * DM, DIN, DM, (void*)(wsb + WS_PROJ), DIN, lds, lane, wave);
        }
        SEAM(k); ++k;
        for (int rep = 0; rep < ((PROBE_DUP & 2) ? 2 : 1); ++rep) if (IN(k)) { if (rep) xcd_barrier(bar); PHASE_ENTER(); mixer_phase(A, l, lds, tid, wave); }
        SEAM(k); ++k;
        for (int rep = 0; rep < ((PROBE_DUP & 16) ? 2 : 1); ++rep) if (IN(k)) { if (rep) xcd_barrier(bar); PHASE_ENTER(); unsigned char* wsb = gptr(A.ws);
            pg8::Gemm g{(const bf16*)(wsb + WS_MERGED), (const bf16*)(wsb + WS_WOUT) + (size_t)l * DM * DM, MR, DM, DM}; pg8::StaticOrder S; S.init(MR, DM, G, (int)blockIdx.x);
            pg8::EpiF32 E{(float*)(wsb + WS_OUT), DM};
            pg8::gemm_phase<pg8::EpiF32, pg8::StaticOrder, PG8_ALIGN, PG8_SP2>(lds, g, S, E);
            __syncthreads(); if (l + 1 < DEPTH) skinny_gemm<1>((const bf16*)(wsb + WS_MERGED) + (size_t)MR * DM, (const bf16*)(wsb + WS_WOUT) + (size_t)l * DM * DM, DM, DM, (void*)(wsb + WS_OUT), DM, lds, lane, wave);
        }
        SEAM(k); ++k;
        if (IN(k)) { PHASE_ENTER(); row_phase(A, A.post_mix_g + (size_t)l * DM, A.pre_ffn_g + (size_t)l * DM, nullptr, (l + 1 < DEPTH) ? MV : MR, gw, NGW, lane); }
        SEAM(k); ++k;
        for (int rep = 0; rep < ((PROBE_DUP & 32) ? 2 : 1); ++rep) if (IN(k)) { if (rep) xcd_barrier(bar); PHASE_ENTER(); unsigned char* wsb = gptr(A.ws);
            pg8::Gemm g{(const bf16*)(wsb + WS_U), (const bf16*)(wsb + WS_WGU), MR, 2 * DFF, DM}; pg8::StaticOrder S; S.init(MR, 2 * DFF, G, (int)blockIdx.x);
            pg8::EpiSwiGLU E{(bf16*)(wsb + WS_ACT), DFF};
            pg8::gemm_phase<pg8::EpiSwiGLU, pg8::StaticOrder, PG8_ALIGN, PG8_SP2>(lds, g, S, E);
            __syncthreads(); if (l + 1 < DEPTH) skinny_gemm<2>((const bf16*)(wsb + WS_U) + (size_t)MR * DM, (const bf16*)(wsb + WS_WGU), 2 * DFF, DM, (void*)(wsb + WS_ACT), DFF, lds, lane, wave);
        }
        SEAM(k); ++k;
        for (int rep = 0; rep < ((PROBE_DUP & 8) ? 2 : 1); ++rep) if (IN(k)) { if (rep) xcd_barrier(bar); PHASE_ENTER(); unsigned char* wsb = gptr(A.ws);
            pg8::Gemm g{(const bf16*)(wsb + WS_ACT), (const bf16*)(wsb + WS_WD), MR, DM, DFF}; pg8::StaticOrder S; S.init(MR, DM, G, (int)blockIdx.x);
            pg8::EpiF32 E{(float*)(wsb + WS_OUT), DM};
            pg8::gemm_phase<pg8::EpiF32, pg8::StaticOrder, PG8_ALIGN, PG8_SP2>(lds, g, S, E);
            __syncthreads(); if (l + 1 < DEPTH) skinny_gemm<1>((const bf16*)(wsb + WS_ACT) + (size_t)MR * DFF, (const bf16*)(wsb + WS_WD), DM, DFF, (void*)(wsb + WS_OUT), DM, lds, lane, wave);
        }
        SEAM(k); ++k;
        if (IN(k)) { PHASE_ENTER();
            if (l + 1 < DEPTH) { convert_ffn_weights(A, l + 1, scr, gw, NGW, lane); row_phase(A, A.post_ffn_g + (size_t)l * DM, A.pre_mix_g + (size_t)(l + 1) * DM, nullptr, MV, gw, NGW, lane); }
            else row_phase(A, A.post_ffn_g + (size_t)l * DM, nullptr, A.out, MR, gw, NGW, lane);
        }
        if (l + 1 < DEPTH) { SEAM(k); } ++k;
    }
#undef IN
#undef SEAM
}

extern "C" void kernel_launch(void* const* d_in, const int* in_sizes, int n_in, void* d_out, int out_size, void* d_ws, size_t ws_size, hipStream_t stream) {
    static int grid = 0;
    if (grid == 0) {
        if (n_in != 19 || in_sizes[0] != MR * DM || out_size != MR * DM || ws_size < WS_END) { fprintf(stderr, "kernel_launch: unexpected problem (n_in %d, in0 %d, out %d, ws %zu, need %zu)\n", n_in, n_in > 0 ? in_sizes[0] : -1, out_size, ws_size, (size_t)WS_END); grid = -1; return; }
        int dev = 0, cus = 0, per_cu = 0;
        if (hipGetDevice(&dev) != hipSuccess || hipDeviceGetAttribute(&cus, hipDeviceAttributeMultiprocessorCount, dev) != hipSuccess) { grid = -1; return; }
        if (hipFuncSetAttribute((const void*)fwd_megakernel, hipFuncAttributeMaxDynamicSharedMemorySize, LDS_BYTES) != hipSuccess) { fprintf(stderr, "kernel_launch: hipFuncSetAttribute failed\n"); grid = -1; return; }
        if (hipOccupancyMaxActiveBlocksPerMultiprocessor(&per_cu, (const void*)fwd_megakernel, 512, LDS_BYTES) != hipSuccess || per_cu < 1) { fprintf(stderr, "kernel_launch: occupancy query says %d blocks per CU\n", per_cu); per_cu = 1; }
        (void)hipGetLastError();
        grid = cus;
    }
    if (grid < 0) return;
    if (hipMemsetAsync((unsigned char*)d_ws + WS_CTL, 0, CTL_BYTES, stream) != hipSuccess) { fprintf(stderr, "kernel_launch: hipMemsetAsync failed\n"); return; }
    Args a{};
    const float** ap = (const float**)&a;
    for (int i = 0; i < 19; ++i) ap[i] = (const float*)d_in[i];
    a.out = (float*)d_out; a.ws = (unsigned char*)d_ws;
#if MK_SPLIT
    for (int ph = 0; ph < NPHASE; ++ph) { a.ph_lo = ph; a.ph_hi = ph + 1; hipLaunchKernelGGL(fwd_megakernel, dim3(grid), dim3(512), LDS_BYTES, stream, a); }
#else
    a.ph_lo = 0; a.ph_hi = NPHASE;
    void* kargs[] = {(void*)&a};
    const hipError_t e = hipLaunchCooperativeKernel((const void*)fwd_megakernel, dim3(grid), dim3(512), kargs, LDS_BYTES, stream);
    if (e != hipSuccess) fprintf(stderr, "kernel_launch: cooperative launch failed: %s (grid %d)\n", hipGetErrorString(e), grid);
#endif
}
```

```cpp
#include <hip/hip_runtime.h>
#include <hip/hip_cooperative_groups.h>
#include <cstdio>
#include <cstdint>
namespace cg = cooperative_groups;
namespace pg8 {
#define PG8_LAS __attribute__((address_space(3)))
typedef unsigned short bf16_t;
typedef short bf16x8 __attribute__((ext_vector_type(8)));
typedef float f32x4 __attribute__((ext_vector_type(4)));
typedef unsigned u32x4 __attribute__((ext_vector_type(4)));
constexpr int BM = 256, BK = 64, HALF = 128, HTB = HALF * BK * 2  , STAGE_BYTES = 8 * HTB, NXCD = 8, WGM = 8;

__host__ __device__ __forceinline__ int lds_byte(int r, int c) { const int st = (r >> 4) * 2 + (c >> 5), rr = r & 15, cc = c & 31, ob = rr * 64 + cc * 2; return st * 1024 + (ob ^ (((ob >> 9) & 1) << 5)); }
__host__ __device__ __forceinline__ void stage_rc(int b, int& R, int& C) { const int st = b / 1024, sb = b % 1024, swz = sb ^ (((sb >> 9) & 1) << 5); R = (st >> 1) * 16 + swz / 64; C = (st & 1) * 32 + (swz % 64) / 2; }
__host__ __device__ __forceinline__ int perm32(int rho) { const int n = rho >> 4, i = rho & 15; return 8 * (i >> 2) + 4 * n + (i & 3); }

struct Unit { int pm, pn; };
struct Gemm { const bf16_t* A; const bf16_t* Bt; int M, N, K; };

struct StaticOrder {
    int nM, nN, nwg, G, c;
    __host__ __device__ void init(int M, int N, int G_, int c_) { nM = M / BM; nN = N / BM; nwg = nM * nN; G = G_; c = c_; }
    __host__ __device__ bool next(int i, Unit& u) const {
        const long L = (long)i * G + c; if (L >= nwg) return false;
        int wgid = (int)L; { const int q = nwg / NXCD, r = nwg % NXCD, xcd = wgid % NXCD, off = wgid / NXCD; wgid = (xcd < r ? xcd * (q + 1) : r * (q + 1) + (xcd - r) * q) + off; }
        const int nig = WGM * nN, gid = wgid / nig, fm = gid * WGM, gsz = (nM - fm) < WGM ? (nM - fm) : WGM;
        u.pm = fm + ((wgid % nig) % gsz); u.pn = (wgid % nig) / gsz; return true;
    }
    __device__ __forceinline__ void a_ready(const Unit&) const {}
    __device__ __forceinline__ void done(const Unit&) const {}
};

__device__ __forceinline__ unsigned cvt_pk_bf16(float lo, float hi) { unsigned r; asm volatile("v_cvt_pk_bf16_f32 %0, %1, %2" : "=v"(r) : "v"(lo), "v"(hi)); return r; }
typedef float f32x2 __attribute__((ext_vector_type(2)));
__device__ __forceinline__ f32x2 gelu_pk(f32x2 v) {
    const f32x2 av = __builtin_elementwise_abs(v), d = av * 0.2316418882f + 1.0f;
    f32x2 t; t.x = __builtin_amdgcn_rcpf(d.x); t.y = __builtin_amdgcn_rcpf(d.y);
    f32x2 q = t * 0.5307027145f + (-0.7265760135f); q = q * t + 0.7107068705f; q = q * t + (-0.142248368f); q = q * t + 0.127414796f; q = q * t;
    const f32x2 s = (v * v) * (-0.72134752044f);
    f32x2 e; e.x = __builtin_amdgcn_exp2f(s.x); e.y = __builtin_amdgcn_exp2f(s.y);
    const f32x2 m = v * (q * e), r = v - m;
    f32x2 o; o.x = v.x < 0.f ? m.x : r.x; o.y = v.y < 0.f ? m.y : r.y; return o;
}

template <int ACT  > struct EpiBf16 {
    static constexpr bool PERM = true, AFTER_DRAIN = false; static_assert(ACT == 0 || ACT == 1, "EpiBf16: ACT is 0 (none) or 1 (gelu_pk)");
    bf16_t* O; int ldc; const float* bias; int split_cols; size_t split_stride; float scale0;
    __device__ __forceinline__ void operator()(const f32x4 (&acc)[2][2][4][2], const Unit& u, int wr, int wc, int fr, int fq) const {
        const int row0 = u.pm * BM + wr * 64 + fr; int colt = u.pn * BM; bf16_t* base = O;
        float sc = 1.f; if (split_cols) { const int t = colt / split_cols; base += (size_t)t * split_stride; colt -= t * split_cols; if (t == 0) sc = scale0; }
        const int col0 = colt + wc * 32 + 8 * fq, bcol0 = u.pn * BM + wc * 32 + 8 * fq;
        f32x4 bv[2][2];
#pragma unroll
        for (int bj = 0; bj < 2; ++bj)
#pragma unroll
            for (int n = 0; n < 2; ++n) bv[bj][n] = bias ? *(const f32x4*)(bias + bcol0 + bj * HALF + 4 * n) : (f32x4){0.f, 0.f, 0.f, 0.f};
#pragma unroll
        for (int ai = 0; ai < 2; ++ai)
#pragma unroll
            for (int m = 0; m < 4; ++m) { bf16_t* rowp = base + (size_t)(row0 + ai * HALF + m * 16) * ldc + col0;
#pragma unroll
                for (int bj = 0; bj < 2; ++bj) { f32x4 v0 = acc[ai][bj][m][0] + bv[bj][0], v1 = acc[ai][bj][m][1] + bv[bj][1];
                    if (ACT == 1) { f32x2 a = gelu_pk((f32x2){v0[0], v0[1]}), b = gelu_pk((f32x2){v0[2], v0[3]}), c = gelu_pk((f32x2){v1[0], v1[1]}), d = gelu_pk((f32x2){v1[2], v1[3]});
                        v0 = (f32x4){a.x, a.y, b.x, b.y}; v1 = (f32x4){c.x, c.y, d.x, d.y}; }
                    v0 = v0 * sc; v1 = v1 * sc; u32x4 w; w.x = cvt_pk_bf16(v0[0], v0[1]); w.y = cvt_pk_bf16(v0[2], v0[3]); w.z = cvt_pk_bf16(v1[0], v1[1]); w.w = cvt_pk_bf16(v1[2], v1[3]);
                    *(u32x4*)(rowp + bj * HALF) = w; } }
    }
};
__device__ __forceinline__ unsigned cvtpk_rne(float lo, float hi) { typedef float f32x2_t __attribute__((ext_vector_type(2))); typedef __bf16 bf16x2_t __attribute__((ext_vector_type(2)));
    f32x2_t v = {lo, hi}; bf16x2_t b = __builtin_convertvector(v, bf16x2_t); return __builtin_bit_cast(unsigned, b); }
struct EpiF32 {
    static constexpr bool PERM = false, AFTER_DRAIN = false;
    float* O; int ldc;
    __device__ __forceinline__ void operator()(const f32x4 (&acc)[2][2][4][2], const Unit& u, int wr, int wc, int fr, int fq) const {
        const int row0 = u.pm * BM + wr * 64 + fr, col0 = u.pn * BM + wc * 32 + 4 * fq;
#pragma unroll
        for (int ai = 0; ai < 2; ++ai)
#pragma unroll
            for (int m = 0; m < 4; ++m) { float* rowp = O + (size_t)(row0 + ai * HALF + m * 16) * ldc + col0;
#pragma unroll
                for (int bj = 0; bj < 2; ++bj)
#pragma unroll
                    for (int n = 0; n < 2; ++n) *(f32x4*)(rowp + bj * HALF + n * 16) = acc[ai][bj][m][n]; }
    }
};
struct EpiSwiGLU {
    static constexpr bool PERM = true, AFTER_DRAIN = false;
    bf16_t* O; int ldc;
    __device__ __forceinline__ void operator()(const f32x4 (&acc)[2][2][4][2], const Unit& u, int wr, int wc, int fr, int fq) const {
        typedef unsigned u32x2 __attribute__((ext_vector_type(2)));
        const int row0 = u.pm * BM + wr * 64 + fr, col0 = u.pn * (BM / 2) + wc * 16 + 4 * fq;
#pragma unroll
        for (int ai = 0; ai < 2; ++ai)
#pragma unroll
            for (int m = 0; m < 4; ++m) { bf16_t* rowp = O + (size_t)(row0 + ai * HALF + m * 16) * ldc + col0;
#pragma unroll
                for (int bj = 0; bj < 2; ++bj) { const f32x4 g = acc[ai][bj][m][0], up = acc[ai][bj][m][1]; float a[4];
#pragma unroll
                    for (int e = 0; e < 4; ++e) a[e] = g[e] * __builtin_amdgcn_rcpf(1.0f + __builtin_amdgcn_exp2f(-1.4426950408889634f * g[e])) * up[e];
                    u32x2 w; w.x = cvtpk_rne(a[0], a[1]); w.y = cvtpk_rne(a[2], a[3]); *(u32x2*)(rowp + bj * (HALF / 2)) = w; } }
    }
};

template <class Epi, class Sched, bool ALIGN_EPI = false, bool SP2 = false>
__device__ __forceinline__ void gemm_phase(PG8_LAS unsigned char* lds, const Gemm g, const Sched& S, const Epi& E) {
    int tid_ = threadIdx.x; asm volatile("" : "+v"(tid_));
    const int tid = tid_, wid = __builtin_amdgcn_readfirstlane(tid >> 6), lane = tid & 63, wr = wid >> 2, wc = wid & 3, fr = lane & 15, fq = lane >> 4;
    const int K = g.K, nt = K / BK;
    unsigned voffA[2], voffB[2];
#pragma unroll
    for (int i = 0; i < 2; ++i) { int R, C; stage_rc(tid * 16 + i * 8192, R, C); const int Rb = Epi::PERM ? ((R & ~31) + perm32(R & 31)) : R;
        voffA[i] = (unsigned)(R * K + C) * 2u; voffB[i] = (unsigned)(Rb * K + C) * 2u; }
    const size_t kstep = (size_t)(BK * 2);
    const size_t hstep = (size_t)HALF * K * 2;
    const size_t tstep = 2 * hstep;
    const unsigned ldsw = (unsigned)wid * 1024u;
    const int aoff = lds_byte(wr * 64 + fr, fq * 8), boff = lds_byte(wc * 32 + fr, fq * 8);
#define PG8_SA(b, h) (((b) * 2 + (h)) * HTB)
#define PG8_SB(b, h) ((4 + (b) * 2 + (h)) * HTB)
#define PG8_STAGE(bufoff, gbase, voff) do { _Pragma("unroll") for (int _i = 0; _i < 2; ++_i) \
        __builtin_amdgcn_global_load_lds((const unsigned*)((const char*)(gbase) + (voff)[_i]), (PG8_LAS unsigned*)(lds + (bufoff) + ldsw + _i * 8192), 16, 0, 0); } while (0)
#define PG8_LDA(dst, b, h) do { _Pragma("unroll") for (int m = 0; m < 4; ++m) _Pragma("unroll") for (int k = 0; k < 2; ++k) dst[m][k] = *(const PG8_LAS bf16x8*)(lds + PG8_SA(b, h) + aoff + m * 2048 + k * 1024); } while (0)
#define PG8_LDB(dst, b, h) do { _Pragma("unroll") for (int n = 0; n < 2; ++n) _Pragma("unroll") for (int k = 0; k < 2; ++k) dst[n][k] = *(const PG8_LAS bf16x8*)(lds + PG8_SB(b, h) + boff + n * 2048 + k * 1024); } while (0)
#define PG8_MMA(ai, bj, At, Bt) do { __builtin_amdgcn_s_setprio(1); _Pragma("unroll") for (int m = 0; m < 4; ++m) _Pragma("unroll") for (int n = 0; n < 2; ++n) _Pragma("unroll") for (int k = 0; k < 2; ++k) \
        acc[ai][bj][m][n] = __builtin_amdgcn_mfma_f32_16x16x32_bf16(Bt[n][k], At[m][k], acc[ai][bj][m][n], 0, 0, 0); __builtin_amdgcn_s_setprio(0); } while (0)
#define PG8_WAIT_V(n) asm volatile("s_waitcnt vmcnt(" #n ")" ::: "memory")
#define PG8_WAIT_L(n) asm volatile("s_waitcnt lgkmcnt(" #n ")" ::: "memory")
#define PG8_BAR __builtin_amdgcn_s_barrier()
#define PG8_SCHED __builtin_amdgcn_sched_barrier(0)
    Unit cur, nxt; int ui = 0;
    if (!S.next(0, cur)) return;
    f32x4 acc[2][2][4][2];
#pragma unroll
    for (int a = 0; a < 2; ++a)
#pragma unroll
        for (int b = 0; b < 2; ++b)
#pragma unroll
            for (int m = 0; m < 4; ++m)
#pragma unroll
                for (int n = 0; n < 2; ++n) acc[a][b][m][n] = (f32x4){0.f, 0.f, 0.f, 0.f};
    bf16x8 At[4][2], B0[2][2], B1[2][2];
    const char* cA = (const char*)g.A + (size_t)cur.pm * tstep; const char* cB = (const char*)g.Bt + (size_t)cur.pn * tstep;
    S.a_ready(cur);
    if constexpr (SP2) {
        PG8_STAGE(PG8_SB(0, 0), cB, voffB); PG8_STAGE(PG8_SB(0, 1), cB + hstep, voffB); PG8_STAGE(PG8_SA(0, 0), cA, voffA); PG8_STAGE(PG8_SA(0, 1), cA + hstep, voffA);
        if (wr == 1) PG8_BAR;
        PG8_WAIT_V(2); PG8_BAR;
        PG8_STAGE(PG8_SB(1, 0), cB + kstep, voffB); PG8_STAGE(PG8_SA(1, 0), cA + kstep, voffA); PG8_STAGE(PG8_SB(1, 1), cB + hstep + kstep, voffB);
        PG8_WAIT_V(6); PG8_BAR;
    } else {
        PG8_STAGE(PG8_SB(0, 0), cB, voffB); PG8_STAGE(PG8_SA(0, 0), cA, voffA); PG8_STAGE(PG8_SB(0, 1), cB + hstep, voffB); PG8_STAGE(PG8_SA(0, 1), cA + hstep, voffA);
        if (wr == 1) PG8_BAR;
        PG8_WAIT_V(4); PG8_BAR;
        PG8_STAGE(PG8_SB(1, 0), cB + kstep, voffB); PG8_STAGE(PG8_SA(1, 0), cA + kstep, voffA); PG8_STAGE(PG8_SB(1, 1), cB + hstep + kstep, voffB);
        PG8_WAIT_V(6); PG8_BAR;
    }
    for (;;) {
        const bool has_next = S.next(ui + 1, nxt);
        const char* nA = has_next ? (const char*)g.A + (size_t)nxt.pm * tstep : cA; const char* nB = has_next ? (const char*)g.Bt + (size_t)nxt.pn * tstep : cB;
        for (int t = 0; t < nt; t += 2) {
            const bool last = (t == nt - 2);
            const char* a1 = cA + (size_t)(t + 1) * kstep;
            const char* a2 = last ? nA : cA + (size_t)(t + 2) * kstep; const char* b2 = last ? nB : cB + (size_t)(t + 2) * kstep;
            const char* a3 = a2 + kstep; const char* b3 = b2 + kstep;
            if (last && has_next) S.a_ready(nxt);
            if constexpr (SP2) {
            PG8_LDB(B0, 0, 0); PG8_LDB(B1, 0, 1); PG8_SCHED; PG8_LDA(At, 0, 0); PG8_STAGE(PG8_SA(1, 1), a1 + hstep, voffA);
            PG8_WAIT_V(8); PG8_WAIT_L(0); PG8_BAR; PG8_MMA(0, 0, At, B0); PG8_MMA(0, 1, At, B1); PG8_BAR; PG8_SCHED;
            PG8_LDA(At, 0, 1); PG8_STAGE(PG8_SB(0, 0), b2, voffB); PG8_STAGE(PG8_SB(0, 1), b2 + hstep, voffB); PG8_STAGE(PG8_SA(0, 0), a2, voffA);
            PG8_WAIT_V(8); PG8_WAIT_L(0); PG8_BAR; PG8_MMA(1, 0, At, B0); PG8_MMA(1, 1, At, B1); PG8_BAR; PG8_SCHED;
            PG8_LDB(B0, 1, 0); PG8_LDB(B1, 1, 1); PG8_SCHED; PG8_LDA(At, 1, 0); PG8_STAGE(PG8_SA(0, 1), a2 + hstep, voffA);
            PG8_WAIT_V(8); PG8_WAIT_L(0); PG8_BAR; PG8_MMA(0, 0, At, B0); PG8_MMA(0, 1, At, B1); PG8_BAR; PG8_SCHED;
            PG8_LDA(At, 1, 1); PG8_STAGE(PG8_SB(1, 0), b3, voffB); PG8_STAGE(PG8_SB(1, 1), b3 + hstep, voffB); PG8_STAGE(PG8_SA(1, 0), a3, voffA);
            PG8_WAIT_V(8); PG8_WAIT_L(0); PG8_BAR; PG8_MMA(1, 0, At, B0); PG8_MMA(1, 1, At, B1); PG8_BAR; PG8_SCHED;
            } else {
            PG8_LDB(B0, 0, 0); PG8_SCHED; PG8_LDA(At, 0, 0); PG8_STAGE(PG8_SA(1, 1), a1 + hstep, voffA);
            PG8_WAIT_L(8); PG8_BAR; PG8_WAIT_L(0); PG8_MMA(0, 0, At, B0); PG8_BAR; PG8_SCHED;
            PG8_LDB(B1, 0, 1); PG8_STAGE(PG8_SB(0, 0), b2, voffB);
            PG8_BAR; PG8_WAIT_L(0); PG8_MMA(0, 1, At, B1); PG8_BAR;
            PG8_LDA(At, 0, 1); PG8_STAGE(PG8_SA(0, 0), a2, voffA);
            PG8_BAR; PG8_WAIT_L(0); PG8_MMA(1, 0, At, B0); PG8_BAR; PG8_SCHED;
            PG8_STAGE(PG8_SB(0, 1), b2 + hstep, voffB);
            PG8_WAIT_V(6); PG8_BAR; PG8_MMA(1, 1, At, B1); PG8_BAR;
            PG8_LDB(B0, 1, 0); PG8_SCHED; PG8_LDA(At, 1, 0); PG8_STAGE(PG8_SA(0, 1), a2 + hstep, voffA);
            PG8_WAIT_L(8); PG8_BAR; PG8_WAIT_L(0); PG8_MMA(0, 0, At, B0); PG8_BAR; PG8_SCHED;
            PG8_LDB(B1, 1, 1); PG8_STAGE(PG8_SB(1, 0), b3, voffB);
            PG8_BAR; PG8_WAIT_L(0); PG8_MMA(0, 1, At, B1); PG8_BAR;
            PG8_LDA(At, 1, 1); PG8_STAGE(PG8_SA(1, 0), a3, voffA);
            PG8_BAR; PG8_WAIT_L(0); PG8_MMA(1, 0, At, B0); PG8_BAR; PG8_SCHED;
            PG8_STAGE(PG8_SB(1, 1), b3 + hstep, voffB);
            PG8_WAIT_V(6); PG8_BAR; PG8_MMA(1, 1, At, B1); PG8_BAR;
            }
        }
        if constexpr (ALIGN_EPI) { if (wr == 0) PG8_BAR; }
        if constexpr (!Epi::AFTER_DRAIN) { E(acc, cur, wr, wc, fr, fq); S.done(cur); }
        if (!has_next) break;
#pragma unroll
        for (int a = 0; a < 2; ++a)
#pragma unroll
            for (int b = 0; b < 2; ++b)
#pragma unroll
                for (int m = 0; m < 4; ++m)
#pragma unroll
                    for (int n = 0; n < 2; ++n) acc[a][b][m][n] = (f32x4){0.f, 0.f, 0.f, 0.f};
        cur = nxt; cA = nA; cB = nB; ++ui;
        if constexpr (ALIGN_EPI) { if (wr == 1) PG8_BAR; }
    }
    PG8_WAIT_V(0);
    if constexpr (!ALIGN_EPI) { if (wr == 0) PG8_BAR; }
    PG8_BAR;
    if constexpr (Epi::AFTER_DRAIN) { E.fused(acc, cur, wr, wc, fr, fq, lds, wid, lane); S.done(cur); }
#undef PG8_SA
#undef PG8_SB
#undef PG8_STAGE
#undef PG8_LDA
#undef PG8_LDB
#undef PG8_MMA
#undef PG8_WAIT_V
#undef PG8_WAIT_L
#undef PG8_BAR
#undef PG8_SCHED
}
}

#ifndef PG8_SP2
#define PG8_SP2 true
#endif
#ifndef PG8_ALIGN
#define PG8_ALIGN true
#endif
#ifndef PROBE_DUP
#define PROBE_DUP 0
#endif
#ifndef MK_SPLIT
#define MK_SPLIT 0
#endif

constexpr int NB = 2, SEQ = 4096, DM = 2048, NMETA = 16, LSEQ = SEQ + NMETA, DEPTH = 2;
constexpr int MR = NB * SEQ;
constexpr int MV = MR + NMETA;
constexpr int MP = 33 * 256;
constexpr int DIN = 4608, DFF = 5632, DATT = 1024, DPOOL = 512, DCONV = 512, NHEAD = 16;
constexpr int C_K = 1024, C_V = 2048, C_POOL = 3072, C_CA = 3584, C_CG = 4096;
constexpr float EPS = 1e-6f, LOG2E = 1.4426950408889634f, LN2 = 0.6931471805599453f;
constexpr float SB_EXIT = -110.0f;

constexpr size_t MiB = 1u << 20;
constexpr size_t WS_WIN = 0;
constexpr size_t WS_WOUT = WS_WIN + 36 * MiB;
constexpr size_t WS_WGU = WS_WOUT + 16 * MiB;
constexpr size_t WS_WD = WS_WGU + 44 * MiB;
constexpr size_t WS_WSM = WS_WD + 22 * MiB;
constexpr size_t WS_H = WS_WSM + 2 * MiB;
constexpr size_t WS_U = WS_H + 66 * MiB;
constexpr size_t WS_OUT = WS_U + 33 * MiB;
constexpr size_t WS_PROJ = WS_OUT + 66 * MiB;
constexpr size_t WS_MERGED = WS_PROJ + (size_t)MP * DIN * 2;
constexpr size_t WS_ACT = WS_PROJ;
constexpr size_t WS_CTL = WS_MERGED + 33 * MiB;
constexpr size_t CTL_BYTES = 65536;
constexpr size_t WS_END = WS_CTL + 1 * MiB;
static_assert((size_t)MP * DFF * 2 <= WS_END - WS_PROJ, "act overlay");

constexpr int LDS_BYTES = 147456;

#define GAS __attribute__((address_space(1)))
#define LAS __attribute__((address_space(3)))
typedef unsigned short bf16;
typedef unsigned v4u __attribute__((ext_vector_type(4)));
typedef unsigned v2u __attribute__((ext_vector_type(2)));
typedef float f32x4 __attribute__((ext_vector_type(4)));
typedef short bf16x8 __attribute__((ext_vector_type(8)));
typedef short v4i16_t __attribute__((ext_vector_type(4)));
#define LDS_WAIT() asm volatile("s_waitcnt lgkmcnt(0)" ::: "memory")

__device__ __forceinline__ unsigned cvtpk(float lo, float hi) { return pg8::cvtpk_rne(lo, hi); }
__device__ __forceinline__ float bflo(unsigned u) { return __uint_as_float(u << 16); }
__device__ __forceinline__ float bfhi(unsigned u) { return __uint_as_float(u & 0xffff0000u); }
__device__ __forceinline__ float bf2f(bf16 v) { return __uint_as_float((unsigned)v << 16); }
__device__ __forceinline__ float wave_sum(float v) {
#pragma unroll
    for (int o = 1; o < 64; o <<= 1) v += __shfl_xor(v, o);
    return v;
}
__device__ __forceinline__ float sigmoidf_(float x) { return __builtin_amdgcn_rcpf(1.0f + __builtin_amdgcn_exp2f(-LOG2E * x)); }
template <class T> __device__ __forceinline__ T* gptr(T* p) { GAS T* g = (GAS T*)p; asm volatile("" : "+s"(g)); return (T*)g; }
__device__ __forceinline__ int rowidx(int b, int pos) { return pos < NMETA ? MR + pos : b * SEQ + pos - NMETA; }
__device__ __forceinline__ f32x4 mfma16(bf16x8 a, bf16x8 b, f32x4 c) { return __builtin_amdgcn_mfma_f32_16x16x32_bf16(a, b, c, 0, 0, 0); }

struct Args {
    const float *x, *meta, *pre_mix_g, *w_in, *w_pool, *pool_scale, *w_dw, *b_dw, *conv_ln_g, *conv_ln_b, *w_pw, *mix_out_g, *w_out, *post_mix_g, *pre_ffn_g, *w_gate, *w_up, *w_down, *post_ffn_g;
    float* out; unsigned char* ws; int ph_lo, ph_hi;
};

__device__ __forceinline__ void transpose_item(const float* __restrict__ W, int K, int N, bf16* WT, int mode, LAS float* scr, int item, int lane) {
    W = gptr(W); WT = gptr(WT);
    const int nblk = N >> 6, kb = item / nblk, nb = item - kb * nblk, k0 = kb << 6, n0 = nb << 6;
    const int r4 = lane >> 4, c4 = (lane & 15) * 4;
#pragma unroll 4
    for (int i = 0; i < 16; ++i) { const int kk = 4 * i + r4; const f32x4 v = *(const f32x4*)(W + (size_t)(k0 + kk) * N + n0 + c4);
        LAS float* s = scr + kk * 65 + c4; s[0] = v.x; s[1] = v.y; s[2] = v.z; s[3] = v.w; }
    LDS_WAIT();
    const int c = lane & 7;
#pragma unroll
    for (int j = 0; j < 8; ++j) { const int n = (lane >> 3) + 8 * j; const LAS float* s = scr + (8 * c) * 65 + n;
        v4u o; o.x = cvtpk(s[0 * 65], s[1 * 65]); o.y = cvtpk(s[2 * 65], s[3 * 65]); o.z = cvtpk(s[4 * 65], s[5 * 65]); o.w = cvtpk(s[6 * 65], s[7 * 65]);
        const int ng = n0 + n; const int R = mode == 0 ? ng : ((ng >> 2) * 8 + (ng & 3) + (mode == 2 ? 4 : 0));
        *(v4u*)(WT + (size_t)R * K + k0 + 8 * c) = o; }
    LDS_WAIT();
}
#define TJOB(Wp, Kk, Nn, WTp, mode) { const int ni_ = ((Kk) / 64) * ((Nn) / 64); if (r < ni_) { transpose_item((Wp), (Kk), (Nn), (WTp), (mode), scr, r, lane); continue; } r -= ni_; }

__device__ __forceinline__ void convert_ffn_weights(const Args& A, int l, LAS float* scr, int gw, int NGW, int lane) {
    bf16* wgu = (bf16*)(A.ws + WS_WGU); bf16* wd = (bf16*)(A.ws + WS_WD);
    constexpr int NI = 3 * (DM / 64) * (DFF / 64);
    for (int it = gw; it < NI; it += NGW) { int r = it;
        TJOB(A.w_gate + (size_t)l * DM * DFF, DM, DFF, wgu, 1)
        TJOB(A.w_up + (size_t)l * DM * DFF, DM, DFF, wgu, 2)
        TJOB(A.w_down + (size_t)l * DFF * DM, DFF, DM, wd, 0)
    }
}
__device__ __forceinline__ void convert_p0_weights(const Args& A, LAS float* scr, int gw, int NGW, int lane) {
    constexpr int I_IN = (DM / 64) * (DIN / 64), I_PW = 64, I_POOL = 16, NI = I_IN + DEPTH * (I_PW + I_POOL);
    for (int it = gw; it < NI; it += NGW) { int r = it;
        if (r < I_IN) { transpose_item(A.w_in, DM, DIN, (bf16*)(A.ws + WS_WIN), 0, scr, r, lane); continue; } r -= I_IN;
        const int l = r / (I_PW + I_POOL); r -= l * (I_PW + I_POOL);
        if (r < I_PW) { transpose_item(A.w_pw + (size_t)l * 512 * 512, 512, 512, (bf16*)(A.ws + WS_WSM + 256 * 1024) + (size_t)l * 512 * 512, 0, scr, r, lane); continue; } r -= I_PW;
        { const int g = r >> 2; transpose_item(A.w_pool + (size_t)(l * 4 + g) * 128 * 128, 128, 128, (bf16*)(A.ws + WS_WSM) + (size_t)(l * 4 + g) * 128 * 128, 0, scr, r & 3, lane); }
    }
}
__device__ __forceinline__ void convert_wout(const Args& A, int l, LAS float* scr, int gw, int NGW, int lane) {
    constexpr int NI = (DM / 64) * (DM / 64);
    for (int it = gw; it < NI; it += NGW) transpose_item(A.w_out + (size_t)l * DM * DM, DM, DM, (bf16*)(A.ws + WS_WOUT) + (size_t)l * DM * DM, 0, scr, it, lane);
}
__device__ __forceinline__ void convert_win(const Args& A, int l, LAS float* scr, int gw, int NGW, int lane) {
    constexpr int NI = (DM / 64) * (DIN / 64);
    for (int it = gw; it < NI; it += NGW) transpose_item(A.w_in + (size_t)l * DM * DIN, DM, DIN, (bf16*)(A.ws + WS_WIN) + (size_t)l * DIN * DM, 0, scr, it, lane);
}

__device__ __forceinline__ float dot4(f32x4 a) { return (a.x * a.x + a.y * a.y) + (a.z * a.z + a.w * a.w); }
__device__ __forceinline__ void store_u_row(bf16* urow, const f32x4 (&hv)[8], float r, const float* g, int lane) {
#pragma unroll
    for (int j = 0; j < 8; ++j) { const f32x4 gv = ((const f32x4*)g)[lane + 64 * j]; v2u w; w.x = cvtpk(hv[j].x * r * gv.x, hv[j].y * r * gv.y); w.y = cvtpk(hv[j].z * r * gv.z, hv[j].w * r * gv.w);
        ((v2u*)urow)[lane + 64 * j] = w; }
}
__device__ __forceinline__ void init_rows(const Args& A, int gw, int NGW, int lane) {
    unsigned char* wsb = gptr(A.ws); float* h = (float*)(wsb + WS_H); bf16* u = (bf16*)(wsb + WS_U); const float* pg = gptr(A.pre_mix_g);
    for (int m = gw; m < MV; m += NGW) {
        const float* src = m < MR ? gptr(A.x) + (size_t)m * DM : gptr(A.meta) + (size_t)(m - MR) * DM;
        f32x4 hv[8]; float ss = 0.f;
#pragma unroll
        for (int j = 0; j < 8; ++j) { hv[j] = ((const f32x4*)src)[lane + 64 * j]; ss += dot4(hv[j]); ((f32x4*)(h + (size_t)m * DM))[lane + 64 * j] = hv[j]; }
        const float r = rsqrtf(wave_sum(ss) * (1.0f / DM) + EPS);
        store_u_row(u + (size_t)m * DM, hv, r, pg, lane);
    }
}
__device__ __forceinline__ void row_phase(const Args& A, const float* g1, const float* g2, float* dout, int nrows, int gw, int NGW, int lane) {
    unsigned char* wsb = gptr(A.ws); float* h = (float*)(wsb + WS_H); bf16* u = (bf16*)(wsb + WS_U); const float* src = (const float*)(wsb + WS_OUT); g1 = gptr(g1); g2 = gptr(g2); dout = gptr(dout);
    for (int m = gw; m < nrows; m += NGW) {
        f32x4 o[8], hv[8]; float ss = 0.f;
#pragma unroll
        for (int j = 0; j < 8; ++j) { o[j] = ((const f32x4*)(src + (size_t)m * DM))[lane + 64 * j]; hv[j] = ((const f32x4*)(h + (size_t)m * DM))[lane + 64 * j]; ss += dot4(o[j]); }
        const float r = rsqrtf(wave_sum(ss) * (1.0f / DM) + EPS);
        float ss2 = 0.f;
#pragma unroll
        for (int j = 0; j < 8; ++j) { const f32x4 gv = ((const f32x4*)g1)[lane + 64 * j]; hv[j] = hv[j] + o[j] * r * gv; ss2 += dot4(hv[j]); }
        if (dout) {
            if (m < MR) {
#pragma unroll
                for (int j = 0; j < 8; ++j) ((f32x4*)(dout + (size_t)m * DM))[lane + 64 * j] = hv[j];
            }
        } else {
#pragma unroll
            for (int j = 0; j < 8; ++j) ((f32x4*)(h + (size_t)m * DM))[lane + 64 * j] = hv[j];
            const float r2 = rsqrtf(wave_sum(ss2) * (1.0f / DM) + EPS);
            store_u_row(u + (size_t)m * DM, hv, r2, g2, lane);
        }
    }
}

template <int MODE> __device__ __forceinline__ void skinny_gemm(const bf16* __restrict__ Arows, const bf16* __restrict__ Bt, int N, int K, void* O, int ldc, LAS unsigned char* lds, int lane, int wave) {
    const int li = lane & 15, fq = lane >> 4; const int nks = K >> 5;
    LAS f32x4* part = (LAS f32x4*)lds;
    for (int blk = blockIdx.x; blk < (N >> 4); blk += gridDim.x) {
        const bf16* bp = Bt + (size_t)(blk * 16 + li) * K + 8 * fq; const bf16* ap = Arows + (size_t)li * K + 8 * fq;
        f32x4 acc = (f32x4){0.f, 0.f, 0.f, 0.f};
#pragma unroll 8
        for (int ks = wave; ks < nks; ks += 8) { const bf16x8 wf = *(const bf16x8*)(bp + ks * 32); const bf16x8 af = *(const bf16x8*)(ap + ks * 32); acc = mfma16(wf, af, acc); }
        part[wave * 64 + lane] = acc;
        __syncthreads();
        if (wave == 0) {
            f32x4 v = part[lane];
#pragma unroll
            for (int w8 = 1; w8 < 8; ++w8) v = v + part[w8 * 64 + lane];
            const int n0 = blk * 16 + 4 * fq;
            if (MODE == 0) { const float sc = n0 < 1024 ? 0.125f : 1.0f; v2u w; w.x = cvtpk(v.x * sc, v.y * sc); w.y = cvtpk(v.z * sc, v.w * sc); *(v2u*)((bf16*)O + (size_t)(MR + li) * ldc + n0) = w; }
            else if (MODE == 1) { *(f32x4*)((float*)O + (size_t)(MR + li) * ldc + n0) = v; }
            else { f32x4 up; up.x = __shfl_xor(v.x, 16); up.y = __shfl_xor(v.y, 16); up.z = __shfl_xor(v.z, 16); up.w = __shfl_xor(v.w, 16);
                if ((fq & 1) == 0) { v2u w; w.x = cvtpk(v.x * sigmoidf_(v.x) * up.x, v.y * sigmoidf_(v.y) * up.y); w.y = cvtpk(v.z * sigmoidf_(v.z) * up.z, v.w * sigmoidf_(v.w) * up.w);
                    *(v2u*)((bf16*)O + (size_t)(MR + li) * ldc + blk * 8 + 4 * (fq >> 1)) = w; } }
        }
        __syncthreads();
    }
}

constexpr int VPITCH = 128;
constexpr int ML_V = 0, ML_ST = 8 * 64 * VPITCH  , ML_RED = ML_ST + 65536, ML_Y = 0  , ML_AB = ML_Y + 16 * 516 * 4;
static_assert(ML_RED + 3 * 512 <= LDS_BYTES && ML_AB + 16 * 1040 <= ML_ST, "mixer LDS");

__device__ __forceinline__ float softplus_(float z) { const float t = __builtin_amdgcn_exp2f(-LOG2E * __builtin_fabsf(z)); return __builtin_fmaxf(z, 0.f) + LN2 * __builtin_amdgcn_logf(1.0f + t); }
__device__ __forceinline__ void split_pack(const f32x4& a, const f32x4& b, bf16x8& hi, bf16x8& lo) {
    v4u h, l;
    h.x = cvtpk(a[0], a[1]); h.y = cvtpk(a[2], a[3]); h.z = cvtpk(b[0], b[1]); h.w = cvtpk(b[2], b[3]);
    l.x = cvtpk(a[0] - bflo(h.x), a[1] - bfhi(h.x)); l.y = cvtpk(a[2] - bflo(h.y), a[3] - bfhi(h.y));
    l.z = cvtpk(b[0] - bflo(h.z), b[1] - bfhi(h.z)); l.w = cvtpk(b[2] - bflo(h.w), b[3] - bfhi(h.w));
    hi = __builtin_bit_cast(bf16x8, h); lo = __builtin_bit_cast(bf16x8, l);
}
__device__ __forceinline__ void sb_attention(const bf16* __restrict__ proj, int b, int p0, int hd, LAS unsigned char* vl, int lane, f32x4 (&o)[4]) {
    const int li = lane & 15, fq = lane >> 4;
    const int qpos = p0 + li;
    const bf16* qp = proj + (size_t)rowidx(b, qpos) * DIN + hd * 64 + fq * 8;
    const bf16x8 qf0 = *(const bf16x8*)qp, qf1 = *(const bf16x8*)(qp + 32);
    unsigned d0 = 0u, d1 = 0u;
    { const unsigned one = 0x3F80u; d0 = ((4 * fq + 0 >= li) ? one : 0u) | ((4 * fq + 1 >= li) ? (one << 16) : 0u); d1 = ((4 * fq + 2 >= li) ? one : 0u) | ((4 * fq + 3 >= li) ? (one << 16) : 0u); }
    const unsigned ONE2 = 0x3F803F80u;
    const bf16x8 F_D1 = __builtin_bit_cast(bf16x8, (v4u){d0, d1, ONE2, ONE2});
    const bf16x8 F_11 = __builtin_bit_cast(bf16x8, (v4u){ONE2, ONE2, ONE2, ONE2});
    const bf16x8 F_0D = __builtin_bit_cast(bf16x8, (v4u){0u, 0u, d0, d1});
#pragma unroll
    for (int i = 0; i < 4; ++i) o[i] = (f32x4){0.f, 0.f, 0.f, 0.f};
    float carry = 0.f;
    const int ktd = p0 >> 6;
    const unsigned trbase = (unsigned)((4 * fq + (li >> 2)) * VPITCH + (lane & 3) * 8);
    bf16x8 kf[4][2];
#define SB_LOADK(KT) do { _Pragma("unroll") for (int kb = 0; kb < 4; ++kb) { int kp = 64 * (KT) + 16 * kb + li; kp = kp < LSEQ ? kp : LSEQ - 1; const bf16* kr = proj + (size_t)rowidx(b, kp) * DIN + C_K + hd * 64 + fq * 8; \
        kf[kb][0] = *(const bf16x8*)kr; kf[kb][1] = *(const bf16x8*)(kr + 32); } } while (0)
    SB_LOADK(ktd);
    for (int kt = ktd; kt >= 0; --kt) {
        const bool diag = (kt == ktd);
#pragma unroll
        for (int it = 0; it < 8; ++it) { const int key = it * 8 + (lane >> 3); int kp = 64 * kt + key; kp = kp < LSEQ ? kp : LSEQ - 1;
            __builtin_amdgcn_global_load_lds((const unsigned*)(proj + (size_t)rowidx(b, kp) * DIN + C_V + hd * 64 + (lane & 7) * 8), (LAS unsigned*)(vl + it * 1024), 16, 0, 0); }
        f32x4 s[4], lnb[4];
#pragma unroll
        for (int kb = 0; kb < 4; ++kb) { s[kb] = mfma16(kf[kb][0], qf0, (f32x4){0.f, 0.f, 0.f, 0.f}); s[kb] = mfma16(kf[kb][1], qf1, s[kb]); }
        { const int ktn = kt > 0 ? kt - 1 : 0; SB_LOADK(ktn); }
#pragma unroll
        for (int kb = 0; kb < 4; ++kb)
#pragma unroll
            for (int e = 0; e < 4; ++e) { const bool m = !diag || (64 * kt + 16 * kb + 4 * fq + e < qpos); lnb[kb][e] = m ? -softplus_(s[kb][e]) : 0.f; }
        bf16x8 bh[2], bl[2];
        split_pack(lnb[0], lnb[1], bh[0], bl[0]); split_pack(lnb[2], lnb[3], bh[1], bl[1]);
        f32x4 c[4];
#pragma unroll
        for (int i = 0; i < 4; ++i) c[i] = (f32x4){carry, carry, carry, carry};
        c[0] = mfma16(F_D1, bh[0], c[0]); c[0] = mfma16(F_D1, bl[0], c[0]); c[0] = mfma16(F_11, bh[1], c[0]); c[0] = mfma16(F_11, bl[1], c[0]);
        c[1] = mfma16(F_0D, bh[0], c[1]); c[1] = mfma16(F_0D, bl[0], c[1]); c[1] = mfma16(F_11, bh[1], c[1]); c[1] = mfma16(F_11, bl[1], c[1]);
        c[2] = mfma16(F_D1, bh[1], c[2]); c[2] = mfma16(F_D1, bl[1], c[2]);
        c[3] = mfma16(F_0D, bh[1], c[3]); c[3] = mfma16(F_0D, bl[1], c[3]);
        f32x4 w[4];
#pragma unroll
        for (int kb = 0; kb < 4; ++kb)
#pragma unroll
            for (int e = 0; e < 4; ++e) { const bool m = !diag || (64 * kt + 16 * kb + 4 * fq + e < qpos); w[kb][e] = m ? __builtin_amdgcn_exp2f(LOG2E * (s[kb][e] + c[kb][e])) : 0.f; }
        carry = __shfl(c[0][0], li);
        v4u p0v, p1v;
        p0v.x = cvtpk(w[0][0], w[0][1]); p0v.y = cvtpk(w[0][2], w[0][3]); p0v.z = cvtpk(w[1][0], w[1][1]); p0v.w = cvtpk(w[1][2], w[1][3]);
        p1v.x = cvtpk(w[2][0], w[2][1]); p1v.y = cvtpk(w[2][2], w[2][3]); p1v.z = cvtpk(w[3][0], w[3][1]); p1v.w = cvtpk(w[3][2], w[3][3]);
        const bf16x8 pf0 = __builtin_bit_cast(bf16x8, p0v), pf1 = __builtin_bit_cast(bf16x8, p1v);
        asm volatile("s_waitcnt vmcnt(0)" ::: "memory");
#pragma unroll
        for (int db = 0; db < 4; ++db) {
#pragma unroll
            for (int s2 = 0; s2 < 2; ++s2) {
                const v4i16_t lo = __builtin_amdgcn_ds_read_tr16_b64_v4i16((LAS v4i16_t*)(vl + trbase + (32 * s2) * VPITCH + db * 32));
                const v4i16_t hi = __builtin_amdgcn_ds_read_tr16_b64_v4i16((LAS v4i16_t*)(vl + trbase + (32 * s2 + 16) * VPITCH + db * 32));
                const bf16x8 vf = (bf16x8){lo[0], lo[1], lo[2], lo[3], hi[0], hi[1], hi[2], hi[3]};
                o[db] = mfma16(vf, s2 == 0 ? pf0 : pf1, o[db]);
            }
        }
        if (__all(carry < SB_EXIT)) break;
    }
#undef SB_LOADK
}

template <int W> __device__ __forceinline__ void pool_group(const bf16* __restrict__ psrc, const bf16* __restrict__ wpt, int b, int pos, f32x4 (&pacc)[4]) {
    const int cnt = (pos + 1 < W) ? pos + 1 : W; const float inv = 1.0f / (float)cnt;
    constexpr int BW = W < 8 ? W : 8;
#pragma unroll 1
    for (int ks = 0; ks < 4; ++ks) {
        bf16x8 wf[4];
#pragma unroll
        for (int nb = 0; nb < 4; ++nb) wf[nb] = *(const bf16x8*)(wpt + (size_t)nb * 16 * 128 + 32 * ks);
        float sum[8], self[8];
#pragma unroll
        for (int e = 0; e < 8; ++e) { sum[e] = 0.f; self[e] = 0.f; }
#pragma unroll
        for (int j0 = 0; j0 < W; j0 += BW) {
            v4u v[BW];
#pragma unroll
            for (int j = 0; j < BW; ++j) { const int pp = pos - j0 - j; v[j] = *(const v4u*)(psrc + (size_t)rowidx(b, pp >= 0 ? pp : 0) * DIN + 32 * ks); }
#pragma unroll
            for (int j = 0; j < BW; ++j) { const float f = (pos - j0 - j) >= 0 ? 1.0f : 0.0f;
                sum[0] += f * bflo(v[j].x); sum[1] += f * bfhi(v[j].x); sum[2] += f * bflo(v[j].y); sum[3] += f * bfhi(v[j].y);
                sum[4] += f * bflo(v[j].z); sum[5] += f * bfhi(v[j].z); sum[6] += f * bflo(v[j].w); sum[7] += f * bfhi(v[j].w); }
            if (j0 == 0) { self[0] = bflo(v[0].x); self[1] = bfhi(v[0].x); self[2] = bflo(v[0].y); self[3] = bfhi(v[0].y); self[4] = bflo(v[0].z); self[5] = bfhi(v[0].z); self[6] = bflo(v[0].w); self[7] = bfhi(v[0].w); }
            if (j0 + BW < W) __builtin_amdgcn_sched_barrier(0);
        }
        v4u pk; pk.x = cvtpk(sum[0] * inv - self[0], sum[1] * inv - self[1]); pk.y = cvtpk(sum[2] * inv - self[2], sum[3] * inv - self[3]);
        pk.z = cvtpk(sum[4] * inv - self[4], sum[5] * inv - self[5]); pk.w = cvtpk(sum[6] * inv - self[6], sum[7] * inv - self[7]);
        const bf16x8 pf = __builtin_bit_cast(bf16x8, pk);
#pragma unroll
        for (int nb = 0; nb < 4; ++nb) pacc[nb] = mfma16(wf[nb], pf, pacc[nb]);
    }
}

__device__ __forceinline__ void mixer_phase(const Args& A, int l, LAS unsigned char* lds, int tid0, int wave) {
    unsigned char* wsb = gptr(A.ws);
    const bf16* proj = (const bf16*)(wsb + WS_PROJ); bf16* merged = (bf16*)(wsb + WS_MERGED);
    const bf16* wpool_t = (const bf16*)(wsb + WS_WSM) + (size_t)l * 4 * 128 * 128;
    const bf16* wpw_t = (const bf16*)(wsb + WS_WSM + 256 * 1024) + (size_t)l * 512 * 512;
    const float* wdw = gptr(A.w_dw) + (size_t)l * 31 * 512; const float* bdw = gptr(A.b_dw) + l * 512; const float* lng = gptr(A.conv_ln_g) + l * 512; const float* lnb_ = gptr(A.conv_ln_b) + l * 512;
    const float* psc = gptr(A.pool_scale) + l * 512; const float* mg = gptr(A.mix_out_g) + (size_t)l * DM;
    LAS float* Y = (LAS float*)(lds + ML_Y); LAS unsigned short* Ab = (LAS unsigned short*)(lds + ML_AB); LAS float* red = (LAS float*)(lds + ML_RED);
    LAS unsigned char* vl = lds + ML_V + wave * (64 * VPITCH); LAS unsigned char* st = lds + ML_ST + wave * 8192;
    const int nunits = (l + 1 < DEPTH) ? 513 : 512;
    for (int ui = blockIdx.x; ui < nunits; ui += gridDim.x) {
        int ti = ui;
        if (gridDim.x == 256 && ui < 512) { const int w = ui & 255, rnd = ui >> 8; ti = 256 * (w >> 7) + (rnd == 0 ? 128 : 0) + (w & 127); }
        int b, p0; if (ti < 512) { b = ti >> 8; p0 = 16 + 16 * (ti & 255); } else { b = 0; p0 = 0; }
        int tid_l = tid0; asm volatile("" : "+v"(tid_l));
        const int tid = tid_l, lane = tid & 63, li = lane & 15, fq = lane >> 4;
#pragma unroll 1
        for (int hh = 0; hh < 2; ++hh) { f32x4 o0[4];
            sb_attention(proj, b, p0, 2 * wave + hh, vl, lane, o0);
#pragma unroll
            for (int db = 0; db < 4; ++db) *(LAS f32x4*)(st + ((hh * 4 + db) * 64 + lane) * 16) = o0[db]; }
        __syncthreads();
        {
            const int c = tid; const bf16* pa = proj + C_CA + c;
            float glu[46];
#pragma unroll
            for (int r = 0; r < 46; ++r) { const int pos = p0 - 30 + r; float gv = 0.f;
                if (pos >= 0) { const size_t row = (size_t)rowidx(b, pos); const float a = bf2f(pa[row * DIN]); const float gt = bf2f(pa[row * DIN + 512]); gv = a * sigmoidf_(gt); }
                glu[r] = gv;
                if ((r & 15) == 15) __builtin_amdgcn_sched_barrier(0); }
            const float* wdc = wdw + c; asm volatile("" : "+v"(wdc));
            float y[16]; const float bias = bdw[c];
#pragma unroll
            for (int t = 0; t < 16; ++t) y[t] = bias;
#pragma unroll
            for (int j = 0; j < 31; ++j) { const float w = wdc[j * 512];
#pragma unroll
                for (int t = 0; t < 16; ++t) y[t] += w * glu[t + j]; }
#pragma unroll
            for (int t = 0; t < 16; ++t) Y[t * 516 + c] = y[t];
        }
        __syncthreads();
#pragma unroll
        for (int tt = 0; tt < 2; ++tt) { const int t = 2 * wave + tt; float v[8]; float sm = 0.f;
#pragma unroll
            for (int i = 0; i < 8; ++i) { v[i] = Y[t * 516 + lane + 64 * i]; sm += v[i]; }
            const float mean = wave_sum(sm) * (1.0f / 512.0f); float q = 0.f;
#pragma unroll
            for (int i = 0; i < 8; ++i) { v[i] -= mean; q += v[i] * v[i]; }
            const float rstd = rsqrtf(wave_sum(q) * (1.0f / 512.0f) + EPS);
#pragma unroll
            for (int i = 0; i < 8; ++i) { const int c = lane + 64 * i; const float yn = v[i] * rstd * lng[c] + lnb_[c]; const float a = yn * sigmoidf_(yn); Ab[t * 520 + c] = (unsigned short)(cvtpk(a, 0.f) & 0xffffu); }
        }
        __syncthreads();
        f32x4 cacc[4];
#pragma unroll
        for (int i = 0; i < 4; ++i) cacc[i] = (f32x4){0.f, 0.f, 0.f, 0.f};
        { const bf16* wp = wpw_t + (size_t)(64 * wave + li) * 512 + 8 * fq; const LAS unsigned char* ab = (const LAS unsigned char*)Ab + li * 1040 + fq * 16;
#pragma unroll 4
            for (int ks = 0; ks < 16; ++ks) { const bf16x8 bfr = *(const LAS bf16x8*)(ab + ks * 64);
#pragma unroll
                for (int nb = 0; nb < 4; ++nb) { const bf16x8 wf = *(const bf16x8*)(wp + (size_t)nb * 16 * 512 + ks * 32); cacc[nb] = mfma16(wf, bfr, cacc[nb]); } } }
        f32x4 pacc[4];
#pragma unroll
        for (int i = 0; i < 4; ++i) pacc[i] = (f32x4){0.f, 0.f, 0.f, 0.f};
        { const int g = wave >> 1, nh = wave & 1;
            const bf16* wpt = wpool_t + (size_t)(g * 128 + 64 * nh + li) * 128 + 8 * fq; const bf16* psrc = proj + C_POOL + 128 * g + 8 * fq;
            if (g == 0) pool_group<2>(psrc, wpt, b, p0 + li, pacc); else if (g == 1) pool_group<4>(psrc, wpt, b, p0 + li, pacc); else if (g == 2) pool_group<8>(psrc, wpt, b, p0 + li, pacc); else pool_group<16>(psrc, wpt, b, p0 + li, pacc); }
        f32x4 oa[2][4];
#pragma unroll
        for (int hh = 0; hh < 2; ++hh)
#pragma unroll
            for (int db = 0; db < 4; ++db) oa[hh][db] = *(const LAS f32x4*)(st + ((hh * 4 + db) * 64 + lane) * 16);
        float ssa = 0.f, ssp = 0.f, ssc = 0.f;
        { const int g = wave >> 1, nh = wave & 1;
#pragma unroll
            for (int nb = 0; nb < 4; ++nb) { const f32x4 sc = *(const f32x4*)(psc + 128 * g + 64 * nh + 16 * nb + 4 * fq); pacc[nb] = pacc[nb] * sc; ssp += dot4(pacc[nb]); ssc += dot4(cacc[nb]); ssa += dot4(oa[0][nb]) + dot4(oa[1][nb]); } }
        ssa += __shfl_xor(ssa, 16); ssa += __shfl_xor(ssa, 32); ssp += __shfl_xor(ssp, 16); ssp += __shfl_xor(ssp, 32); ssc += __shfl_xor(ssc, 16); ssc += __shfl_xor(ssc, 32);
        if (lane < 16) { red[wave * 16 + lane] = ssa; red[128 + wave * 16 + lane] = ssp; red[256 + wave * 16 + lane] = ssc; }
        __syncthreads();
        float ta = 0.f, tp = 0.f, tc = 0.f;
#pragma unroll
        for (int w8 = 0; w8 < 8; ++w8) { ta += red[w8 * 16 + li]; tp += red[128 + w8 * 16 + li]; tc += red[256 + w8 * 16 + li]; }
        const float ra = rsqrtf(ta * (1.0f / DATT) + EPS), rp = rsqrtf(tp * (1.0f / DPOOL) + EPS), rc = rsqrtf(tc * (1.0f / DCONV) + EPS);
        bf16* orow = merged + (size_t)rowidx(b, p0 + li) * DM;
#pragma unroll
        for (int hh = 0; hh < 2; ++hh)
#pragma unroll
            for (int db = 0; db < 4; ++db) { const int col = (2 * wave + hh) * 64 + 16 * db + 4 * fq; const f32x4 gv = *(const f32x4*)(mg + col); const f32x4 v = oa[hh][db] * ra * gv;
                v2u w2; w2.x = cvtpk(v.x, v.y); w2.y = cvtpk(v.z, v.w); *(v2u*)(orow + col) = w2; }
        { const int g = wave >> 1, nh = wave & 1;
#pragma unroll
            for (int nb = 0; nb < 4; ++nb) { const int col = DATT + 128 * g + 64 * nh + 16 * nb + 4 * fq; const f32x4 gv = *(const f32x4*)(mg + col); const f32x4 v = pacc[nb] * rp * gv;
                v2u w2; w2.x = cvtpk(v.x, v.y); w2.y = cvtpk(v.z, v.w); *(v2u*)(orow + col) = w2; } }
#pragma unroll
        for (int nb = 0; nb < 4; ++nb) { const int col = DATT + DPOOL + 64 * wave + 16 * nb + 4 * fq; const f32x4 gv = *(const f32x4*)(mg + col); const f32x4 v = cacc[nb] * rc * gv;
            v2u w2; w2.x = cvtpk(v.x, v.y); w2.y = cvtpk(v.z, v.w); *(v2u*)(orow + col) = w2; }
        __syncthreads();
    }
}

#define XB_TMO      128
#define XB_XCNT(j)  (256  + 64 * (j))
#define XB_XSUB(j)  (1280 + 64 * (j))
#define XB_XGEN(j)  (2304 + 64 * (j))
#define XB_TOP      3328
#define XB_TOPGEN   3392
#define XCD_BAR_WORDS 3456
#define XB_SPIN_CAP (1u << 18)

__device__ __forceinline__ unsigned xb_ld(unsigned* p)              { return __hip_atomic_load(p, __ATOMIC_RELAXED, __HIP_MEMORY_SCOPE_AGENT); }
__device__ __forceinline__ unsigned xb_add(unsigned* p, unsigned v) { return __hip_atomic_fetch_add(p, v, __ATOMIC_RELAXED, __HIP_MEMORY_SCOPE_AGENT); }
__device__ __forceinline__ unsigned xb_xcc_id() { return (unsigned)__builtin_amdgcn_s_getreg((3 << 11) | 20) & 0xFu; }
#define XB_SPIN(cond, bar) do { unsigned _sp = 0; while (cond) { __builtin_amdgcn_s_sleep(1); \
    if ((++_sp & 255u) == 0u) { if (xb_ld(&(bar)[XB_TMO])) break; if (_sp > XB_SPIN_CAP) { atomicAdd(&(bar)[XB_TMO], 1u); break; } } } } while (0)

struct XcdBarrier {
    unsigned* bar; unsigned x;
    volatile LAS unsigned* st;
};

__device__ __forceinline__ XcdBarrier xcd_barrier_post(unsigned* bar, volatile LAS unsigned* st) {
    XcdBarrier b; b.bar = bar; b.x = xb_xcc_id(); b.st = st;
    if (threadIdx.x == 0) (void)xb_add(&bar[XB_XCNT(b.x)], 1u);
    return b;
}
__device__ __forceinline__ void xcd_barrier_complete(unsigned* bar, unsigned x, unsigned& nloc, unsigned& nx) {
    const unsigned G = gridDim.x * gridDim.y * gridDim.z;
    unsigned sum, cnt, mine, sp = 0u;
    for (;;) {
        sum = 0u; cnt = 0u; mine = 0u;
#pragma unroll
        for (unsigned j = 0; j < 16; ++j) { const unsigned c = xb_ld(&bar[XB_XCNT(j)]); sum += c; cnt += (c > 0u) ? 1u : 0u; mine = (j == x) ? c : mine; }
        if (sum == G) break;
        __builtin_amdgcn_s_sleep(1);
        if ((++sp & 255u) == 0u) { if (xb_ld(&bar[XB_TMO])) break; if (sp > XB_SPIN_CAP) { atomicAdd(&bar[XB_TMO], 1u); break; } }
    }
    nloc = mine > 0u ? mine : 1u; nx = cnt > 0u ? cnt : 1u;
}

__device__ __forceinline__ void xcd_barrier(const XcdBarrier& b) {
    asm volatile("s_waitcnt vmcnt(0)" ::: "memory");
    __syncthreads();
    if (threadIdx.x == 0) {
        unsigned* bar = b.bar;
        __builtin_amdgcn_s_waitcnt(0);
        unsigned nloc = b.st[0], nx = b.st[1];
        if (nloc == 0u) { xcd_barrier_complete(bar, b.x, nloc, nx); b.st[0] = nloc; b.st[1] = nx; }
        const unsigned old = xb_add(&bar[XB_XSUB(b.x)], 1u);
        const unsigned gen = old / nloc;
        if (old + 1u == (gen + 1u) * nloc) {
            __builtin_amdgcn_fence(__ATOMIC_RELEASE, "agent");
            asm volatile("s_waitcnt vmcnt(0)" ::: "memory");
            const unsigned og = xb_add(&bar[XB_TOP], 1u);
            const unsigned tg = og / nx;
            if (og + 1u == (tg + 1u) * nx) xb_add(&bar[XB_TOPGEN], 1u);
            else XB_SPIN(xb_ld(&bar[XB_TOPGEN]) == tg, bar);
            __builtin_amdgcn_fence(__ATOMIC_ACQUIRE, "agent");
            xb_add(&bar[XB_XGEN(b.x)], 1u);
            asm volatile("s_waitcnt vmcnt(0)" ::: "memory");
        } else {
            XB_SPIN(xb_ld(&bar[XB_XGEN(b.x)]) == gen, bar);
            __builtin_amdgcn_fence(__ATOMIC_ACQUIRE, "agent");
            asm volatile("s_waitcnt vmcnt(0)" ::: "memory");
        }
    }
    __syncthreads();
}

constexpr int NPHASE = 1 + 7 * DEPTH;
#define PHASE_ENTER() int tid_ = threadIdx.x; asm volatile("" : "+v"(tid_)); const int tid = tid_, lane = tid & 63, wave = __builtin_amdgcn_readfirstlane(tid >> 6); \
    const __attribute__((address_space(4))) Args* ka_ = (const __attribute__((address_space(4))) Args*)__builtin_amdgcn_kernarg_segment_ptr(); asm volatile("" : "+s"(ka_)); Args A; __builtin_memcpy(&A, ka_, sizeof(Args)); \
    const int G = gridDim.x, gw = blockIdx.x * 8 + wave, NGW = G * 8; LAS float* scr = (LAS float*)(lds + wave * 16640); (void)tid; (void)lane; (void)gw; (void)NGW; (void)scr; (void)G;
__global__ void __launch_bounds__(512, 2) fwd_megakernel(Args args) {
    extern __shared__ __attribute__((aligned(16))) unsigned char lds_raw[];
    LAS unsigned char* lds = (LAS unsigned char*)lds_raw;
    cg::grid_group grid = cg::this_grid();
    const int lo = args.ph_lo, hi = args.ph_hi;
    volatile LAS unsigned* bst = (volatile LAS unsigned*)(lds + LDS_BYTES - 64);
    if (threadIdx.x < 16) bst[threadIdx.x] = 0u;
    __syncthreads();
    XcdBarrier bar = xcd_barrier_post((unsigned*)(args.ws + WS_CTL), bst);
#if !MK_SPLIT
    grid.sync();
#endif
#define IN(k) (lo <= (k) && (k) < hi)
#define SEAM(k) do { if (IN(k) && IN((k) + 1)) xcd_barrier(bar); } while (0)
    int k = 0;
    for (int rep = 0; rep < ((PROBE_DUP & 1) ? 2 : 1); ++rep) if (IN(k)) { if (rep) xcd_barrier(bar); PHASE_ENTER(); convert_p0_weights(A, scr, gw, NGW, lane); init_rows(A, gw, NGW, lane); }
    SEAM(k); ++k;
    for (int l = 0; l < DEPTH; ++l) {
        for (int rep = 0; rep < ((PROBE_DUP & 4) ? 2 : 1); ++rep) if (IN(k)) { if (rep) xcd_barrier(bar); PHASE_ENTER(); unsigned char* wsb = gptr(A.ws);
            pg8::Gemm g{(const bf16*)(wsb + WS_U), (const bf16*)(wsb + WS_WIN) + (size_t)l * DIN * DM, MR, DIN, DM}; pg8::StaticOrder S; S.init(MR, DIN, G, (int)blockIdx.x);
            pg8::EpiBf16<0> E{(bf16*)(wsb + WS_PROJ), DIN, nullptr, 1024, 1024, 0.125f};
            pg8::gemm_phase<pg8::EpiBf16<0>, pg8::StaticOrder, PG8_ALIGN, PG8_SP2>(lds, g, S, E);
            __syncthreads();
            { const int ex = ((MR / 256) * (DIN / 256)) % G, c = (int)blockIdx.x;
                if (ex == 0 || c >= ex) { const int c0 = ex == 0 ? 0 : ex, gw2 = (c - c0) * 8 + wave, n2 = (G - c0) * 8; convert_ffn_weights(A, l, scr, gw2, n2, lane); if (l == 0) convert_wout(A, 0, scr, gw2, n2, lane); } }
            __syncthreads(); skinny_gemm<0>((const bf16*)(wsb + WS_U) + (size_t)MR * DM, (const bf16*)(wsb + WS_WIN) + (size_t)l * DIN * DM, DIN, DM, (void*)(wsb + WS_PROJ), DIN, lds, lane, wave);
        }
        SEAM(k); ++k;
        for (int rep = 0; rep < ((PROBE_DUP & 2) ? 2 : 1); ++rep) if (IN(k)) { if (rep) xcd_barrier(bar); PHASE_ENTER(); mixer_phase(A, l, lds, tid, wave); }
        SEAM(k); ++k;
        for (int rep = 0; rep < ((PROBE_DUP & 16) ? 2 : 1); ++rep) if (IN(k)) { if (rep) xcd_barrier(bar); PHASE_ENTER(); unsigned char* wsb = gptr(A.ws);
            pg8::Gemm g{(const bf16*)(wsb + WS_MERGED), (const bf16*)(wsb + WS_WOUT) + (size_t)l * DM * DM, MR, DM, DM}; pg8::StaticOrder S; S.init(MR, DM, G, (int)blockIdx.x);
            pg8::EpiF32 E{(float*)(wsb + WS_OUT), DM};
            pg8::gemm_phase<pg8::EpiF32, pg8::StaticOrder, PG8_ALIGN, PG8_SP2>(lds, g, S, E);
            __syncthreads(); if (l + 1 < DEPTH) skinny_gemm<1>((const bf16*)(wsb + WS_MERGED) + (size_t)MR * DM, (const bf16*)(wsb + WS_WOUT) + (size_t)l * DM * DM, DM, DM, (void*)(wsb + WS_OUT), DM, lds, lane, wave);
        }
        SEAM(k); ++k;
        if (IN(k)) { PHASE_ENTER(); row_phase(A, A.post_mix_g + (size_t)l * DM, A.pre_ffn_g + (size_t)l * DM, nullptr, (l + 1 < DEPTH) ? MV : MR, gw, NGW, lane); }
        SEAM(k); ++k;
        for (int rep = 0; rep < ((PROBE_DUP & 32) ? 2 : 1); ++rep) if (IN(k)) { if (rep) xcd_barrier(bar); PHASE_ENTER(); unsigned char* wsb = gptr(A.ws);
            pg8::Gemm g{(const bf16*)(wsb + WS_U), (const bf16*)(wsb + WS_WGU), MR, 2 * DFF, DM}; pg8::StaticOrder S; S.init(MR, 2 * DFF, G, (int)blockIdx.x);
            pg8::EpiSwiGLU E{(bf16*)(wsb + WS_ACT), DFF};
            pg8::gemm_phase<pg8::EpiSwiGLU, pg8::StaticOrder, PG8_ALIGN, PG8_SP2>(lds, g, S, E);
            __syncthreads();
            if (l + 1 < DEPTH) { const int ex = ((MR / 256) * (2 * DFF / 256)) % G, c = (int)blockIdx.x;
                if (ex == 0 || c >= ex) { const int c0 = ex == 0 ? 0 : ex, gw2 = (c - c0) * 8 + wave, n2 = (G - c0) * 8; convert_win(A, l + 1, scr, gw2, n2, lane); convert_wout(A, l + 1, scr, gw2, n2, lane); } }
            __syncthreads(); if (l + 1 < DEPTH) skinny_gemm<2>((const bf16*)(wsb + WS_U) + (size_t)MR * DM, (const bf16*)(wsb + WS_WGU), 2 * DFF, DM, (void*)(wsb + WS_ACT), DFF, lds, lane, wave);
        }
        SEAM(k); ++k;
        for (int rep = 0; rep < ((PROBE_DUP & 8) ? 2 : 1); ++rep) if (IN(k)) { if (rep) xcd_barrier(bar); PHASE_ENTER(); unsigned char* wsb = gptr(A.ws);
            pg8::Gemm g{(const bf16*)(wsb + WS_ACT), (const bf16*)(wsb + WS_WD), MR, DM, DFF}; pg8::StaticOrder S; S.init(MR, DM, G, (int)blockIdx.x);
            pg8::EpiF32 E{(float*)(wsb + WS_OUT), DM};
            pg8::gemm_phase<pg8::EpiF32, pg8::StaticOrder, PG8_ALIGN, PG8_SP2>(lds, g, S, E);
            __syncthreads(); if (l + 1 < DEPTH) skinny_gemm<1>((const bf16*)(wsb + WS_ACT) + (size_t)MR * DFF, (const bf16*)(wsb + WS_WD), DM, DFF, (void*)(wsb + WS_OUT), DM, lds, lane, wave);
        }
        SEAM(k); ++k;
        if (IN(k)) { PHASE_ENTER();
            if (l + 1 < DEPTH) { row_phase(A, A.post_ffn_g + (size_t)l * DM, A.pre_mix_g + (size_t)(l + 1) * DM, nullptr, MV, gw, NGW, lane); }
            else row_phase(A, A.post_ffn_g + (size_t)l * DM, nullptr, A.out, MR, gw, NGW, lane);
        }
        if (l + 1 < DEPTH) { SEAM(k); } ++k;
    }
#undef IN
#undef SEAM
}

extern "C" void kernel_launch(void* const* d_in, const int* in_sizes, int n_in, void* d_out, int out_size, void* d_ws, size_t ws_size, hipStream_t stream) {
    static int grid = 0;
    if (grid == 0) {
        if (n_in != 19 || in_sizes[0] != MR * DM || out_size != MR * DM || ws_size < WS_END) { fprintf(stderr, "kernel_launch: unexpected problem (n_in %d, in0 %d, out %d, ws %zu, need %zu)\n", n_in, n_in > 0 ? in_sizes[0] : -1, out_size, ws_size, (size_t)WS_END); grid = -1; return; }
        int dev = 0, cus = 0, per_cu = 0;
        if (hipGetDevice(&dev) != hipSuccess || hipDeviceGetAttribute(&cus, hipDeviceAttributeMultiprocessorCount, dev) != hipSuccess) { grid = -1; return; }
        if (hipFuncSetAttribute((const void*)fwd_megakernel, hipFuncAttributeMaxDynamicSharedMemorySize, LDS_BYTES) != hipSuccess) { fprintf(stderr, "kernel_launch: hipFuncSetAttribute failed\n"); grid = -1; return; }
        if (hipOccupancyMaxActiveBlocksPerMultiprocessor(&per_cu, (const void*)fwd_megakernel, 512, LDS_BYTES) != hipSuccess || per_cu < 1) { fprintf(stderr, "kernel_launch: occupancy query says %d blocks per CU\n", per_cu); per_cu = 1; }
        (void)hipGetLastError();
        grid = cus;
    }
    if (grid < 0) return;
    if (hipMemsetAsync((unsigned char*)d_ws + WS_CTL, 0, CTL_BYTES, stream) != hipSuccess) { fprintf(stderr, "kernel_launch: hipMemsetAsync failed\n"); return; }
    Args a{};
    const float** ap = (const float**)&a;
    for (int i = 0; i < 19; ++i) ap[i] = (const float*)d_in[i];
    a.out = (float*)d_out; a.ws = (unsigned char*)d_ws;
#if MK_SPLIT
    for (int ph = 0; ph < NPHASE; ++ph) { a.ph_lo = ph; a.ph_hi = ph + 1; hipLaunchKernelGGL(fwd_megakernel, dim3(grid), dim3(512), LDS_BYTES, stream, a); }
#else
    a.ph_lo = 0; a.ph_hi = NPHASE;
    void* kargs[] = {(void*)&a};
    const hipError_t e = hipLaunchCooperativeKernel((const void*)fwd_megakernel, dim3(grid), dim3(512), kargs, LDS_BYTES, stream);
    if (e != hipSuccess) fprintf(stderr, "kernel_launch: cooperative launch failed: %s (grid %d)\n", hipGetErrorString(e), grid);
#endif
}
```

```cpp
#include <hip/hip_runtime.h>
#include <hip/hip_cooperative_groups.h>
#include <cstdio>
#include <cstdint>
namespace cg = cooperative_groups;
namespace pg8 {
#define PG8_LAS __attribute__((address_space(3)))
typedef unsigned short bf16_t;
typedef short bf16x8 __attribute__((ext_vector_type(8)));
typedef float f32x4 __attribute__((ext_vector_type(4)));
typedef unsigned u32x4 __attribute__((ext_vector_type(4)));
constexpr int BM = 256, BK = 64, HALF = 128, HTB = HALF * BK * 2  , STAGE_BYTES = 8 * HTB, NXCD = 8, WGM = 8;

__host__ __device__ __forceinline__ int lds_byte(int r, int c) { const int st = (r >> 4) * 2 + (c >> 5), rr = r & 15, cc = c & 31, ob = rr * 64 + cc * 2; return st * 1024 + (ob ^ (((ob >> 9) & 1) << 5)); }
__host__ __device__ __forceinline__ void stage_rc(int b, int& R, int& C) { const int st = b / 1024, sb = b % 1024, swz = sb ^ (((sb >> 9) & 1) << 5); R = (st >> 1) * 16 + swz / 64; C = (st & 1) * 32 + (swz % 64) / 2; }
__host__ __device__ __forceinline__ int perm32(int rho) { const int n = rho >> 4, i = rho & 15; return 8 * (i >> 2) + 4 * n + (i & 3); }

struct Unit { int pm, pn; };
struct Gemm { const bf16_t* A; const bf16_t* Bt; int M, N, K; };

struct StaticOrder {
    int nM, nN, nwg, G, c;
    __host__ __device__ void init(int M, int N, int G_, int c_) { nM = M / BM; nN = N / BM; nwg = nM * nN; G = G_; c = c_; }
    __host__ __device__ bool next(int i, Unit& u) const {
        const long L = (long)i * G + c; if (L >= nwg) return false;
        int wgid = (int)L; { const int q = nwg / NXCD, r = nwg % NXCD, xcd = wgid % NXCD, off = wgid / NXCD; wgid = (xcd < r ? xcd * (q + 1) : r * (q + 1) + (xcd - r) * q) + off; }
        const int nig = WGM * nN, gid = wgid / nig, fm = gid * WGM, gsz = (nM - fm) < WGM ? (nM - fm) : WGM;
        u.pm = fm + ((wgid % nig) % gsz); u.pn = (wgid % nig) / gsz; return true;
    }
    __device__ __forceinline__ void a_ready(const Unit&) const {}
    __device__ __forceinline__ void done(const Unit&) const {}
};

__device__ __forceinline__ unsigned cvt_pk_bf16(float lo, float hi) { unsigned r; asm volatile("v_cvt_pk_bf16_f32 %0, %1, %2" : "=v"(r) : "v"(lo), "v"(hi)); return r; }
typedef float f32x2 __attribute__((ext_vector_type(2)));
__device__ __forceinline__ f32x2 gelu_pk(f32x2 v) {
    const f32x2 av = __builtin_elementwise_abs(v), d = av * 0.2316418882f + 1.0f;
    f32x2 t; t.x = __builtin_amdgcn_rcpf(d.x); t.y = __builtin_amdgcn_rcpf(d.y);
    f32x2 q = t * 0.5307027145f + (-0.7265760135f); q = q * t + 0.7107068705f; q = q * t + (-0.142248368f); q = q * t + 0.127414796f; q = q * t;
    const f32x2 s = (v * v) * (-0.72134752044f);
    f32x2 e; e.x = __builtin_amdgcn_exp2f(s.x); e.y = __builtin_amdgcn_exp2f(s.y);
    const f32x2 m = v * (q * e), r = v - m;
    f32x2 o; o.x = v.x < 0.f ? m.x : r.x; o.y = v.y < 0.f ? m.y : r.y; return o;
}

template <int ACT  > struct EpiBf16 {
    static constexpr bool PERM = true, AFTER_DRAIN = false; static_assert(ACT == 0 || ACT == 1, "EpiBf16: ACT is 0 (none) or 1 (gelu_pk)");
    bf16_t* O; int ldc; const float* bias; int split_cols; size_t split_stride; float scale0;
    __device__ __forceinline__ void operator()(const f32x4 (&acc)[2][2][4][2], const Unit& u, int wr, int wc, int fr, int fq) const {
        const int row0 = u.pm * BM + wr * 64 + fr; int colt = u.pn * BM; bf16_t* base = O;
        float sc = 1.f; if (split_cols) { const int t = colt / split_cols; base += (size_t)t * split_stride; colt -= t * split_cols; if (t == 0) sc = scale0; }
        const int col0 = colt + wc * 32 + 8 * fq, bcol0 = u.pn * BM + wc * 32 + 8 * fq;
        f32x4 bv[2][2];
#pragma unroll
        for (int bj = 0; bj < 2; ++bj)
#pragma unroll
            for (int n = 0; n < 2; ++n) bv[bj][n] = bias ? *(const f32x4*)(bias + bcol0 + bj * HALF + 4 * n) : (f32x4){0.f, 0.f, 0.f, 0.f};
#pragma unroll
        for (int ai = 0; ai < 2; ++ai)
#pragma unroll
            for (int m = 0; m < 4; ++m) { bf16_t* rowp = base + (size_t)(row0 + ai * HALF + m * 16) * ldc + col0;
#pragma unroll
                for (int bj = 0; bj < 2; ++bj) { f32x4 v0 = acc[ai][bj][m][0] + bv[bj][0], v1 = acc[ai][bj][m][1] + bv[bj][1];
                    if (ACT == 1) { f32x2 a = gelu_pk((f32x2){v0[0], v0[1]}), b = gelu_pk((f32x2){v0[2], v0[3]}), c = gelu_pk((f32x2){v1[0], v1[1]}), d = gelu_pk((f32x2){v1[2], v1[3]});
                        v0 = (f32x4){a.x, a.y, b.x, b.y}; v1 = (f32x4){c.x, c.y, d.x, d.y}; }
                    v0 = v0 * sc; v1 = v1 * sc; u32x4 w; w.x = cvt_pk_bf16(v0[0], v0[1]); w.y = cvt_pk_bf16(v0[2], v0[3]); w.z = cvt_pk_bf16(v1[0], v1[1]); w.w = cvt_pk_bf16(v1[2], v1[3]);
                    *(u32x4*)(rowp + bj * HALF) = w; } }
    }
};
__device__ __forceinline__ unsigned cvtpk_rne(float lo, float hi) { typedef float f32x2_t __attribute__((ext_vector_type(2))); typedef __bf16 bf16x2_t __attribute__((ext_vector_type(2)));
    f32x2_t v = {lo, hi}; bf16x2_t b = __builtin_convertvector(v, bf16x2_t); return __builtin_bit_cast(unsigned, b); }
struct EpiF32 {
    static constexpr bool PERM = false, AFTER_DRAIN = false;
    float* O; int ldc;
    __device__ __forceinline__ void operator()(const f32x4 (&acc)[2][2][4][2], const Unit& u, int wr, int wc, int fr, int fq) const {
        const int row0 = u.pm * BM + wr * 64 + fr, col0 = u.pn * BM + wc * 32 + 4 * fq;
#pragma unroll
        for (int ai = 0; ai < 2; ++ai)
#pragma unroll
            for (int m = 0; m < 4; ++m) { float* rowp = O + (size_t)(row0 + ai * HALF + m * 16) * ldc + col0;
#pragma unroll
                for (int bj = 0; bj < 2; ++bj)
#pragma unroll
                    for (int n = 0; n < 2; ++n) *(f32x4*)(rowp + bj * HALF + n * 16) = acc[ai][bj][m][n]; }
    }
};
struct EpiSwiGLU {
    static constexpr bool PERM = true, AFTER_DRAIN = false;
    bf16_t* O; int ldc;
    __device__ __forceinline__ void operator()(const f32x4 (&acc)[2][2][4][2], const Unit& u, int wr, int wc, int fr, int fq) const {
        typedef unsigned u32x2 __attribute__((ext_vector_type(2)));
        const int row0 = u.pm * BM + wr * 64 + fr, col0 = u.pn * (BM / 2) + wc * 16 + 4 * fq;
#pragma unroll
        for (int ai = 0; ai < 2; ++ai)
#pragma unroll
            for (int m = 0; m < 4; ++m) { bf16_t* rowp = O + (size_t)(row0 + ai * HALF + m * 16) * ldc + col0;
#pragma unroll
                for (int bj = 0; bj < 2; ++bj) { const f32x4 g = acc[ai][bj][m][0], up = acc[ai][bj][m][1]; float a[4];
#pragma unroll
                    for (int e = 0; e < 4; ++e) a[e] = g[e] * __builtin_amdgcn_rcpf(1.0f + __builtin_amdgcn_exp2f(-1.4426950408889634f * g[e])) * up[e];
                    u32x2 w; w.x = cvtpk_rne(a[0], a[1]); w.y = cvtpk_rne(a[2], a[3]); *(u32x2*)(rowp + bj * (HALF / 2)) = w; } }
    }
};

template <class Epi, class Sched, bool ALIGN_EPI = false, bool SP2 = false>
__device__ __forceinline__ void gemm_phase(PG8_LAS unsigned char* lds, const Gemm g, const Sched& S, const Epi& E) {
    int tid_ = threadIdx.x; asm volatile("" : "+v"(tid_));
    const int tid = tid_, wid = __builtin_amdgcn_readfirstlane(tid >> 6), lane = tid & 63, wr = wid >> 2, wc = wid & 3, fr = lane & 15, fq = lane >> 4;
    const int K = g.K, nt = K / BK;
    unsigned voffA[2], voffB[2];
#pragma unroll
    for (int i = 0; i < 2; ++i) { int R, C; stage_rc(tid * 16 + i * 8192, R, C); const int Rb = Epi::PERM ? ((R & ~31) + perm32(R & 31)) : R;
        voffA[i] = (unsigned)(R * K + C) * 2u; voffB[i] = (unsigned)(Rb * K + C) * 2u; }
    const size_t kstep = (size_t)(BK * 2);
    const size_t hstep = (size_t)HALF * K * 2;
    const size_t tstep = 2 * hstep;
    const unsigned ldsw = (unsigned)wid * 1024u;
    const int aoff = lds_byte(wr * 64 + fr, fq * 8), boff = lds_byte(wc * 32 + fr, fq * 8);
#define PG8_SA(b, h) (((b) * 2 + (h)) * HTB)
#define PG8_SB(b, h) ((4 + (b) * 2 + (h)) * HTB)
#define PG8_STAGE(bufoff, gbase, voff) do { _Pragma("unroll") for (int _i = 0; _i < 2; ++_i) \
        __builtin_amdgcn_global_load_lds((const unsigned*)((const char*)(gbase) + (voff)[_i]), (PG8_LAS unsigned*)(lds + (bufoff) + ldsw + _i * 8192), 16, 0, 0); } while (0)
#define PG8_LDA(dst, b, h) do { _Pragma("unroll") for (int m = 0; m < 4; ++m) _Pragma("unroll") for (int k = 0; k < 2; ++k) dst[m][k] = *(const PG8_LAS bf16x8*)(lds + PG8_SA(b, h) + aoff + m * 2048 + k * 1024); } while (0)
#define PG8_LDB(dst, b, h) do { _Pragma("unroll") for (int n = 0; n < 2; ++n) _Pragma("unroll") for (int k = 0; k < 2; ++k) dst[n][k] = *(const PG8_LAS bf16x8*)(lds + PG8_SB(b, h) + boff + n * 2048 + k * 1024); } while (0)
#define PG8_MMA(ai, bj, At, Bt) do { __builtin_amdgcn_s_setprio(1); _Pragma("unroll") for (int m = 0; m < 4; ++m) _Pragma("unroll") for (int n = 0; n < 2; ++n) _Pragma("unroll") for (int k = 0; k < 2; ++k) \
        acc[ai][bj][m][n] = __builtin_amdgcn_mfma_f32_16x16x32_bf16(Bt[n][k], At[m][k], acc[ai][bj][m][n], 0, 0, 0); __builtin_amdgcn_s_setprio(0); } while (0)
#define PG8_WAIT_V(n) asm volatile("s_waitcnt vmcnt(" #n ")" ::: "memory")
#define PG8_WAIT_L(n) asm volatile("s_waitcnt lgkmcnt(" #n ")" ::: "memory")
#define PG8_BAR __builtin_amdgcn_s_barrier()
#define PG8_SCHED __builtin_amdgcn_sched_barrier(0)
    Unit cur, nxt; int ui = 0;
    if (!S.next(0, cur)) return;
    f32x4 acc[2][2][4][2];
#pragma unroll
    for (int a = 0; a < 2; ++a)
#pragma unroll
        for (int b = 0; b < 2; ++b)
#pragma unroll
            for (int m = 0; m < 4; ++m)
#pragma unroll
                for (int n = 0; n < 2; ++n) acc[a][b][m][n] = (f32x4){0.f, 0.f, 0.f, 0.f};
    bf16x8 At[4][2], B0[2][2], B1[2][2];
    const char* cA = (const char*)g.A + (size_t)cur.pm * tstep; const char* cB = (const char*)g.Bt + (size_t)cur.pn * tstep;
    S.a_ready(cur);
    if constexpr (SP2) {
        PG8_STAGE(PG8_SB(0, 0), cB, voffB); PG8_STAGE(PG8_SB(0, 1), cB + hstep, voffB); PG8_STAGE(PG8_SA(0, 0), cA, voffA); PG8_STAGE(PG8_SA(0, 1), cA + hstep, voffA);
        if (wr == 1) PG8_BAR;
        PG8_WAIT_V(2); PG8_BAR;
        PG8_STAGE(PG8_SB(1, 0), cB + kstep, voffB); PG8_STAGE(PG8_SA(1, 0), cA + kstep, voffA); PG8_STAGE(PG8_SB(1, 1), cB + hstep + kstep, voffB);
        PG8_WAIT_V(6); PG8_BAR;
    } else {
        PG8_STAGE(PG8_SB(0, 0), cB, voffB); PG8_STAGE(PG8_SA(0, 0), cA, voffA); PG8_STAGE(PG8_SB(0, 1), cB + hstep, voffB); PG8_STAGE(PG8_SA(0, 1), cA + hstep, voffA);
        if (wr == 1) PG8_BAR;
        PG8_WAIT_V(4); PG8_BAR;
        PG8_STAGE(PG8_SB(1, 0), cB + kstep, voffB); PG8_STAGE(PG8_SA(1, 0), cA + kstep, voffA); PG8_STAGE(PG8_SB(1, 1), cB + hstep + kstep, voffB);
        PG8_WAIT_V(6); PG8_BAR;
    }
    for (;;) {
        const bool has_next = S.next(ui + 1, nxt);
        const char* nA = has_next ? (const char*)g.A + (size_t)nxt.pm * tstep : cA; const char* nB = has_next ? (const char*)g.Bt + (size_t)nxt.pn * tstep : cB;
        for (int t = 0; t < nt; t += 2) {
            const bool last = (t == nt - 2);
            const char* a1 = cA + (size_t)(t + 1) * kstep;
            const char* a2 = last ? nA : cA + (size_t)(t + 2) * kstep; const char* b2 = last ? nB : cB + (size_t)(t + 2) * kstep;
            const char* a3 = a2 + kstep; const char* b3 = b2 + kstep;
            if (last && has_next) S.a_ready(nxt);
            if constexpr (SP2) {
            PG8_LDB(B0, 0, 0); PG8_LDB(B1, 0, 1); PG8_SCHED; PG8_LDA(At, 0, 0); PG8_STAGE(PG8_SA(1, 1), a1 + hstep, voffA);
            PG8_WAIT_V(8); PG8_WAIT_L(0); PG8_BAR; PG8_MMA(0, 0, At, B0); PG8_MMA(0, 1, At, B1); PG8_BAR; PG8_SCHED;
            PG8_LDA(At, 0, 1); PG8_STAGE(PG8_SB(0, 0), b2, voffB); PG8_STAGE(PG8_SB(0, 1), b2 + hstep, voffB); PG8_STAGE(PG8_SA(0, 0), a2, voffA);
            PG8_WAIT_V(8); PG8_WAIT_L(0); PG8_BAR; PG8_MMA(1, 0, At, B0); PG8_MMA(1, 1, At, B1); PG8_BAR; PG8_SCHED;
            PG8_LDB(B0, 1, 0); PG8_LDB(B1, 1, 1); PG8_SCHED; PG8_LDA(At, 1, 0); PG8_STAGE(PG8_SA(0, 1), a2 + hstep, voffA);
            PG8_WAIT_V(8); PG8_WAIT_L(0); PG8_BAR; PG8_MMA(0, 0, At, B0); PG8_MMA(0, 1, At, B1); PG8_BAR; PG8_SCHED;
            PG8_LDA(At, 1, 1); PG8_STAGE(PG8_SB(1, 0), b3, voffB); PG8_STAGE(PG8_SB(1, 1), b3 + hstep, voffB); PG8_STAGE(PG8_SA(1, 0), a3, voffA);
            PG8_WAIT_V(8); PG8_WAIT_L(0); PG8_BAR; PG8_MMA(1, 0, At, B0); PG8_MMA(1, 1, At, B1); PG8_BAR; PG8_SCHED;
            } else {
            PG8_LDB(B0, 0, 0); PG8_SCHED; PG8_LDA(At, 0, 0); PG8_STAGE(PG8_SA(1, 1), a1 + hstep, voffA);
            PG8_WAIT_L(8); PG8_BAR; PG8_WAIT_L(0); PG8_MMA(0, 0, At, B0); PG8_BAR; PG8_SCHED;
            PG8_LDB(B1, 0, 1); PG8_STAGE(PG8_SB(0, 0), b2, voffB);
            PG8_BAR; PG8_WAIT_L(0); PG8_MMA(0, 1, At, B1); PG8_BAR;
            PG8_LDA(At, 0, 1); PG8_STAGE(PG8_SA(0, 0), a2, voffA);
            PG8_BAR; PG8_WAIT_L(0); PG8_MMA(1, 0, At, B0); PG8_BAR; PG8_SCHED;
            PG8_STAGE(PG8_SB(0, 1), b2 + hstep, voffB);
            PG8_WAIT_V(6); PG8_BAR; PG8_MMA(1, 1, At, B1); PG8_BAR;
            PG8_LDB(B0, 1, 0); PG8_SCHED; PG8_LDA(At, 1, 0); PG8_STAGE(PG8_SA(0, 1), a2 + hstep, voffA);
            PG8_WAIT_L(8); PG8_BAR; PG8_WAIT_L(0); PG8_MMA(0, 0, At, B0); PG8_BAR; PG8_SCHED;
            PG8_LDB(B1, 1, 1); PG8_STAGE(PG8_SB(1, 0), b3, voffB);
            PG8_BAR; PG8_WAIT_L(0); PG8_MMA(0, 1, At, B1); PG8_BAR;
            PG8_LDA(At, 1, 1); PG8_STAGE(PG8_SA(1, 0), a3, voffA);
            PG8_BAR; PG8_WAIT_L(0); PG8_MMA(1, 0, At, B0); PG8_BAR; PG8_SCHED;
            PG8_STAGE(PG8_SB(1, 1), b3 + hstep, voffB);
            PG8_WAIT_V(6); PG8_BAR; PG8_MMA(1, 1, At, B1); PG8_BAR;
            }
        }
        if constexpr (ALIGN_EPI) { if (wr == 0) PG8_BAR; }
        if constexpr (!Epi::AFTER_DRAIN) { E(acc, cur, wr, wc, fr, fq); S.done(cur); }
        if (!has_next) break;
#pragma unroll
        for (int a = 0; a < 2; ++a)
#pragma unroll
            for (int b = 0; b < 2; ++b)
#pragma unroll
                for (int m = 0; m < 4; ++m)
#pragma unroll
                    for (int n = 0; n < 2; ++n) acc[a][b][m][n] = (f32x4){0.f, 0.f, 0.f, 0.f};
        cur = nxt; cA = nA; cB = nB; ++ui;
        if constexpr (ALIGN_EPI) { if (wr == 1) PG8_BAR; }
    }
    PG8_WAIT_V(0);
    if constexpr (!ALIGN_EPI) { if (wr == 0) PG8_BAR; }
    PG8_BAR;
    if constexpr (Epi::AFTER_DRAIN) { E.fused(acc, cur, wr, wc, fr, fq, lds, wid, lane); S.done(cur); }
#undef PG8_SA
#undef PG8_SB
#undef PG8_STAGE
#undef PG8_LDA
#undef PG8_LDB
#undef PG8_MMA
#undef PG8_WAIT_V
#undef PG8_WAIT_L
#undef PG8_BAR
#undef PG8_SCHED
}
}

#ifndef PG8_SP2
#define PG8_SP2 true
#endif
#ifndef PG8_ALIGN
#define PG8_ALIGN true
#endif
#ifndef PROBE_DUP
#define PROBE_DUP 0
#endif
#ifndef MK_SPLIT
#define MK_SPLIT 0
#endif

constexpr int NB = 2, SEQ = 4096, DM = 2048, NMETA = 16, LSEQ = SEQ + NMETA, DEPTH = 2;
constexpr int MR = NB * SEQ;
constexpr int MV = MR + NMETA;
constexpr int MP = 33 * 256;
constexpr int DIN = 4608, DFF = 5632, DATT = 1024, DPOOL = 512, DCONV = 512, NHEAD = 16;
constexpr int C_K = 1024, C_V = 2048, C_POOL = 3072, C_CA = 3584, C_CG = 4096;
constexpr float EPS = 1e-6f, LOG2E = 1.4426950408889634f, LN2 = 0.6931471805599453f;
constexpr float SB_EXIT = -104.0f;

constexpr size_t MiB = 1u << 20;
constexpr size_t WS_WIN = 0;
constexpr size_t WS_WOUT = WS_WIN + 36 * MiB;
constexpr size_t WS_WGU = WS_WOUT + 16 * MiB;
constexpr size_t WS_WD = WS_WGU + 44 * MiB;
constexpr size_t WS_WSM = WS_WD + 22 * MiB;
constexpr size_t WS_H = WS_WSM + 2 * MiB;
constexpr size_t WS_U = WS_H + 66 * MiB;
constexpr size_t WS_OUT = WS_U + 33 * MiB;
constexpr size_t WS_PROJ = WS_OUT + 66 * MiB;
constexpr size_t WS_MERGED = WS_PROJ + (size_t)MP * DIN * 2;
constexpr size_t WS_ACT = WS_PROJ;
constexpr size_t WS_CTL = WS_MERGED + 33 * MiB;
constexpr size_t CTL_BYTES = 65536;
constexpr size_t WS_END = WS_CTL + 1 * MiB;
static_assert((size_t)MP * DFF * 2 <= WS_END - WS_PROJ, "act overlay");

constexpr int LDS_BYTES = 147456;

#define GAS __attribute__((address_space(1)))
#define LAS __attribute__((address_space(3)))
typedef unsigned short bf16;
typedef unsigned v4u __attribute__((ext_vector_type(4)));
typedef unsigned v2u __attribute__((ext_vector_type(2)));
typedef float f32x4 __attribute__((ext_vector_type(4)));
typedef short bf16x8 __attribute__((ext_vector_type(8)));
typedef short v4i16_t __attribute__((ext_vector_type(4)));
#define LDS_WAIT() asm volatile("s_waitcnt lgkmcnt(0)" ::: "memory")

__device__ __forceinline__ unsigned cvtpk(float lo, float hi) { return pg8::cvtpk_rne(lo, hi); }
__device__ __forceinline__ float bflo(unsigned u) { return __uint_as_float(u << 16); }
__device__ __forceinline__ float bfhi(unsigned u) { return __uint_as_float(u & 0xffff0000u); }
__device__ __forceinline__ float bf2f(bf16 v) { return __uint_as_float((unsigned)v << 16); }
__device__ __forceinline__ float wave_sum(float v) {
#pragma unroll
    for (int o = 1; o < 64; o <<= 1) v += __shfl_xor(v, o);
    return v;
}
__device__ __forceinline__ float sigmoidf_(float x) { return __builtin_amdgcn_rcpf(1.0f + __builtin_amdgcn_exp2f(-LOG2E * x)); }
template <class T> __device__ __forceinline__ T* gptr(T* p) { GAS T* g = (GAS T*)p; asm volatile("" : "+s"(g)); return (T*)g; }
__device__ __forceinline__ int rowidx(int b, int pos) { return pos < NMETA ? MR + pos : b * SEQ + pos - NMETA; }
__device__ __forceinline__ f32x4 mfma16(bf16x8 a, bf16x8 b, f32x4 c) { return __builtin_amdgcn_mfma_f32_16x16x32_bf16(a, b, c, 0, 0, 0); }

struct Args {
    const float *x, *meta, *pre_mix_g, *w_in, *w_pool, *pool_scale, *w_dw, *b_dw, *conv_ln_g, *conv_ln_b, *w_pw, *mix_out_g, *w_out, *post_mix_g, *pre_ffn_g, *w_gate, *w_up, *w_down, *post_ffn_g;
    float* out; unsigned char* ws; int ph_lo, ph_hi;
};

__device__ __forceinline__ void transpose_item(const float* __restrict__ W, int K, int N, bf16* WT, int mode, LAS float* scr, int item, int lane) {
    W = gptr(W); WT = gptr(WT);
    const int nblk = N >> 6, kb = item / nblk, nb = item - kb * nblk, k0 = kb << 6, n0 = nb << 6;
    const int r4 = lane >> 4, c4 = (lane & 15) * 4;
    f32x4 tv[16];
#pragma unroll
    for (int i = 0; i < 16; ++i) tv[i] = *(const f32x4*)(W + (size_t)(k0 + 4 * i + r4) * N + n0 + c4);
#pragma unroll
    for (int i = 0; i < 16; ++i) { LAS float* s = scr + (4 * i + r4) * 65 + c4; s[0] = tv[i].x; s[1] = tv[i].y; s[2] = tv[i].z; s[3] = tv[i].w; }
    LDS_WAIT();
    const int c = lane & 7;
#pragma unroll
    for (int j = 0; j < 8; ++j) { const int n = (lane >> 3) + 8 * j; const LAS float* s = scr + (8 * c) * 65 + n;
        v4u o; o.x = cvtpk(s[0 * 65], s[1 * 65]); o.y = cvtpk(s[2 * 65], s[3 * 65]); o.z = cvtpk(s[4 * 65], s[5 * 65]); o.w = cvtpk(s[6 * 65], s[7 * 65]);
        const int ng = n0 + n; const int R = mode == 0 ? ng : ((ng >> 2) * 8 + (ng & 3) + (mode == 2 ? 4 : 0));
        *(v4u*)(WT + (size_t)R * K + k0 + 8 * c) = o; }
    LDS_WAIT();
}
#define TJOB(Wp, Kk, Nn, WTp, mode) { const int ni_ = ((Kk) / 64) * ((Nn) / 64); if (r < ni_) { transpose_item((Wp), (Kk), (Nn), (WTp), (mode), scr, r, lane); continue; } r -= ni_; }

__device__ __forceinline__ void convert_ffn_weights(const Args& A, int l, LAS float* scr, int gw, int NGW, int lane) {
    bf16* wgu = (bf16*)(A.ws + WS_WGU); bf16* wd = (bf16*)(A.ws + WS_WD);
    constexpr int NI = 3 * (DM / 64) * (DFF / 64);
    for (int it = gw; it < NI; it += NGW) { int r = it;
        TJOB(A.w_gate + (size_t)l * DM * DFF, DM, DFF, wgu, 1)
        TJOB(A.w_up + (size_t)l * DM * DFF, DM, DFF, wgu, 2)
        TJOB(A.w_down + (size_t)l * DFF * DM, DFF, DM, wd, 0)
    }
}
__device__ __forceinline__ void convert_p0_weights(const Args& A, LAS float* scr, int gw, int NGW, int lane) {
    constexpr int I_IN = (DM / 64) * (DIN / 64), I_PW = 64, I_POOL = 16, NI = I_IN + DEPTH * (I_PW + I_POOL);
    for (int it = gw; it < NI; it += NGW) { int r = it;
        if (r < I_IN) { transpose_item(A.w_in, DM, DIN, (bf16*)(A.ws + WS_WIN), 0, scr, r, lane); continue; } r -= I_IN;
        const int l = r / (I_PW + I_POOL); r -= l * (I_PW + I_POOL);
        if (r < I_PW) { transpose_item(A.w_pw + (size_t)l * 512 * 512, 512, 512, (bf16*)(A.ws + WS_WSM + 256 * 1024) + (size_t)l * 512 * 512, 0, scr, r, lane); continue; } r -= I_PW;
        { const int g = r >> 2; transpose_item(A.w_pool + (size_t)(l * 4 + g) * 128 * 128, 128, 128, (bf16*)(A.ws + WS_WSM) + (size_t)(l * 4 + g) * 128 * 128, 0, scr, r & 3, lane); }
    }
}
__device__ __forceinline__ void convert_wout(const Args& A, int l, LAS float* scr, int gw, int NGW, int lane) {
    constexpr int NI = (DM / 64) * (DM / 64);
    for (int it = gw; it < NI; it += NGW) transpose_item(A.w_out + (size_t)l * DM * DM, DM, DM, (bf16*)(A.ws + WS_WOUT) + (size_t)l * DM * DM, 0, scr, it, lane);
}
__device__ __forceinline__ void convert_win(const Args& A, int l, LAS float* scr, int gw, int NGW, int lane) {
    constexpr int NI = (DM / 64) * (DIN / 64);
    for (int it = gw; it < NI; it += NGW) transpose_item(A.w_in + (size_t)l * DM * DIN, DM, DIN, (bf16*)(A.ws + WS_WIN) + (size_t)l * DIN * DM, 0, scr, it, lane);
}

__device__ __forceinline__ float dot4(f32x4 a) { return (a.x * a.x + a.y * a.y) + (a.z * a.z + a.w * a.w); }
__device__ __forceinline__ void store_u_row(bf16* urow, const f32x4 (&hv)[8], float r, const float* g, int lane) {
#pragma unroll
    for (int j = 0; j < 8; ++j) { const f32x4 gv = ((const f32x4*)g)[lane + 64 * j]; v2u w; w.x = cvtpk(hv[j].x * r * gv.x, hv[j].y * r * gv.y); w.y = cvtpk(hv[j].z * r * gv.z, hv[j].w * r * gv.w);
        ((v2u*)urow)[lane + 64 * j] = w; }
}
__device__ __forceinline__ void init_rows(const Args& A, int gw, int NGW, int lane) {
    unsigned char* wsb = gptr(A.ws); float* h = (float*)(wsb + WS_H); bf16* u = (bf16*)(wsb + WS_U); const float* pg = gptr(A.pre_mix_g);
    for (int m = gw; m < MV; m += NGW) {
        const float* src = m < MR ? gptr(A.x) + (size_t)m * DM : gptr(A.meta) + (size_t)(m - MR) * DM;
        f32x4 hv[8]; float ss = 0.f;
#pragma unroll
        for (int j = 0; j < 8; ++j) { hv[j] = ((const f32x4*)src)[lane + 64 * j]; ss += dot4(hv[j]); ((f32x4*)(h + (size_t)m * DM))[lane + 64 * j] = hv[j]; }
        const float r = rsqrtf(wave_sum(ss) * (1.0f / DM) + EPS);
        store_u_row(u + (size_t)m * DM, hv, r, pg, lane);
    }
}
__device__ __forceinline__ void row_phase(const Args& A, const float* g1, const float* g2, float* dout, int nrows, int gw, int NGW, int lane) {
    unsigned char* wsb = gptr(A.ws); float* h = (float*)(wsb + WS_H); bf16* u = (bf16*)(wsb + WS_U); const float* src = (const float*)(wsb + WS_OUT); g1 = gptr(g1); g2 = gptr(g2); dout = gptr(dout);
    for (int m = gw; m < nrows; m += NGW) {
        f32x4 o[8], hv[8]; float ss = 0.f;
#pragma unroll
        for (int j = 0; j < 8; ++j) { o[j] = ((const f32x4*)(src + (size_t)m * DM))[lane + 64 * j]; hv[j] = ((const f32x4*)(h + (size_t)m * DM))[lane + 64 * j]; ss += dot4(o[j]); }
        const float r = rsqrtf(wave_sum(ss) * (1.0f / DM) + EPS);
        float ss2 = 0.f;
#pragma unroll
        for (int j = 0; j < 8; ++j) { const f32x4 gv = ((const f32x4*)g1)[lane + 64 * j]; hv[j] = hv[j] + o[j] * r * gv; ss2 += dot4(hv[j]); }
        if (dout) {
            if (m < MR) {
#pragma unroll
                for (int j = 0; j < 8; ++j) ((f32x4*)(dout + (size_t)m * DM))[lane + 64 * j] = hv[j];
            }
        } else {
#pragma unroll
            for (int j = 0; j < 8; ++j) ((f32x4*)(h + (size_t)m * DM))[lane + 64 * j] = hv[j];
            const float r2 = rsqrtf(wave_sum(ss2) * (1.0f / DM) + EPS);
            store_u_row(u + (size_t)m * DM, hv, r2, g2, lane);
        }
    }
}

template <int MODE> __device__ __forceinline__ void skinny_gemm(const bf16* __restrict__ Arows, const bf16* __restrict__ Bt, int N, int K, void* O, int ldc, LAS unsigned char* lds, int lane, int wave) {
    const int li = lane & 15, fq = lane >> 4; const int nks = K >> 5;
    LAS f32x4* part = (LAS f32x4*)lds;
    for (int blk = blockIdx.x; blk < (N >> 4); blk += gridDim.x) {
        const bf16* bp = Bt + (size_t)(blk * 16 + li) * K + 8 * fq; const bf16* ap = Arows + (size_t)li * K + 8 * fq;
        f32x4 acc = (f32x4){0.f, 0.f, 0.f, 0.f};
#pragma unroll 8
        for (int ks = wave; ks < nks; ks += 8) { const bf16x8 wf = *(const bf16x8*)(bp + ks * 32); const bf16x8 af = *(const bf16x8*)(ap + ks * 32); acc = mfma16(wf, af, acc); }
        part[wave * 64 + lane] = acc;
        __syncthreads();
        if (wave == 0) {
            f32x4 v = part[lane];
#pragma unroll
            for (int w8 = 1; w8 < 8; ++w8) v = v + part[w8 * 64 + lane];
            const int n0 = blk * 16 + 4 * fq;
            if (MODE == 0) { const float sc = n0 < 1024 ? 0.125f : 1.0f; v2u w; w.x = cvtpk(v.x * sc, v.y * sc); w.y = cvtpk(v.z * sc, v.w * sc); *(v2u*)((bf16*)O + (size_t)(MR + li) * ldc + n0) = w; }
            else if (MODE == 1) { *(f32x4*)((float*)O + (size_t)(MR + li) * ldc + n0) = v; }
            else { f32x4 up; up.x = __shfl_xor(v.x, 16); up.y = __shfl_xor(v.y, 16); up.z = __shfl_xor(v.z, 16); up.w = __shfl_xor(v.w, 16);
                if ((fq & 1) == 0) { v2u w; w.x = cvtpk(v.x * sigmoidf_(v.x) * up.x, v.y * sigmoidf_(v.y) * up.y); w.y = cvtpk(v.z * sigmoidf_(v.z) * up.z, v.w * sigmoidf_(v.w) * up.w);
                    *(v2u*)((bf16*)O + (size_t)(MR + li) * ldc + blk * 8 + 4 * (fq >> 1)) = w; } }
        }
        __syncthreads();
    }
}

constexpr int VPITCH = 128;
constexpr int ML_V = 0, ML_ST = 8 * 64 * VPITCH  , ML_RED = ML_ST + 65536, ML_Y = 0  , ML_AB = ML_Y + 16 * 516 * 4;
static_assert(ML_RED + 3 * 512 <= LDS_BYTES && ML_AB + 16 * 1040 <= ML_ST, "mixer LDS");

__device__ __forceinline__ float softplus_(float z) { const float t = __builtin_amdgcn_exp2f(-LOG2E * __builtin_fabsf(z)); return __builtin_fmaxf(z, 0.f) + LN2 * __builtin_amdgcn_logf(1.0f + t); }
__device__ __forceinline__ void split_pack(const f32x4& a, const f32x4& b, bf16x8& hi, bf16x8& lo) {
    v4u h, l;
    h.x = cvtpk(a[0], a[1]); h.y = cvtpk(a[2], a[3]); h.z = cvtpk(b[0], b[1]); h.w = cvtpk(b[2], b[3]);
    l.x = cvtpk(a[0] - bflo(h.x), a[1] - bfhi(h.x)); l.y = cvtpk(a[2] - bflo(h.y), a[3] - bfhi(h.y));
    l.z = cvtpk(b[0] - bflo(h.z), b[1] - bfhi(h.z)); l.w = cvtpk(b[2] - bflo(h.w), b[3] - bfhi(h.w));
    hi = __builtin_bit_cast(bf16x8, h); lo = __builtin_bit_cast(bf16x8, l);
}
__device__ __forceinline__ void sb_attention(const bf16* __restrict__ proj, int b, int p0, int hd, LAS unsigned char* vl, int lane, f32x4 (&o)[4]) {
    const int li = lane & 15, fq = lane >> 4;
    const int qpos = p0 + li;
    const bf16* qp = proj + (size_t)rowidx(b, qpos) * DIN + hd * 64 + fq * 8;
    const bf16x8 qf0 = *(const bf16x8*)qp, qf1 = *(const bf16x8*)(qp + 32);
    unsigned d0 = 0u, d1 = 0u;
    { const unsigned one = 0x3F80u; d0 = ((4 * fq + 0 >= li) ? one : 0u) | ((4 * fq + 1 >= li) ? (one << 16) : 0u); d1 = ((4 * fq + 2 >= li) ? one : 0u) | ((4 * fq + 3 >= li) ? (one << 16) : 0u); }
    const unsigned ONE2 = 0x3F803F80u;
    const bf16x8 F_D1 = __builtin_bit_cast(bf16x8, (v4u){d0, d1, ONE2, ONE2});
    const bf16x8 F_11 = __builtin_bit_cast(bf16x8, (v4u){ONE2, ONE2, ONE2, ONE2});
    const bf16x8 F_0D = __builtin_bit_cast(bf16x8, (v4u){0u, 0u, d0, d1});
#pragma unroll
    for (int i = 0; i < 4; ++i) o[i] = (f32x4){0.f, 0.f, 0.f, 0.f};
    float carry = 0.f;
    const int ktd = p0 >> 6, kbmax = (p0 & 63) >> 4;
    const unsigned trbase = (unsigned)((4 * fq + (li >> 2)) * VPITCH + (lane & 3) * 8);
    bf16x8 kf[4][2];
#define SB_LOADK(KT) do { _Pragma("unroll") for (int kb = 0; kb < 4; ++kb) { int kp = 64 * (KT) + 16 * kb + li; kp = kp < LSEQ ? kp : LSEQ - 1; const bf16* kr = proj + (size_t)rowidx(b, kp) * DIN + C_K + hd * 64 + fq * 8; \
        kf[kb][0] = *(const bf16x8*)kr; kf[kb][1] = *(const bf16x8*)(kr + 32); } } while (0)
    SB_LOADK(ktd);
    for (int kt = ktd; kt >= 0; --kt) {
        const bool diag = (kt == ktd);
#pragma unroll
        for (int it = 0; it < 8; ++it) { const int key = it * 8 + (lane >> 3); int kp = 64 * kt + key; kp = kp < LSEQ ? kp : LSEQ - 1;
            __builtin_amdgcn_global_load_lds((const unsigned*)(proj + (size_t)rowidx(b, kp) * DIN + C_V + hd * 64 + (lane & 7) * 8), (LAS unsigned*)(vl + it * 1024), 16, 0, 0); }
        f32x4 s[4], lnb[4];
#pragma unroll
        for (int kb = 0; kb < 4; ++kb) { s[kb] = mfma16(kf[kb][0], qf0, (f32x4){0.f, 0.f, 0.f, 0.f}); s[kb] = mfma16(kf[kb][1], qf1, s[kb]); }
        { const int ktn = kt > 0 ? kt - 1 : 0; SB_LOADK(ktn); }
#pragma unroll
        for (int kb = 0; kb < 4; ++kb)
#pragma unroll
            for (int e = 0; e < 4; ++e) { const bool m = !diag || (64 * kt + 16 * kb + 4 * fq + e < qpos); lnb[kb][e] = (diag && kb > kbmax) ? 0.f : (m ? -softplus_(s[kb][e]) : 0.f); }
        bf16x8 bh[2], bl[2];
        split_pack(lnb[0], lnb[1], bh[0], bl[0]); split_pack(lnb[2], lnb[3], bh[1], bl[1]);
        f32x4 c[4];
#pragma unroll
        for (int i = 0; i < 4; ++i) c[i] = (f32x4){carry, carry, carry, carry};
        c[0] = mfma16(F_D1, bh[0], c[0]); c[0] = mfma16(F_D1, bl[0], c[0]); c[0] = mfma16(F_11, bh[1], c[0]); c[0] = mfma16(F_11, bl[1], c[0]);
        c[1] = mfma16(F_0D, bh[0], c[1]); c[1] = mfma16(F_0D, bl[0], c[1]); c[1] = mfma16(F_11, bh[1], c[1]); c[1] = mfma16(F_11, bl[1], c[1]);
        c[2] = mfma16(F_D1, bh[1], c[2]); c[2] = mfma16(F_D1, bl[1], c[2]);
        c[3] = mfma16(F_0D, bh[1], c[3]); c[3] = mfma16(F_0D, bl[1], c[3]);
        f32x4 w[4];
#pragma unroll
        for (int kb = 0; kb < 4; ++kb)
#pragma unroll
            for (int e = 0; e < 4; ++e) { const bool m = !diag || (64 * kt + 16 * kb + 4 * fq + e < qpos); w[kb][e] = (diag && kb > kbmax) ? 0.f : (m ? __builtin_amdgcn_exp2f(LOG2E * (s[kb][e] + c[kb][e])) : 0.f); }
        carry = __shfl(c[0][0], li);
        v4u p0v, p1v;
        p0v.x = cvtpk(w[0][0], w[0][1]); p0v.y = cvtpk(w[0][2], w[0][3]); p0v.z = cvtpk(w[1][0], w[1][1]); p0v.w = cvtpk(w[1][2], w[1][3]);
        p1v.x = cvtpk(w[2][0], w[2][1]); p1v.y = cvtpk(w[2][2], w[2][3]); p1v.z = cvtpk(w[3][0], w[3][1]); p1v.w = cvtpk(w[3][2], w[3][3]);
        const bf16x8 pf0 = __builtin_bit_cast(bf16x8, p0v), pf1 = __builtin_bit_cast(bf16x8, p1v);
        asm volatile("s_waitcnt vmcnt(0)" ::: "memory");
#pragma unroll
        for (int db = 0; db < 4; ++db) {
#pragma unroll
            for (int s2 = 0; s2 < 2; ++s2) {
                const v4i16_t lo = __builtin_amdgcn_ds_read_tr16_b64_v4i16((LAS v4i16_t*)(vl + trbase + (32 * s2) * VPITCH + db * 32));
                const v4i16_t hi = __builtin_amdgcn_ds_read_tr16_b64_v4i16((LAS v4i16_t*)(vl + trbase + (32 * s2 + 16) * VPITCH + db * 32));
                const bf16x8 vf = (bf16x8){lo[0], lo[1], lo[2], lo[3], hi[0], hi[1], hi[2], hi[3]};
                o[db] = mfma16(vf, s2 == 0 ? pf0 : pf1, o[db]);
            }
        }
        if (__all(carry < SB_EXIT)) break;
    }
#undef SB_LOADK
}

template <int W> __device__ __forceinline__ void pool_group(const bf16* __restrict__ psrc, const bf16* __restrict__ wpt, int b, int pos, f32x4 (&pacc)[4]) {
    const int cnt = (pos + 1 < W) ? pos + 1 : W; const float inv = 1.0f / (float)cnt;
    constexpr int BW = W < 8 ? W : 8;
#pragma unroll 1
    for (int ks = 0; ks < 4; ++ks) {
        bf16x8 wf[4];
#pragma unroll
        for (int nb = 0; nb < 4; ++nb) wf[nb] = *(const bf16x8*)(wpt + (size_t)nb * 16 * 128 + 32 * ks);
        float sum[8], self[8];
#pragma unroll
        for (int e = 0; e < 8; ++e) { sum[e] = 0.f; self[e] = 0.f; }
#pragma unroll
        for (int j0 = 0; j0 < W; j0 += BW) {
            v4u v[BW];
#pragma unroll
            for (int j = 0; j < BW; ++j) { const int pp = pos - j0 - j; v[j] = *(const v4u*)(psrc + (size_t)rowidx(b, pp >= 0 ? pp : 0) * DIN + 32 * ks); }
#pragma unroll
            for (int j = 0; j < BW; ++j) { const float f = (pos - j0 - j) >= 0 ? 1.0f : 0.0f;
                sum[0] += f * bflo(v[j].x); sum[1] += f * bfhi(v[j].x); sum[2] += f * bflo(v[j].y); sum[3] += f * bfhi(v[j].y);
                sum[4] += f * bflo(v[j].z); sum[5] += f * bfhi(v[j].z); sum[6] += f * bflo(v[j].w); sum[7] += f * bfhi(v[j].w); }
            if (j0 == 0) { self[0] = bflo(v[0].x); self[1] = bfhi(v[0].x); self[2] = bflo(v[0].y); self[3] = bfhi(v[0].y); self[4] = bflo(v[0].z); self[5] = bfhi(v[0].z); self[6] = bflo(v[0].w); self[7] = bfhi(v[0].w); }
            if (j0 + BW < W) __builtin_amdgcn_sched_barrier(0);
        }
        v4u pk; pk.x = cvtpk(sum[0] * inv - self[0], sum[1] * inv - self[1]); pk.y = cvtpk(sum[2] * inv - self[2], sum[3] * inv - self[3]);
        pk.z = cvtpk(sum[4] * inv - self[4], sum[5] * inv - self[5]); pk.w = cvtpk(sum[6] * inv - self[6], sum[7] * inv - self[7]);
        const bf16x8 pf = __builtin_bit_cast(bf16x8, pk);
#pragma unroll
        for (int nb = 0; nb < 4; ++nb) pacc[nb] = mfma16(wf[nb], pf, pacc[nb]);
    }
}

__device__ __forceinline__ void mixer_phase(const Args& A, int l, LAS unsigned char* lds, int tid0, int wave) {
    unsigned char* wsb = gptr(A.ws);
    const bf16* proj = (const bf16*)(wsb + WS_PROJ); bf16* merged = (bf16*)(wsb + WS_MERGED);
    const bf16* wpool_t = (const bf16*)(wsb + WS_WSM) + (size_t)l * 4 * 128 * 128;
    const bf16* wpw_t = (const bf16*)(wsb + WS_WSM + 256 * 1024) + (size_t)l * 512 * 512;
    const float* wdw = gptr(A.w_dw) + (size_t)l * 31 * 512; const float* bdw = gptr(A.b_dw) + l * 512; const float* lng = gptr(A.conv_ln_g) + l * 512; const float* lnb_ = gptr(A.conv_ln_b) + l * 512;
    const float* psc = gptr(A.pool_scale) + l * 512; const float* mg = gptr(A.mix_out_g) + (size_t)l * DM;
    LAS float* Y = (LAS float*)(lds + ML_Y); LAS unsigned short* Ab = (LAS unsigned short*)(lds + ML_AB); LAS float* red = (LAS float*)(lds + ML_RED);
    LAS unsigned char* vl = lds + ML_V + wave * (64 * VPITCH); LAS unsigned char* st = lds + ML_ST + wave * 8192;
    const int nunits = (l + 1 < DEPTH) ? 513 : 512;
    for (int ui = blockIdx.x; ui < nunits; ui += gridDim.x) {
        int ti = ui;
        if (gridDim.x == 256 && ui < 512) { const int w = ui & 255, rnd = ui >> 8; ti = 256 * (w >> 7) + (rnd == 0 ? 128 : 0) + (w & 127); }
        int b, p0; if (ti < 512) { b = ti >> 8; p0 = 16 + 16 * (ti & 255); } else { b = 0; p0 = 0; }
        int tid_l = tid0; asm volatile("" : "+v"(tid_l));
        const int tid = tid_l, lane = tid & 63, li = lane & 15, fq = lane >> 4;
#pragma unroll 1
        for (int hh = 0; hh < ((PROBE_DUP & 64) ? 4 : 2); ++hh) { f32x4 o0[4];
            sb_attention(proj, b, p0, 2 * wave + (hh & 1), vl, lane, o0);
#pragma unroll
            for (int db = 0; db < 4; ++db) *(LAS f32x4*)(st + (((hh & 1) * 4 + db) * 64 + lane) * 16) = o0[db]; }
        __syncthreads();
        {
            const int c = tid; const bf16* pa = proj + C_CA + c;
            float glu[46];
#pragma unroll
            for (int r = 0; r < 46; ++r) { const int pos = p0 - 30 + r; float gv = 0.f;
                if (pos >= 0) { const size_t row = (size_t)rowidx(b, pos); const float a = bf2f(pa[row * DIN]); const float gt = bf2f(pa[row * DIN + 512]); gv = a * sigmoidf_(gt); }
                glu[r] = gv;
                if ((r & 15) == 15) __builtin_amdgcn_sched_barrier(0); }
            const float* wdc = wdw + c; asm volatile("" : "+v"(wdc));
            float y[16]; const float bias = bdw[c];
#pragma unroll
            for (int t = 0; t < 16; ++t) y[t] = bias;
#pragma unroll
            for (int j = 0; j < 31; ++j) { const float w = wdc[j * 512];
#pragma unroll
                for (int t = 0; t < 16; ++t) y[t] += w * glu[t + j]; }
#pragma unroll
            for (int t = 0; t < 16; ++t) Y[t * 516 + c] = y[t];
        }
        __syncthreads();
#pragma unroll
        for (int tt = 0; tt < 2; ++tt) { const int t = 2 * wave + tt; float v[8]; float sm = 0.f;
#pragma unroll
            for (int i = 0; i < 8; ++i) { v[i] = Y[t * 516 + lane + 64 * i]; sm += v[i]; }
            const float mean = wave_sum(sm) * (1.0f / 512.0f); float q = 0.f;
#pragma unroll
            for (int i = 0; i < 8; ++i) { v[i] -= mean; q += v[i] * v[i]; }
            const float rstd = rsqrtf(wave_sum(q) * (1.0f / 512.0f) + EPS);
#pragma unroll
            for (int i = 0; i < 8; ++i) { const int c = lane + 64 * i; const float yn = v[i] * rstd * lng[c] + lnb_[c]; const float a = yn * sigmoidf_(yn); Ab[t * 520 + c] = (unsigned short)(cvtpk(a, 0.f) & 0xffffu); }
        }
        __syncthreads();
        f32x4 cacc[4];
#pragma unroll
        for (int i = 0; i < 4; ++i) cacc[i] = (f32x4){0.f, 0.f, 0.f, 0.f};
        { const bf16* wp = wpw_t + (size_t)(64 * wave + li) * 512 + 8 * fq; const LAS unsigned char* ab = (const LAS unsigned char*)Ab + li * 1040 + fq * 16;
#pragma unroll 4
            for (int ks = 0; ks < 16; ++ks) { const bf16x8 bfr = *(const LAS bf16x8*)(ab + ks * 64);
#pragma unroll
                for (int nb = 0; nb < 4; ++nb) { const bf16x8 wf = *(const bf16x8*)(wp + (size_t)nb * 16 * 512 + ks * 32); cacc[nb] = mfma16(wf, bfr, cacc[nb]); } } }
        f32x4 pacc[4];
#pragma unroll
        for (int i = 0; i < 4; ++i) pacc[i] = (f32x4){0.f, 0.f, 0.f, 0.f};
        { const int g = wave >> 1, nh = wave & 1;
            const bf16* wpt = wpool_t + (size_t)(g * 128 + 64 * nh + li) * 128 + 8 * fq; const bf16* psrc = proj + C_POOL + 128 * g + 8 * fq;
            if (g == 0) pool_group<2>(psrc, wpt, b, p0 + li, pacc); else if (g == 1) pool_group<4>(psrc, wpt, b, p0 + li, pacc); else if (g == 2) pool_group<8>(psrc, wpt, b, p0 + li, pacc); else pool_group<16>(psrc, wpt, b, p0 + li, pacc); }
        f32x4 oa[2][4];
#pragma unroll
        for (int hh = 0; hh < 2; ++hh)
#pragma unroll
            for (int db = 0; db < 4; ++db) oa[hh][db] = *(const LAS f32x4*)(st + ((hh * 4 + db) * 64 + lane) * 16);
        float ssa = 0.f, ssp = 0.f, ssc = 0.f;
        { const int g = wave >> 1, nh = wave & 1;
#pragma unroll
            for (int nb = 0; nb < 4; ++nb) { const f32x4 sc = *(const f32x4*)(psc + 128 * g + 64 * nh + 16 * nb + 4 * fq); pacc[nb] = pacc[nb] * sc; ssp += dot4(pacc[nb]); ssc += dot4(cacc[nb]); ssa += dot4(oa[0][nb]) + dot4(oa[1][nb]); } }
        ssa += __shfl_xor(ssa, 16); ssa += __shfl_xor(ssa, 32); ssp += __shfl_xor(ssp, 16); ssp += __shfl_xor(ssp, 32); ssc += __shfl_xor(ssc, 16); ssc += __shfl_xor(ssc, 32);
        if (lane < 16) { red[wave * 16 + lane] = ssa; red[128 + wave * 16 + lane] = ssp; red[256 + wave * 16 + lane] = ssc; }
        __syncthreads();
        float ta = 0.f, tp = 0.f, tc = 0.f;
#pragma unroll
        for (int w8 = 0; w8 < 8; ++w8) { ta += red[w8 * 16 + li]; tp += red[128 + w8 * 16 + li]; tc += red[256 + w8 * 16 + li]; }
        const float ra = rsqrtf(ta * (1.0f / DATT) + EPS), rp = rsqrtf(tp * (1.0f / DPOOL) + EPS), rc = rsqrtf(tc * (1.0f / DCONV) + EPS);
        bf16* orow = merged + (size_t)rowidx(b, p0 + li) * DM;
#pragma unroll
        for (int hh = 0; hh < 2; ++hh)
#pragma unroll
            for (int db = 0; db < 4; ++db) { const int col = (2 * wave + hh) * 64 + 16 * db + 4 * fq; const f32x4 gv = *(const f32x4*)(mg + col); const f32x4 v = oa[hh][db] * ra * gv;
                v2u w2; w2.x = cvtpk(v.x, v.y); w2.y = cvtpk(v.z, v.w); *(v2u*)(orow + col) = w2; }
        { const int g = wave >> 1, nh = wave & 1;
#pragma unroll
            for (int nb = 0; nb < 4; ++nb) { const int col = DATT + 128 * g + 64 * nh + 16 * nb + 4 * fq; const f32x4 gv = *(const f32x4*)(mg + col); const f32x4 v = pacc[nb] * rp * gv;
                v2u w2; w2.x = cvtpk(v.x, v.y); w2.y = cvtpk(v.z, v.w); *(v2u*)(orow + col) = w2; } }
#pragma unroll
        for (int nb = 0; nb < 4; ++nb) { const int col = DATT + DPOOL + 64 * wave + 16 * nb + 4 * fq; const f32x4 gv = *(const f32x4*)(mg + col); const f32x4 v = cacc[nb] * rc * gv;
            v2u w2; w2.x = cvtpk(v.x, v.y); w2.y = cvtpk(v.z, v.w); *(v2u*)(orow + col) = w2; }
        __syncthreads();
    }
}

#define XB_TMO      128
#define XB_XCNT(j)  (256  + 64 * (j))
#define XB_XSUB(j)  (1280 + 64 * (j))
#define XB_XGEN(j)  (2304 + 64 * (j))
#define XB_TOP      3328
#define XB_TOPGEN   3392
#define XCD_BAR_WORDS 3456
#define XB_SPIN_CAP (1u << 18)

__device__ __forceinline__ unsigned xb_ld(unsigned* p)              { return __hip_atomic_load(p, __ATOMIC_RELAXED, __HIP_MEMORY_SCOPE_AGENT); }
__device__ __forceinline__ unsigned xb_add(unsigned* p, unsigned v) { return __hip_atomic_fetch_add(p, v, __ATOMIC_RELAXED, __HIP_MEMORY_SCOPE_AGENT); }
__device__ __forceinline__ unsigned xb_xcc_id() { return (unsigned)__builtin_amdgcn_s_getreg((3 << 11) | 20) & 0xFu; }
#define XB_SPIN(cond, bar) do { unsigned _sp = 0; while (cond) { __builtin_amdgcn_s_sleep(1); \
    if ((++_sp & 255u) == 0u) { if (xb_ld(&(bar)[XB_TMO])) break; if (_sp > XB_SPIN_CAP) { atomicAdd(&(bar)[XB_TMO], 1u); break; } } } } while (0)

struct XcdBarrier {
    unsigned* bar; unsigned x;
    volatile LAS unsigned* st;
};

__device__ __forceinline__ XcdBarrier xcd_barrier_post(unsigned* bar, volatile LAS unsigned* st) {
    XcdBarrier b; b.bar = bar; b.x = xb_xcc_id(); b.st = st;
    if (threadIdx.x == 0) (void)xb_add(&bar[XB_XCNT(b.x)], 1u);
    return b;
}
__device__ __forceinline__ void xcd_barrier_complete(unsigned* bar, unsigned x, unsigned& nloc, unsigned& nx) {
    const unsigned G = gridDim.x * gridDim.y * gridDim.z;
    unsigned sum, cnt, mine, sp = 0u;
    for (;;) {
        sum = 0u; cnt = 0u; mine = 0u;
#pragma unroll
        for (unsigned j = 0; j < 16; ++j) { const unsigned c = xb_ld(&bar[XB_XCNT(j)]); sum += c; cnt += (c > 0u) ? 1u : 0u; mine = (j == x) ? c : mine; }
        if (sum == G) break;
        __builtin_amdgcn_s_sleep(1);
        if ((++sp & 255u) == 0u) { if (xb_ld(&bar[XB_TMO])) break; if (sp > XB_SPIN_CAP) { atomicAdd(&bar[XB_TMO], 1u); break; } }
    }
    nloc = mine > 0u ? mine : 1u; nx = cnt > 0u ? cnt : 1u;
}

__device__ __forceinline__ void xcd_barrier(const XcdBarrier& b) {
    asm volatile("s_waitcnt vmcnt(0)" ::: "memory");
    __syncthreads();
    if (threadIdx.x == 0) {
        unsigned* bar = b.bar;
        __builtin_amdgcn_s_waitcnt(0);
        unsigned nloc = b.st[0], nx = b.st[1];
        if (nloc == 0u) { xcd_barrier_complete(bar, b.x, nloc, nx); b.st[0] = nloc; b.st[1] = nx; }
        const unsigned old = xb_add(&bar[XB_XSUB(b.x)], 1u);
        const unsigned gen = old / nloc;
        if (old + 1u == (gen + 1u) * nloc) {
            __builtin_amdgcn_fence(__ATOMIC_RELEASE, "agent");
            asm volatile("s_waitcnt vmcnt(0)" ::: "memory");
            const unsigned og = xb_add(&bar[XB_TOP], 1u);
            const unsigned tg = og / nx;
            if (og + 1u == (tg + 1u) * nx) xb_add(&bar[XB_TOPGEN], 1u);
            else XB_SPIN(xb_ld(&bar[XB_TOPGEN]) == tg, bar);
            __builtin_amdgcn_fence(__ATOMIC_ACQUIRE, "agent");
            xb_add(&bar[XB_XGEN(b.x)], 1u);
            asm volatile("s_waitcnt vmcnt(0)" ::: "memory");
        } else {
            XB_SPIN(xb_ld(&bar[XB_XGEN(b.x)]) == gen, bar);
            __builtin_amdgcn_fence(__ATOMIC_ACQUIRE, "agent");
            asm volatile("s_waitcnt vmcnt(0)" ::: "memory");
        }
    }
    __syncthreads();
}

constexpr int NPHASE = 1 + 7 * DEPTH;
#define PHASE_ENTER() int tid_ = threadIdx.x; asm volatile("" : "+v"(tid_)); const int tid = tid_, lane = tid & 63, wave = __builtin_amdgcn_readfirstlane(tid >> 6); \
    const __attribute__((address_space(4))) Args* ka_ = (const __attribute__((address_space(4))) Args*)__builtin_amdgcn_kernarg_segment_ptr(); asm volatile("" : "+s"(ka_)); Args A; __builtin_memcpy(&A, ka_, sizeof(Args)); \
    const int G = gridDim.x, gw = blockIdx.x * 8 + wave, NGW = G * 8; LAS float* scr = (LAS float*)(lds + wave * 16640); (void)tid; (void)lane; (void)gw; (void)NGW; (void)scr; (void)G;
__global__ void __launch_bounds__(512, 2) fwd_megakernel(Args args) {
    extern __shared__ __attribute__((aligned(16))) unsigned char lds_raw[];
    LAS unsigned char* lds = (LAS unsigned char*)lds_raw;
    cg::grid_group grid = cg::this_grid();
    const int lo = args.ph_lo, hi = args.ph_hi;
    volatile LAS unsigned* bst = (volatile LAS unsigned*)(lds + LDS_BYTES - 64);
    if (threadIdx.x < 16) bst[threadIdx.x] = 0u;
    __syncthreads();
    XcdBarrier bar = xcd_barrier_post((unsigned*)(args.ws + WS_CTL), bst);
#if !MK_SPLIT
    grid.sync();
#endif
#define IN(k) (lo <= (k) && (k) < hi)
#define SEAM(k) do { if (IN(k) && IN((k) + 1)) xcd_barrier(bar); } while (0)
    int k = 0;
    for (int rep = 0; rep < ((PROBE_DUP & 1) ? 2 : 1); ++rep) if (IN(k)) { if (rep) xcd_barrier(bar); PHASE_ENTER(); convert_p0_weights(A, scr, gw, NGW, lane); init_rows(A, gw, NGW, lane); }
    SEAM(k); ++k;
    for (int l = 0; l < DEPTH; ++l) {
        for (int rep = 0; rep < ((PROBE_DUP & 4) ? 2 : 1); ++rep) if (IN(k)) { if (rep) xcd_barrier(bar); PHASE_ENTER(); unsigned char* wsb = gptr(A.ws);
            pg8::Gemm g{(const bf16*)(wsb + WS_U), (const bf16*)(wsb + WS_WIN) + (size_t)l * DIN * DM, MR, DIN, DM}; pg8::StaticOrder S; S.init(MR, DIN, G, (int)blockIdx.x);
            pg8::EpiBf16<0> E{(bf16*)(wsb + WS_PROJ), DIN, nullptr, 1024, 1024, 0.125f};
            pg8::gemm_phase<pg8::EpiBf16<0>, pg8::StaticOrder, PG8_ALIGN, PG8_SP2>(lds, g, S, E);
            __syncthreads();
            { const int ex = ((MR / 256) * (DIN / 256)) % G, c = (int)blockIdx.x;
                if (ex == 0 || c >= ex) { const int c0 = ex == 0 ? 0 : ex, gw2 = (c - c0) * 8 + wave, n2 = (G - c0) * 8; convert_ffn_weights(A, l, scr, gw2, n2, lane); if (l == 0) convert_wout(A, 0, scr, gw2, n2, lane); } }
            __syncthreads(); skinny_gemm<0>((const bf16*)(wsb + WS_U) + (size_t)MR * DM, (const bf16*)(wsb + WS_WIN) + (size_t)l * DIN * DM, DIN, DM, (void*)(wsb + WS_PROJ), DIN, lds, lane, wave);
        }
        SEAM(k); ++k;
        for (int rep = 0; rep < ((PROBE_DUP & 2) ? 2 : 1); ++rep) if (IN(k)) { if (rep) xcd_barrier(bar); PHASE_ENTER(); mixer_phase(A, l, lds, tid, wave); }
        SEAM(k); ++k;
        for (int rep = 0; rep < ((PROBE_DUP & 16) ? 2 : 1); ++rep) if (IN(k)) { if (rep) xcd_barrier(bar); PHASE_ENTER(); unsigned char* wsb = gptr(A.ws);
            pg8::Gemm g{(const bf16*)(wsb + WS_MERGED), (const bf16*)(wsb + WS_WOUT) + (size_t)l * DM * DM, MR, DM, DM}; pg8::StaticOrder S; S.init(MR, DM, G, (int)blockIdx.x);
            pg8::EpiF32 E{(float*)(wsb + WS_OUT), DM};
            pg8::gemm_phase<pg8::EpiF32, pg8::StaticOrder, PG8_ALIGN, PG8_SP2>(lds, g, S, E);
            __syncthreads(); if (l + 1 < DEPTH) skinny_gemm<1>((const bf16*)(wsb + WS_MERGED) + (size_t)MR * DM, (const bf16*)(wsb + WS_WOUT) + (size_t)l * DM * DM, DM, DM, (void*)(wsb + WS_OUT), DM, lds, lane, wave);
        }
        SEAM(k); ++k;
        if (IN(k)) { PHASE_ENTER(); row_phase(A, A.post_mix_g + (size_t)l * DM, A.pre_ffn_g + (size_t)l * DM, nullptr, (l + 1 < DEPTH) ? MV : MR, gw, NGW, lane); }
        SEAM(k); ++k;
        for (int rep = 0; rep < ((PROBE_DUP & 32) ? 2 : 1); ++rep) if (IN(k)) { if (rep) xcd_barrier(bar); PHASE_ENTER(); unsigned char* wsb = gptr(A.ws);
            pg8::Gemm g{(const bf16*)(wsb + WS_U), (const bf16*)(wsb + WS_WGU), MR, 2 * DFF, DM}; pg8::StaticOrder S; S.init(MR, 2 * DFF, G, (int)blockIdx.x);
            pg8::EpiSwiGLU E{(bf16*)(wsb + WS_ACT), DFF};
            pg8::gemm_phase<pg8::EpiSwiGLU, pg8::StaticOrder, PG8_ALIGN, PG8_SP2>(lds, g, S, E);
            __syncthreads();
            if (l + 1 < DEPTH) { const int ex = ((MR / 256) * (2 * DFF / 256)) % G, c = (int)blockIdx.x;
                if (ex == 0 || c >= ex) { const int c0 = ex == 0 ? 0 : ex, gw2 = (c - c0) * 8 + wave, n2 = (G - c0) * 8; convert_win(A, l + 1, scr, gw2, n2, lane); convert_wout(A, l + 1, scr, gw2, n2, lane); } }
            __syncthreads(); if (l + 1 < DEPTH) skinny_gemm<2>((const bf16*)(wsb + WS_U) + (size_t)MR * DM, (const bf16*)(wsb + WS_WGU), 2 * DFF, DM, (void*)(wsb + WS_ACT), DFF, lds, lane, wave);
        }
        SEAM(k); ++k;
        for (int rep = 0; rep < ((PROBE_DUP & 8) ? 2 : 1); ++rep) if (IN(k)) { if (rep) xcd_barrier(bar); PHASE_ENTER(); unsigned char* wsb = gptr(A.ws);
            pg8::Gemm g{(const bf16*)(wsb + WS_ACT), (const bf16*)(wsb + WS_WD), MR, DM, DFF}; pg8::StaticOrder S; S.init(MR, DM, G, (int)blockIdx.x);
            pg8::EpiF32 E{(float*)(wsb + WS_OUT), DM};
            pg8::gemm_phase<pg8::EpiF32, pg8::StaticOrder, PG8_ALIGN, PG8_SP2>(lds, g, S, E);
            __syncthreads(); if (l + 1 < DEPTH) skinny_gemm<1>((const bf16*)(wsb + WS_ACT) + (size_t)MR * DFF, (const bf16*)(wsb + WS_WD), DM, DFF, (void*)(wsb + WS_OUT), DM, lds, lane, wave);
        }
        SEAM(k); ++k;
        if (IN(k)) { PHASE_ENTER();
            if (l + 1 < DEPTH) { row_phase(A, A.post_ffn_g + (size_t)l * DM, A.pre_mix_g + (size_t)(l + 1) * DM, nullptr, MV, gw, NGW, lane); }
            else row_phase(A, A.post_ffn_g + (size_t)l * DM, nullptr, A.out, MR, gw, NGW, lane);
        }
        if (l + 1 < DEPTH) { SEAM(k); } ++k;
    }
#undef IN
#undef SEAM
}

extern "C" void kernel_launch(void* const* d_in, const int* in_sizes, int n_in, void* d_out, int out_size, void* d_ws, size_t ws_size, hipStream_t stream) {
    static int grid = 0;
    if (grid == 0) {
        if (n_in != 19 || in_sizes[0] != MR * DM || out_size != MR * DM || ws_size < WS_END) { fprintf(stderr, "kernel_launch: unexpected problem (n_in %d, in0 %d, out %d, ws %zu, need %zu)\n", n_in, n_in > 0 ? in_sizes[0] : -1, out_size, ws_size, (size_t)WS_END); grid = -1; return; }
        int dev = 0, cus = 0, per_cu = 0;
        if (hipGetDevice(&dev) != hipSuccess || hipDeviceGetAttribute(&cus, hipDeviceAttributeMultiprocessorCount, dev) != hipSuccess) { grid = -1; return; }
        if (hipFuncSetAttribute((const void*)fwd_megakernel, hipFuncAttributeMaxDynamicSharedMemorySize, LDS_BYTES) != hipSuccess) { fprintf(stderr, "kernel_launch: hipFuncSetAttribute failed\n"); grid = -1; return; }
        if (hipOccupancyMaxActiveBlocksPerMultiprocessor(&per_cu, (const void*)fwd_megakernel, 512, LDS_BYTES) != hipSuccess || per_cu < 1) { fprintf(stderr, "kernel_launch: occupancy query says %d blocks per CU\n", per_cu); per_cu = 1; }
        (void)hipGetLastError();
        grid = cus;
    }
    if (grid < 0) return;
    if (hipMemsetAsync((unsigned char*)d_ws + WS_CTL, 0, CTL_BYTES, stream) != hipSuccess) { fprintf(stderr, "kernel_launch: hipMemsetAsync failed\n"); return; }
    Args a{};
    const float** ap = (const float**)&a;
    for (int i = 0; i < 19; ++i) ap[i] = (const float*)d_in[i];
    a.out = (float*)d_out; a.ws = (unsigned char*)d_ws;
#if MK_SPLIT
    for (int ph = 0; ph < NPHASE; ++ph) { a.ph_lo = ph; a.ph_hi = ph + 1; hipLaunchKernelGGL(fwd_megakernel, dim3(grid), dim3(512), LDS_BYTES, stream, a); }
#else
    a.ph_lo = 0; a.ph_hi = NPHASE;
    void* kargs[] = {(void*)&a};
    const hipError_t e = hipLaunchCooperativeKernel((const void*)fwd_megakernel, dim3(grid), dim3(512), kargs, LDS_BYTES, stream);
    if (e != hipSuccess) fprintf(stderr, "kernel_launch: cooperative launch failed: %s (grid %d)\n", hipGetErrorString(e), grid);
#endif
}
```

```cpp
#include <hip/hip_runtime.h>
#include <hip/hip_cooperative_groups.h>
#include <cstdio>
#include <cstdint>
namespace cg = cooperative_groups;
namespace pg8 {
#define PG8_LAS __attribute__((address_space(3)))
typedef unsigned short bf16_t;
typedef short bf16x8 __attribute__((ext_vector_type(8)));
typedef float f32x4 __attribute__((ext_vector_type(4)));
typedef unsigned u32x4 __attribute__((ext_vector_type(4)));
constexpr int BM = 256, BK = 64, HALF = 128, HTB = HALF * BK * 2  , STAGE_BYTES = 8 * HTB, NXCD = 8, WGM = 8;

__host__ __device__ __forceinline__ int lds_byte(int r, int c) { const int st = (r >> 4) * 2 + (c >> 5), rr = r & 15, cc = c & 31, ob = rr * 64 + cc * 2; return st * 1024 + (ob ^ (((ob >> 9) & 1) << 5)); }
__host__ __device__ __forceinline__ void stage_rc(int b, int& R, int& C) { const int st = b / 1024, sb = b % 1024, swz = sb ^ (((sb >> 9) & 1) << 5); R = (st >> 1) * 16 + swz / 64; C = (st & 1) * 32 + (swz % 64) / 2; }
__host__ __device__ __forceinline__ int perm32(int rho) { const int n = rho >> 4, i = rho & 15; return 8 * (i >> 2) + 4 * n + (i & 3); }

struct Unit { int pm, pn; };
struct Gemm { const bf16_t* A; const bf16_t* Bt; int M, N, K; };

struct StaticOrder {
    int nM, nN, nwg, G, c;
    __host__ __device__ void init(int M, int N, int G_, int c_) { nM = M / BM; nN = N / BM; nwg = nM * nN; G = G_; c = c_; }
    __host__ __device__ bool next(int i, Unit& u) const {
        const long L = (long)i * G + c; if (L >= nwg) return false;
        int wgid = (int)L; { const int q = nwg / NXCD, r = nwg % NXCD, xcd = wgid % NXCD, off = wgid / NXCD; wgid = (xcd < r ? xcd * (q + 1) : r * (q + 1) + (xcd - r) * q) + off; }
        const int nig = WGM * nN, gid = wgid / nig, fm = gid * WGM, gsz = (nM - fm) < WGM ? (nM - fm) : WGM;
        u.pm = fm + ((wgid % nig) % gsz); u.pn = (wgid % nig) / gsz; return true;
    }
    __device__ __forceinline__ void a_ready(const Unit&) const {}
    __device__ __forceinline__ void done(const Unit&) const {}
};

__device__ __forceinline__ unsigned cvt_pk_bf16(float lo, float hi) { unsigned r; asm volatile("v_cvt_pk_bf16_f32 %0, %1, %2" : "=v"(r) : "v"(lo), "v"(hi)); return r; }
typedef float f32x2 __attribute__((ext_vector_type(2)));
__device__ __forceinline__ f32x2 gelu_pk(f32x2 v) {
    const f32x2 av = __builtin_elementwise_abs(v), d = av * 0.2316418882f + 1.0f;
    f32x2 t; t.x = __builtin_amdgcn_rcpf(d.x); t.y = __builtin_amdgcn_rcpf(d.y);
    f32x2 q = t * 0.5307027145f + (-0.7265760135f); q = q * t + 0.7107068705f; q = q * t + (-0.142248368f); q = q * t + 0.127414796f; q = q * t;
    const f32x2 s = (v * v) * (-0.72134752044f);
    f32x2 e; e.x = __builtin_amdgcn_exp2f(s.x); e.y = __builtin_amdgcn_exp2f(s.y);
    const f32x2 m = v * (q * e), r = v - m;
    f32x2 o; o.x = v.x < 0.f ? m.x : r.x; o.y = v.y < 0.f ? m.y : r.y; return o;
}

template <int ACT  > struct EpiBf16 {
    static constexpr bool PERM = true, AFTER_DRAIN = false; static_assert(ACT == 0 || ACT == 1, "EpiBf16: ACT is 0 (none) or 1 (gelu_pk)");
    bf16_t* O; int ldc; const float* bias; int split_cols; size_t split_stride; float scale0;
    __device__ __forceinline__ void operator()(const f32x4 (&acc)[2][2][4][2], const Unit& u, int wr, int wc, int fr, int fq) const {
        const int row0 = u.pm * BM + wr * 64 + fr; int colt = u.pn * BM; bf16_t* base = O;
        float sc = 1.f; if (split_cols) { const int t = colt / split_cols; base += (size_t)t * split_stride; colt -= t * split_cols; if (t == 0) sc = scale0; }
        const int col0 = colt + wc * 32 + 8 * fq, bcol0 = u.pn * BM + wc * 32 + 8 * fq;
        f32x4 bv[2][2];
#pragma unroll
        for (int bj = 0; bj < 2; ++bj)
#pragma unroll
            for (int n = 0; n < 2; ++n) bv[bj][n] = bias ? *(const f32x4*)(bias + bcol0 + bj * HALF + 4 * n) : (f32x4){0.f, 0.f, 0.f, 0.f};
#pragma unroll
        for (int ai = 0; ai < 2; ++ai)
#pragma unroll
            for (int m = 0; m < 4; ++m) { bf16_t* rowp = base + (size_t)(row0 + ai * HALF + m * 16) * ldc + col0;
#pragma unroll
                for (int bj = 0; bj < 2; ++bj) { f32x4 v0 = acc[ai][bj][m][0] + bv[bj][0], v1 = acc[ai][bj][m][1] + bv[bj][1];
                    if (ACT == 1) { f32x2 a = gelu_pk((f32x2){v0[0], v0[1]}), b = gelu_pk((f32x2){v0[2], v0[3]}), c = gelu_pk((f32x2){v1[0], v1[1]}), d = gelu_pk((f32x2){v1[2], v1[3]});
                        v0 = (f32x4){a.x, a.y, b.x, b.y}; v1 = (f32x4){c.x, c.y, d.x, d.y}; }
                    v0 = v0 * sc; v1 = v1 * sc; u32x4 w; w.x = cvt_pk_bf16(v0[0], v0[1]); w.y = cvt_pk_bf16(v0[2], v0[3]); w.z = cvt_pk_bf16(v1[0], v1[1]); w.w = cvt_pk_bf16(v1[2], v1[3]);
                    *(u32x4*)(rowp + bj * HALF) = w; } }
    }
};
__device__ __forceinline__ unsigned cvtpk_rne(float lo, float hi) { typedef float f32x2_t __attribute__((ext_vector_type(2))); typedef __bf16 bf16x2_t __attribute__((ext_vector_type(2)));
    f32x2_t v = {lo, hi}; bf16x2_t b = __builtin_convertvector(v, bf16x2_t); return __builtin_bit_cast(unsigned, b); }
struct EpiF32 {
    static constexpr bool PERM = false, AFTER_DRAIN = false;
    float* O; int ldc;
    __device__ __forceinline__ void operator()(const f32x4 (&acc)[2][2][4][2], const Unit& u, int wr, int wc, int fr, int fq) const {
        const int row0 = u.pm * BM + wr * 64 + fr, col0 = u.pn * BM + wc * 32 + 4 * fq;
#pragma unroll
        for (int ai = 0; ai < 2; ++ai)
#pragma unroll
            for (int m = 0; m < 4; ++m) { float* rowp = O + (size_t)(row0 + ai * HALF + m * 16) * ldc + col0;
#pragma unroll
                for (int bj = 0; bj < 2; ++bj)
#pragma unroll
                    for (int n = 0; n < 2; ++n) *(f32x4*)(rowp + bj * HALF + n * 16) = acc[ai][bj][m][n]; }
    }
};
struct EpiSwiGLU {
    static constexpr bool PERM = true, AFTER_DRAIN = false;
    bf16_t* O; int ldc;
    __device__ __forceinline__ void operator()(const f32x4 (&acc)[2][2][4][2], const Unit& u, int wr, int wc, int fr, int fq) const {
        typedef unsigned u32x2 __attribute__((ext_vector_type(2)));
        const int row0 = u.pm * BM + wr * 64 + fr, col0 = u.pn * (BM / 2) + wc * 16 + 4 * fq;
#pragma unroll
        for (int ai = 0; ai < 2; ++ai)
#pragma unroll
            for (int m = 0; m < 4; ++m) { bf16_t* rowp = O + (size_t)(row0 + ai * HALF + m * 16) * ldc + col0;
#pragma unroll
                for (int bj = 0; bj < 2; ++bj) { const f32x4 g = acc[ai][bj][m][0], up = acc[ai][bj][m][1]; float a[4];
#pragma unroll
                    for (int e = 0; e < 4; ++e) a[e] = g[e] * __builtin_amdgcn_rcpf(1.0f + __builtin_amdgcn_exp2f(-1.4426950408889634f * g[e])) * up[e];
                    u32x2 w; w.x = cvtpk_rne(a[0], a[1]); w.y = cvtpk_rne(a[2], a[3]); *(u32x2*)(rowp + bj * (HALF / 2)) = w; } }
    }
};

template <class Epi, class Sched, bool ALIGN_EPI = false, bool SP2 = false>
__device__ __forceinline__ void gemm_phase(PG8_LAS unsigned char* lds, const Gemm g, const Sched& S, const Epi& E) {
    int tid_ = threadIdx.x; asm volatile("" : "+v"(tid_));
    const int tid = tid_, wid = __builtin_amdgcn_readfirstlane(tid >> 6), lane = tid & 63, wr = wid >> 2, wc = wid & 3, fr = lane & 15, fq = lane >> 4;
    const int K = g.K, nt = K / BK;
    unsigned voffA[2], voffB[2];
#pragma unroll
    for (int i = 0; i < 2; ++i) { int R, C; stage_rc(tid * 16 + i * 8192, R, C); const int Rb = Epi::PERM ? ((R & ~31) + perm32(R & 31)) : R;
        voffA[i] = (unsigned)(R * K + C) * 2u; voffB[i] = (unsigned)(Rb * K + C) * 2u; }
    const size_t kstep = (size_t)(BK * 2);
    const size_t hstep = (size_t)HALF * K * 2;
    const size_t tstep = 2 * hstep;
    const unsigned ldsw = (unsigned)wid * 1024u;
    const int aoff = lds_byte(wr * 64 + fr, fq * 8), boff = lds_byte(wc * 32 + fr, fq * 8);
#define PG8_SA(b, h) (((b) * 2 + (h)) * HTB)
#define PG8_SB(b, h) ((4 + (b) * 2 + (h)) * HTB)
#define PG8_STAGE(bufoff, gbase, voff) do { _Pragma("unroll") for (int _i = 0; _i < 2; ++_i) \
        __builtin_amdgcn_global_load_lds((const unsigned*)((const char*)(gbase) + (voff)[_i]), (PG8_LAS unsigned*)(lds + (bufoff) + ldsw + _i * 8192), 16, 0, 0); } while (0)
#define PG8_LDA(dst, b, h) do { _Pragma("unroll") for (int m = 0; m < 4; ++m) _Pragma("unroll") for (int k = 0; k < 2; ++k) dst[m][k] = *(const PG8_LAS bf16x8*)(lds + PG8_SA(b, h) + aoff + m * 2048 + k * 1024); } while (0)
#define PG8_LDB(dst, b, h) do { _Pragma("unroll") for (int n = 0; n < 2; ++n) _Pragma("unroll") for (int k = 0; k < 2; ++k) dst[n][k] = *(const PG8_LAS bf16x8*)(lds + PG8_SB(b, h) + boff + n * 2048 + k * 1024); } while (0)
#define PG8_MMA(ai, bj, At, Bt) do { __builtin_amdgcn_s_setprio(1); _Pragma("unroll") for (int m = 0; m < 4; ++m) _Pragma("unroll") for (int n = 0; n < 2; ++n) _Pragma("unroll") for (int k = 0; k < 2; ++k) \
        acc[ai][bj][m][n] = __builtin_amdgcn_mfma_f32_16x16x32_bf16(Bt[n][k], At[m][k], acc[ai][bj][m][n], 0, 0, 0); __builtin_amdgcn_s_setprio(0); } while (0)
#define PG8_WAIT_V(n) asm volatile("s_waitcnt vmcnt(" #n ")" ::: "memory")
#define PG8_WAIT_L(n) asm volatile("s_waitcnt lgkmcnt(" #n ")" ::: "memory")
#define PG8_BAR __builtin_amdgcn_s_barrier()
#define PG8_SCHED __builtin_amdgcn_sched_barrier(0)
    Unit cur, nxt; int ui = 0;
    if (!S.next(0, cur)) return;
    f32x4 acc[2][2][4][2];
#pragma unroll
    for (int a = 0; a < 2; ++a)
#pragma unroll
        for (int b = 0; b < 2; ++b)
#pragma unroll
            for (int m = 0; m < 4; ++m)
#pragma unroll
                for (int n = 0; n < 2; ++n) acc[a][b][m][n] = (f32x4){0.f, 0.f, 0.f, 0.f};
    bf16x8 At[4][2], B0[2][2], B1[2][2];
    const char* cA = (const char*)g.A + (size_t)cur.pm * tstep; const char* cB = (const char*)g.Bt + (size_t)cur.pn * tstep;
    S.a_ready(cur);
    if constexpr (SP2) {
        PG8_STAGE(PG8_SB(0, 0), cB, voffB); PG8_STAGE(PG8_SB(0, 1), cB + hstep, voffB); PG8_STAGE(PG8_SA(0, 0), cA, voffA); PG8_STAGE(PG8_SA(0, 1), cA + hstep, voffA);
        if (wr == 1) PG8_BAR;
        PG8_WAIT_V(2); PG8_BAR;
        PG8_STAGE(PG8_SB(1, 0), cB + kstep, voffB); PG8_STAGE(PG8_SA(1, 0), cA + kstep, voffA); PG8_STAGE(PG8_SB(1, 1), cB + hstep + kstep, voffB);
        PG8_WAIT_V(6); PG8_BAR;
    } else {
        PG8_STAGE(PG8_SB(0, 0), cB, voffB); PG8_STAGE(PG8_SA(0, 0), cA, voffA); PG8_STAGE(PG8_SB(0, 1), cB + hstep, voffB); PG8_STAGE(PG8_SA(0, 1), cA + hstep, voffA);
        if (wr == 1) PG8_BAR;
        PG8_WAIT_V(4); PG8_BAR;
        PG8_STAGE(PG8_SB(1, 0), cB + kstep, voffB); PG8_STAGE(PG8_SA(1, 0), cA + kstep, voffA); PG8_STAGE(PG8_SB(1, 1), cB + hstep + kstep, voffB);
        PG8_WAIT_V(6); PG8_BAR;
    }
    for (;;) {
        const bool has_next = S.next(ui + 1, nxt);
        const char* nA = has_next ? (const char*)g.A + (size_t)nxt.pm * tstep : cA; const char* nB = has_next ? (const char*)g.Bt + (size_t)nxt.pn * tstep : cB;
        for (int t = 0; t < nt; t += 2) {
            const bool last = (t == nt - 2);
            const char* a1 = cA + (size_t)(t + 1) * kstep;
            const char* a2 = last ? nA : cA + (size_t)(t + 2) * kstep; const char* b2 = last ? nB : cB + (size_t)(t + 2) * kstep;
            const char* a3 = a2 + kstep; const char* b3 = b2 + kstep;
            if (last && has_next) S.a_ready(nxt);
            if constexpr (SP2) {
            PG8_LDB(B0, 0, 0); PG8_LDB(B1, 0, 1); PG8_SCHED; PG8_LDA(At, 0, 0); PG8_STAGE(PG8_SA(1, 1), a1 + hstep, voffA);
            PG8_WAIT_V(8); PG8_WAIT_L(0); PG8_BAR; PG8_MMA(0, 0, At, B0); PG8_MMA(0, 1, At, B1); PG8_BAR; PG8_SCHED;
            PG8_LDA(At, 0, 1); PG8_STAGE(PG8_SB(0, 0), b2, voffB); PG8_STAGE(PG8_SB(0, 1), b2 + hstep, voffB); PG8_STAGE(PG8_SA(0, 0), a2, voffA);
            PG8_WAIT_V(8); PG8_WAIT_L(0); PG8_BAR; PG8_MMA(1, 0, At, B0); PG8_MMA(1, 1, At, B1); PG8_BAR; PG8_SCHED;
            PG8_LDB(B0, 1, 0); PG8_LDB(B1, 1, 1); PG8_SCHED; PG8_LDA(At, 1, 0); PG8_STAGE(PG8_SA(0, 1), a2 + hstep, voffA);
            PG8_WAIT_V(8); PG8_WAIT_L(0); PG8_BAR; PG8_MMA(0, 0, At, B0); PG8_MMA(0, 1, At, B1); PG8_BAR; PG8_SCHED;
            PG8_LDA(At, 1, 1); PG8_STAGE(PG8_SB(1, 0), b3, voffB); PG8_STAGE(PG8_SB(1, 1), b3 + hstep, voffB); PG8_STAGE(PG8_SA(1, 0), a3, voffA);
            PG8_WAIT_V(8); PG8_WAIT_L(0); PG8_BAR; PG8_MMA(1, 0, At, B0); PG8_MMA(1, 1, At, B1); PG8_BAR; PG8_SCHED;
            } else {
            PG8_LDB(B0, 0, 0); PG8_SCHED; PG8_LDA(At, 0, 0); PG8_STAGE(PG8_SA(1, 1), a1 + hstep, voffA);
            PG8_WAIT_L(8); PG8_BAR; PG8_WAIT_L(0); PG8_MMA(0, 0, At, B0); PG8_BAR; PG8_SCHED;
            PG8_LDB(B1, 0, 1); PG8_STAGE(PG8_SB(0, 0), b2, voffB);
            PG8_BAR; PG8_WAIT_L(0); PG8_MMA(0, 1, At, B1); PG8_BAR;
            PG8_LDA(At, 0, 1); PG8_STAGE(PG8_SA(0, 0), a2, voffA);
            PG8_BAR; PG8_WAIT_L(0); PG8_MMA(1, 0, At, B0); PG8_BAR; PG8_SCHED;
            PG8_STAGE(PG8_SB(0, 1), b2 + hstep, voffB);
            PG8_WAIT_V(6); PG8_BAR; PG8_MMA(1, 1, At, B1); PG8_BAR;
            PG8_LDB(B0, 1, 0); PG8_SCHED; PG8_LDA(At, 1, 0); PG8_STAGE(PG8_SA(0, 1), a2 + hstep, voffA);
            PG8_WAIT_L(8); PG8_BAR; PG8_WAIT_L(0); PG8_MMA(0, 0, At, B0); PG8_BAR; PG8_SCHED;
            PG8_LDB(B1, 1, 1); PG8_STAGE(PG8_SB(1, 0), b3, voffB);
            PG8_BAR; PG8_WAIT_L(0); PG8_MMA(0, 1, At, B1); PG8_BAR;
            PG8_LDA(At, 1, 1); PG8_STAGE(PG8_SA(1, 0), a3, voffA);
            PG8_BAR; PG8_WAIT_L(0); PG8_MMA(1, 0, At, B0); PG8_BAR; PG8_SCHED;
            PG8_STAGE(PG8_SB(1, 1), b3 + hstep, voffB);
            PG8_WAIT_V(6); PG8_BAR; PG8_MMA(1, 1, At, B1); PG8_BAR;
            }
        }
        if constexpr (ALIGN_EPI) { if (wr == 0) PG8_BAR; }
        if constexpr (!Epi::AFTER_DRAIN) { E(acc, cur, wr, wc, fr, fq); S.done(cur); }
        if (!has_next) break;
#pragma unroll
        for (int a = 0; a < 2; ++a)
#pragma unroll
            for (int b = 0; b < 2; ++b)
#pragma unroll
                for (int m = 0; m < 4; ++m)
#pragma unroll
                    for (int n = 0; n < 2; ++n) acc[a][b][m][n] = (f32x4){0.f, 0.f, 0.f, 0.f};
        cur = nxt; cA = nA; cB = nB; ++ui;
        if constexpr (ALIGN_EPI) { if (wr == 1) PG8_BAR; }
    }
    PG8_WAIT_V(0);
    if constexpr (!ALIGN_EPI) { if (wr == 0) PG8_BAR; }
    PG8_BAR;
    if constexpr (Epi::AFTER_DRAIN) { E.fused(acc, cur, wr, wc, fr, fq, lds, wid, lane); S.done(cur); }
#undef PG8_SA
#undef PG8_SB
#undef PG8_STAGE
#undef PG8_LDA
#undef PG8_LDB
#undef PG8_MMA
#undef PG8_WAIT_V
#undef PG8_WAIT_L
#undef PG8_BAR
#undef PG8_SCHED
}
}

#ifndef PG8_SP2
#define PG8_SP2 true
#endif
#ifndef PG8_ALIGN
#define PG8_ALIGN true
#endif
#ifndef PROBE_DUP
#define PROBE_DUP 0
#endif
#ifndef MK_SPLIT
#define MK_SPLIT 0
#endif

constexpr int NB = 2, SEQ = 4096, DM = 2048, NMETA = 16, LSEQ = SEQ + NMETA, DEPTH = 2;
constexpr int MR = NB * SEQ;
constexpr int MV = MR + NMETA;
constexpr int MP = 33 * 256;
constexpr int DIN = 4608, DFF = 5632, DATT = 1024, DPOOL = 512, DCONV = 512, NHEAD = 16;
constexpr int C_K = 1024, C_V = 2048, C_POOL = 3072, C_CA = 3584, C_CG = 4096;
constexpr float EPS = 1e-6f, LOG2E = 1.4426950408889634f, LN2 = 0.6931471805599453f;
constexpr float SB_EXIT = -104.0f;

constexpr size_t MiB = 1u << 20;
constexpr size_t WS_WIN = 0;
constexpr size_t WS_WOUT = WS_WIN + 36 * MiB;
constexpr size_t WS_WGU = WS_WOUT + 16 * MiB;
constexpr size_t WS_WD = WS_WGU + 44 * MiB;
constexpr size_t WS_WSM = WS_WD + 22 * MiB;
constexpr size_t WS_H = WS_WSM + 2 * MiB;
constexpr size_t WS_U = WS_H + 66 * MiB;
constexpr size_t WS_OUT = WS_U + 33 * MiB;
constexpr size_t WS_PROJ = WS_OUT + 66 * MiB;
constexpr size_t WS_MERGED = WS_PROJ + (size_t)MP * DIN * 2;
constexpr size_t WS_ACT = WS_PROJ;
constexpr size_t WS_CTL = WS_MERGED + 33 * MiB;
constexpr size_t CTL_BYTES = 65536;
constexpr size_t WS_END = WS_CTL + 1 * MiB;
static_assert((size_t)MP * DFF * 2 <= WS_END - WS_PROJ, "act overlay");

constexpr int LDS_BYTES = 147456;

#define GAS __attribute__((address_space(1)))
#define LAS __attribute__((address_space(3)))
typedef unsigned short bf16;
typedef unsigned v4u __attribute__((ext_vector_type(4)));
typedef unsigned v2u __attribute__((ext_vector_type(2)));
typedef float f32x4 __attribute__((ext_vector_type(4)));
typedef short bf16x8 __attribute__((ext_vector_type(8)));
typedef short v4i16_t __attribute__((ext_vector_type(4)));
#define LDS_WAIT() asm volatile("s_waitcnt lgkmcnt(0)" ::: "memory")

__device__ __forceinline__ unsigned cvtpk(float lo, float hi) { return pg8::cvtpk_rne(lo, hi); }
__device__ __forceinline__ float bflo(unsigned u) { return __uint_as_float(u << 16); }
__device__ __forceinline__ float bfhi(unsigned u) { return __uint_as_float(u & 0xffff0000u); }
__device__ __forceinline__ float bf2f(bf16 v) { return __uint_as_float((unsigned)v << 16); }
__device__ __forceinline__ float wave_sum(float v) {
#pragma unroll
    for (int o = 1; o < 64; o <<= 1) v += __shfl_xor(v, o);
    return v;
}
__device__ __forceinline__ float sigmoidf_(float x) { return __builtin_amdgcn_rcpf(1.0f + __builtin_amdgcn_exp2f(-LOG2E * x)); }
template <class T> __device__ __forceinline__ T* gptr(T* p) { GAS T* g = (GAS T*)p; asm volatile("" : "+s"(g)); return (T*)g; }
__device__ __forceinline__ int rowidx(int b, int pos) { return pos < NMETA ? MR + pos : b * SEQ + pos - NMETA; }
__device__ __forceinline__ f32x4 mfma16(bf16x8 a, bf16x8 b, f32x4 c) { return __builtin_amdgcn_mfma_f32_16x16x32_bf16(a, b, c, 0, 0, 0); }

struct Args {
    const float *x, *meta, *pre_mix_g, *w_in, *w_pool, *pool_scale, *w_dw, *b_dw, *conv_ln_g, *conv_ln_b, *w_pw, *mix_out_g, *w_out, *post_mix_g, *pre_ffn_g, *w_gate, *w_up, *w_down, *post_ffn_g;
    float* out; unsigned char* ws; int ph_lo, ph_hi;
};

__device__ __forceinline__ void transpose_item(const float* __restrict__ W, int K, int N, bf16* WT, int mode, LAS float* scr, int item, int lane) {
    W = gptr(W); WT = gptr(WT);
    const int nblk = N >> 6, kb = item / nblk, nb = item - kb * nblk, k0 = kb << 6, n0 = nb << 6;
    const int r4 = lane >> 4, c4 = (lane & 15) * 4;
    f32x4 tv[16];
#pragma unroll
    for (int i = 0; i < 16; ++i) tv[i] = *(const f32x4*)(W + (size_t)(k0 + 4 * i + r4) * N + n0 + c4);
#pragma unroll
    for (int i = 0; i < 16; ++i) { LAS float* s = scr + (4 * i + r4) * 65 + c4; s[0] = tv[i].x; s[1] = tv[i].y; s[2] = tv[i].z; s[3] = tv[i].w; }
    LDS_WAIT();
    const int c = lane & 7;
#pragma unroll
    for (int j = 0; j < 8; ++j) { const int n = (lane >> 3) + 8 * j; const LAS float* s = scr + (8 * c) * 65 + n;
        v4u o; o.x = cvtpk(s[0 * 65], s[1 * 65]); o.y = cvtpk(s[2 * 65], s[3 * 65]); o.z = cvtpk(s[4 * 65], s[5 * 65]); o.w = cvtpk(s[6 * 65], s[7 * 65]);
        const int ng = n0 + n; const int R = mode == 0 ? ng : ((ng >> 2) * 8 + (ng & 3) + (mode == 2 ? 4 : 0));
        *(v4u*)(WT + (size_t)R * K + k0 + 8 * c) = o; }
    LDS_WAIT();
}
#define TJOB(Wp, Kk, Nn, WTp, mode) { const int ni_ = ((Kk) / 64) * ((Nn) / 64); if (r < ni_) { transpose_item((Wp), (Kk), (Nn), (WTp), (mode), scr, r, lane); continue; } r -= ni_; }

__device__ __forceinline__ void convert_ffn_weights(const Args& A, int l, LAS float* scr, int gw, int NGW, int lane) {
    bf16* wgu = (bf16*)(A.ws + WS_WGU); bf16* wd = (bf16*)(A.ws + WS_WD);
    constexpr int NI = 3 * (DM / 64) * (DFF / 64);
    for (int it = gw; it < NI; it += NGW) { int r = it;
        TJOB(A.w_gate + (size_t)l * DM * DFF, DM, DFF, wgu, 1)
        TJOB(A.w_up + (size_t)l * DM * DFF, DM, DFF, wgu, 2)
        TJOB(A.w_down + (size_t)l * DFF * DM, DFF, DM, wd, 0)
    }
}
__device__ __forceinline__ void convert_p0_weights(const Args& A, LAS float* scr, int gw, int NGW, int lane) {
    constexpr int I_IN = (DM / 64) * (DIN / 64), I_PW = 64, I_POOL = 16, NI = I_IN + DEPTH * (I_PW + I_POOL);
    for (int it = gw; it < NI; it += NGW) { int r = it;
        if (r < I_IN) { transpose_item(A.w_in, DM, DIN, (bf16*)(A.ws + WS_WIN), 0, scr, r, lane); continue; } r -= I_IN;
        const int l = r / (I_PW + I_POOL); r -= l * (I_PW + I_POOL);
        if (r < I_PW) { transpose_item(A.w_pw + (size_t)l * 512 * 512, 512, 512, (bf16*)(A.ws + WS_WSM + 256 * 1024) + (size_t)l * 512 * 512, 0, scr, r, lane); continue; } r -= I_PW;
        { const int g = r >> 2; transpose_item(A.w_pool + (size_t)(l * 4 + g) * 128 * 128, 128, 128, (bf16*)(A.ws + WS_WSM) + (size_t)(l * 4 + g) * 128 * 128, 0, scr, r & 3, lane); }
    }
}
__device__ __forceinline__ void convert_wout(const Args& A, int l, LAS float* scr, int gw, int NGW, int lane) {
    constexpr int NI = (DM / 64) * (DM / 64);
    for (int it = gw; it < NI; it += NGW) transpose_item(A.w_out + (size_t)l * DM * DM, DM, DM, (bf16*)(A.ws + WS_WOUT) + (size_t)l * DM * DM, 0, scr, it, lane);
}
__device__ __forceinline__ void convert_win(const Args& A, int l, LAS float* scr, int gw, int NGW, int lane) {
    constexpr int NI = (DM / 64) * (DIN / 64);
    for (int it = gw; it < NI; it += NGW) transpose_item(A.w_in + (size_t)l * DM * DIN, DM, DIN, (bf16*)(A.ws + WS_WIN) + (size_t)l * DIN * DM, 0, scr, it, lane);
}

__device__ __forceinline__ float dot4(f32x4 a) { return (a.x * a.x + a.y * a.y) + (a.z * a.z + a.w * a.w); }
__device__ __forceinline__ void store_u_row(bf16* urow, const f32x4 (&hv)[8], float r, const float* g, int lane) {
#pragma unroll
    for (int j = 0; j < 8; ++j) { const f32x4 gv = ((const f32x4*)g)[lane + 64 * j]; v2u w; w.x = cvtpk(hv[j].x * r * gv.x, hv[j].y * r * gv.y); w.y = cvtpk(hv[j].z * r * gv.z, hv[j].w * r * gv.w);
        ((v2u*)urow)[lane + 64 * j] = w; }
}
__device__ __forceinline__ void init_rows(const Args& A, int gw, int NGW, int lane) {
    unsigned char* wsb = gptr(A.ws); float* h = (float*)(wsb + WS_H); bf16* u = (bf16*)(wsb + WS_U); const float* pg = gptr(A.pre_mix_g);
    for (int m = gw; m < MV; m += NGW) {
        const float* src = m < MR ? gptr(A.x) + (size_t)m * DM : gptr(A.meta) + (size_t)(m - MR) * DM;
        f32x4 hv[8]; float ss = 0.f;
#pragma unroll
        for (int j = 0; j < 8; ++j) { hv[j] = ((const f32x4*)src)[lane + 64 * j]; ss += dot4(hv[j]); ((f32x4*)(h + (size_t)m * DM))[lane + 64 * j] = hv[j]; }
        const float r = rsqrtf(wave_sum(ss) * (1.0f / DM) + EPS);
        store_u_row(u + (size_t)m * DM, hv, r, pg, lane);
    }
}
__device__ __forceinline__ void row_phase(const Args& A, const float* g1, const float* g2, float* dout, int nrows, int gw, int NGW, int lane) {
    unsigned char* wsb = gptr(A.ws); float* h = (float*)(wsb + WS_H); bf16* u = (bf16*)(wsb + WS_U); const float* src = (const float*)(wsb + WS_OUT); g1 = gptr(g1); g2 = gptr(g2); dout = gptr(dout);
    for (int m0 = gw; m0 < nrows; m0 += 2 * NGW) {
        const int m1 = m0 + NGW; const bool two = m1 < nrows; const int mb = two ? m1 : m0;
        f32x4 oA[8], hA[8], oB[8], hB[8]; float ssA = 0.f, ssB = 0.f;
#pragma unroll
        for (int j = 0; j < 8; ++j) { oA[j] = ((const f32x4*)(src + (size_t)m0 * DM))[lane + 64 * j]; hA[j] = ((const f32x4*)(h + (size_t)m0 * DM))[lane + 64 * j]; }
#pragma unroll
        for (int j = 0; j < 8; ++j) { oB[j] = ((const f32x4*)(src + (size_t)mb * DM))[lane + 64 * j]; hB[j] = ((const f32x4*)(h + (size_t)mb * DM))[lane + 64 * j]; }
#pragma unroll
        for (int j = 0; j < 8; ++j) { ssA += dot4(oA[j]); ssB += dot4(oB[j]); }
        const float rA = rsqrtf(wave_sum(ssA) * (1.0f / DM) + EPS), rB = rsqrtf(wave_sum(ssB) * (1.0f / DM) + EPS);
        float s2A = 0.f, s2B = 0.f;
#pragma unroll
        for (int j = 0; j < 8; ++j) { const f32x4 gv = ((const f32x4*)g1)[lane + 64 * j]; hA[j] = hA[j] + oA[j] * rA * gv; hB[j] = hB[j] + oB[j] * rB * gv; s2A += dot4(hA[j]); s2B += dot4(hB[j]); }
        if (dout) {
            if (m0 < MR) {
#pragma unroll
                for (int j = 0; j < 8; ++j) ((f32x4*)(dout + (size_t)m0 * DM))[lane + 64 * j] = hA[j];
            }
            if (two && m1 < MR) {
#pragma unroll
                for (int j = 0; j < 8; ++j) ((f32x4*)(dout + (size_t)m1 * DM))[lane + 64 * j] = hB[j];
            }
        } else {
#pragma unroll
            for (int j = 0; j < 8; ++j) ((f32x4*)(h + (size_t)m0 * DM))[lane + 64 * j] = hA[j];
            if (two) {
#pragma unroll
                for (int j = 0; j < 8; ++j) ((f32x4*)(h + (size_t)m1 * DM))[lane + 64 * j] = hB[j];
            }
            const float r2A = rsqrtf(wave_sum(s2A) * (1.0f / DM) + EPS), r2B = rsqrtf(wave_sum(s2B) * (1.0f / DM) + EPS);
            store_u_row(u + (size_t)m0 * DM, hA, r2A, g2, lane);
            if (two) store_u_row(u + (size_t)m1 * DM, hB, r2B, g2, lane);
        }
    }
}

template <int MODE> __device__ __forceinline__ void skinny_gemm(const bf16* __restrict__ Arows, const bf16* __restrict__ Bt, int N, int K, void* O, int ldc, LAS unsigned char* lds, int lane, int wave) {
    const int li = lane & 15, fq = lane >> 4; const int nks = K >> 5;
    LAS f32x4* part = (LAS f32x4*)lds;
    for (int blk = blockIdx.x; blk < (N >> 4); blk += gridDim.x) {
        const bf16* bp = Bt + (size_t)(blk * 16 + li) * K + 8 * fq; const bf16* ap = Arows + (size_t)li * K + 8 * fq;
        f32x4 acc = (f32x4){0.f, 0.f, 0.f, 0.f};
#pragma unroll 8
        for (int ks = wave; ks < nks; ks += 8) { const bf16x8 wf = *(const bf16x8*)(bp + ks * 32); const bf16x8 af = *(const bf16x8*)(ap + ks * 32); acc = mfma16(wf, af, acc); }
        part[wave * 64 + lane] = acc;
        __syncthreads();
        if (wave == 0) {
            f32x4 v = part[lane];
#pragma unroll
            for (int w8 = 1; w8 < 8; ++w8) v = v + part[w8 * 64 + lane];
            const int n0 = blk * 16 + 4 * fq;
            if (MODE == 0) { const float sc = n0 < 1024 ? 0.125f : 1.0f; v2u w; w.x = cvtpk(v.x * sc, v.y * sc); w.y = cvtpk(v.z * sc, v.w * sc); *(v2u*)((bf16*)O + (size_t)(MR + li) * ldc + n0) = w; }
            else if (MODE == 1) { *(f32x4*)((float*)O + (size_t)(MR + li) * ldc + n0) = v; }
            else { f32x4 up; up.x = __shfl_xor(v.x, 16); up.y = __shfl_xor(v.y, 16); up.z = __shfl_xor(v.z, 16); up.w = __shfl_xor(v.w, 16);
                if ((fq & 1) == 0) { v2u w; w.x = cvtpk(v.x * sigmoidf_(v.x) * up.x, v.y * sigmoidf_(v.y) * up.y); w.y = cvtpk(v.z * sigmoidf_(v.z) * up.z, v.w * sigmoidf_(v.w) * up.w);
                    *(v2u*)((bf16*)O + (size_t)(MR + li) * ldc + blk * 8 + 4 * (fq >> 1)) = w; } }
        }
        __syncthreads();
    }
}

constexpr int VPITCH = 128;
constexpr int ML_V = 0, ML_ST = 8 * 64 * VPITCH  , ML_RED = ML_ST + 65536, ML_Y = 0  , ML_AB = ML_Y + 16 * 516 * 4;
static_assert(ML_RED + 3 * 512 <= LDS_BYTES && ML_AB + 16 * 1040 <= ML_ST, "mixer LDS");

__device__ __forceinline__ float softplus_(float z) { const float t = __builtin_amdgcn_exp2f(-LOG2E * __builtin_fabsf(z)); return __builtin_fmaxf(z, 0.f) + LN2 * __builtin_amdgcn_logf(1.0f + t); }
__device__ __forceinline__ void split_pack(const f32x4& a, const f32x4& b, bf16x8& hi, bf16x8& lo) {
    v4u h, l;
    h.x = cvtpk(a[0], a[1]); h.y = cvtpk(a[2], a[3]); h.z = cvtpk(b[0], b[1]); h.w = cvtpk(b[2], b[3]);
    l.x = cvtpk(a[0] - bflo(h.x), a[1] - bfhi(h.x)); l.y = cvtpk(a[2] - bflo(h.y), a[3] - bfhi(h.y));
    l.z = cvtpk(b[0] - bflo(h.z), b[1] - bfhi(h.z)); l.w = cvtpk(b[2] - bflo(h.w), b[3] - bfhi(h.w));
    hi = __builtin_bit_cast(bf16x8, h); lo = __builtin_bit_cast(bf16x8, l);
}
__device__ __forceinline__ void sb_attention(const bf16* __restrict__ proj, int b, int p0, int hd, LAS unsigned char* vl, int lane, f32x4 (&o)[4]) {
    const int li = lane & 15, fq = lane >> 4;
    const int qpos = p0 + li;
    const bf16* qp = proj + (size_t)rowidx(b, qpos) * DIN + hd * 64 + fq * 8;
    const bf16x8 qf0 = *(const bf16x8*)qp, qf1 = *(const bf16x8*)(qp + 32);
    unsigned d0 = 0u, d1 = 0u;
    { const unsigned one = 0x3F80u; d0 = ((4 * fq + 0 >= li) ? one : 0u) | ((4 * fq + 1 >= li) ? (one << 16) : 0u); d1 = ((4 * fq + 2 >= li) ? one : 0u) | ((4 * fq + 3 >= li) ? (one << 16) : 0u); }
    const unsigned ONE2 = 0x3F803F80u;
    const bf16x8 F_D1 = __builtin_bit_cast(bf16x8, (v4u){d0, d1, ONE2, ONE2});
    const bf16x8 F_11 = __builtin_bit_cast(bf16x8, (v4u){ONE2, ONE2, ONE2, ONE2});
    const bf16x8 F_0D = __builtin_bit_cast(bf16x8, (v4u){0u, 0u, d0, d1});
#pragma unroll
    for (int i = 0; i < 4; ++i) o[i] = (f32x4){0.f, 0.f, 0.f, 0.f};
    float carry = 0.f;
    const int ktd = p0 >> 6, kbmax = (p0 & 63) >> 4;
    const unsigned trbase = (unsigned)((4 * fq + (li >> 2)) * VPITCH + (lane & 3) * 8);
    bf16x8 kf[4][2];
#define SB_LOADK(KT) do { _Pragma("unroll") for (int kb = 0; kb < 4; ++kb) { int kp = 64 * (KT) + 16 * kb + li; kp = kp < LSEQ ? kp : LSEQ - 1; const bf16* kr = proj + (size_t)rowidx(b, kp) * DIN + C_K + hd * 64 + fq * 8; \
        kf[kb][0] = *(const bf16x8*)kr; kf[kb][1] = *(const bf16x8*)(kr + 32); } } while (0)
    SB_LOADK(ktd);
    for (int kt = ktd; kt >= 0; --kt) {
        const bool diag = (kt == ktd);
#pragma unroll
        for (int it = 0; it < 8; ++it) { const int key = it * 8 + (lane >> 3); int kp = 64 * kt + key; kp = kp < LSEQ ? kp : LSEQ - 1;
            __builtin_amdgcn_global_load_lds((const unsigned*)(proj + (size_t)rowidx(b, kp) * DIN + C_V + hd * 64 + (lane & 7) * 8), (LAS unsigned*)(vl + it * 1024), 16, 0, 0); }
        f32x4 s[4], lnb[4];
#pragma unroll
        for (int kb = 0; kb < 4; ++kb) { s[kb] = mfma16(kf[kb][0], qf0, (f32x4){0.f, 0.f, 0.f, 0.f}); s[kb] = mfma16(kf[kb][1], qf1, s[kb]); }
        { const int ktn = kt > 0 ? kt - 1 : 0; SB_LOADK(ktn); }
#pragma unroll
        for (int kb = 0; kb < 4; ++kb)
#pragma unroll
            for (int e = 0; e < 4; ++e) { const bool m = !diag || (64 * kt + 16 * kb + 4 * fq + e < qpos); lnb[kb][e] = (diag && kb > kbmax) ? 0.f : (m ? -softplus_(s[kb][e]) : 0.f); }
        bf16x8 bh[2], bl[2];
        split_pack(lnb[0], lnb[1], bh[0], bl[0]); split_pack(lnb[2], lnb[3], bh[1], bl[1]);
        f32x4 c[4];
#pragma unroll
        for (int i = 0; i < 4; ++i) c[i] = (f32x4){carry, carry, carry, carry};
        c[0] = mfma16(F_D1, bh[0], c[0]); c[0] = mfma16(F_D1, bl[0], c[0]); c[0] = mfma16(F_11, bh[1], c[0]); c[0] = mfma16(F_11, bl[1], c[0]);
        c[1] = mfma16(F_0D, bh[0], c[1]); c[1] = mfma16(F_0D, bl[0], c[1]); c[1] = mfma16(F_11, bh[1], c[1]); c[1] = mfma16(F_11, bl[1], c[1]);
        c[2] = mfma16(F_D1, bh[1], c[2]); c[2] = mfma16(F_D1, bl[1], c[2]);
        c[3] = mfma16(F_0D, bh[1], c[3]); c[3] = mfma16(F_0D, bl[1], c[3]);
        f32x4 w[4];
#pragma unroll
        for (int kb = 0; kb < 4; ++kb)
#pragma unroll
            for (int e = 0; e < 4; ++e) { const bool m = !diag || (64 * kt + 16 * kb + 4 * fq + e < qpos); w[kb][e] = (diag && kb > kbmax) ? 0.f : (m ? __builtin_amdgcn_exp2f(LOG2E * (s[kb][e] + c[kb][e])) : 0.f); }
        carry = __shfl(c[0][0], li);
        v4u p0v, p1v;
        p0v.x = cvtpk(w[0][0], w[0][1]); p0v.y = cvtpk(w[0][2], w[0][3]); p0v.z = cvtpk(w[1][0], w[1][1]); p0v.w = cvtpk(w[1][2], w[1][3]);
        p1v.x = cvtpk(w[2][0], w[2][1]); p1v.y = cvtpk(w[2][2], w[2][3]); p1v.z = cvtpk(w[3][0], w[3][1]); p1v.w = cvtpk(w[3][2], w[3][3]);
        const bf16x8 pf0 = __builtin_bit_cast(bf16x8, p0v), pf1 = __builtin_bit_cast(bf16x8, p1v);
        asm volatile("s_waitcnt vmcnt(0)" ::: "memory");
#pragma unroll
        for (int db = 0; db < 4; ++db) {
#pragma unroll
            for (int s2 = 0; s2 < 2; ++s2) {
                const v4i16_t lo = __builtin_amdgcn_ds_read_tr16_b64_v4i16((LAS v4i16_t*)(vl + trbase + (32 * s2) * VPITCH + db * 32));
                const v4i16_t hi = __builtin_amdgcn_ds_read_tr16_b64_v4i16((LAS v4i16_t*)(vl + trbase + (32 * s2 + 16) * VPITCH + db * 32));
                const bf16x8 vf = (bf16x8){lo[0], lo[1], lo[2], lo[3], hi[0], hi[1], hi[2], hi[3]};
                o[db] = mfma16(vf, s2 == 0 ? pf0 : pf1, o[db]);
            }
        }
        if (__all(carry < SB_EXIT)) break;
    }
#undef SB_LOADK
}

template <int W> __device__ __forceinline__ void pool_group(const bf16* __restrict__ psrc, const bf16* __restrict__ wpt, int b, int pos, f32x4 (&pacc)[4]) {
    const int cnt = (pos + 1 < W) ? pos + 1 : W; const float inv = 1.0f / (float)cnt;
    constexpr int BW = W < 8 ? W : 8;
#pragma unroll 1
    for (int ks = 0; ks < 4; ++ks) {
        bf16x8 wf[4];
#pragma unroll
        for (int nb = 0; nb < 4; ++nb) wf[nb] = *(const bf16x8*)(wpt + (size_t)nb * 16 * 128 + 32 * ks);
        float sum[8], self[8];
#pragma unroll
        for (int e = 0; e < 8; ++e) { sum[e] = 0.f; self[e] = 0.f; }
#pragma unroll
        for (int j0 = 0; j0 < W; j0 += BW) {
            v4u v[BW];
#pragma unroll
            for (int j = 0; j < BW; ++j) { const int pp = pos - j0 - j; v[j] = *(const v4u*)(psrc + (size_t)rowidx(b, pp >= 0 ? pp : 0) * DIN + 32 * ks); }
#pragma unroll
            for (int j = 0; j < BW; ++j) { const float f = (pos - j0 - j) >= 0 ? 1.0f : 0.0f;
                sum[0] += f * bflo(v[j].x); sum[1] += f * bfhi(v[j].x); sum[2] += f * bflo(v[j].y); sum[3] += f * bfhi(v[j].y);
                sum[4] += f * bflo(v[j].z); sum[5] += f * bfhi(v[j].z); sum[6] += f * bflo(v[j].w); sum[7] += f * bfhi(v[j].w); }
            if (j0 == 0) { self[0] = bflo(v[0].x); self[1] = bfhi(v[0].x); self[2] = bflo(v[0].y); self[3] = bfhi(v[0].y); self[4] = bflo(v[0].z); self[5] = bfhi(v[0].z); self[6] = bflo(v[0].w); self[7] = bfhi(v[0].w); }
            if (j0 + BW < W) __builtin_amdgcn_sched_barrier(0);
        }
        v4u pk; pk.x = cvtpk(sum[0] * inv - self[0], sum[1] * inv - self[1]); pk.y = cvtpk(sum[2] * inv - self[2], sum[3] * inv - self[3]);
        pk.z = cvtpk(sum[4] * inv - self[4], sum[5] * inv - self[5]); pk.w = cvtpk(sum[6] * inv - self[6], sum[7] * inv - self[7]);
        const bf16x8 pf = __builtin_bit_cast(bf16x8, pk);
#pragma unroll
        for (int nb = 0; nb < 4; ++nb) pacc[nb] = mfma16(wf[nb], pf, pacc[nb]);
    }
}

__device__ __forceinline__ void mixer_phase(const Args& A, int l, LAS unsigned char* lds, int tid0, int wave) {
    unsigned char* wsb = gptr(A.ws);
    const bf16* proj = (const bf16*)(wsb + WS_PROJ); bf16* merged = (bf16*)(wsb + WS_MERGED);
    const bf16* wpool_t = (const bf16*)(wsb + WS_WSM) + (size_t)l * 4 * 128 * 128;
    const bf16* wpw_t = (const bf16*)(wsb + WS_WSM + 256 * 1024) + (size_t)l * 512 * 512;
    const float* wdw = gptr(A.w_dw) + (size_t)l * 31 * 512; const float* bdw = gptr(A.b_dw) + l * 512; const float* lng = gptr(A.conv_ln_g) + l * 512; const float* lnb_ = gptr(A.conv_ln_b) + l * 512;
    const float* psc = gptr(A.pool_scale) + l * 512; const float* mg = gptr(A.mix_out_g) + (size_t)l * DM;
    LAS float* Y = (LAS float*)(lds + ML_Y); LAS unsigned short* Ab = (LAS unsigned short*)(lds + ML_AB); LAS float* red = (LAS float*)(lds + ML_RED);
    LAS unsigned char* vl = lds + ML_V + wave * (64 * VPITCH); LAS unsigned char* st = lds + ML_ST + wave * 8192;
    const int nunits = (l + 1 < DEPTH) ? 513 : 512;
    for (int ui = blockIdx.x; ui < nunits; ui += gridDim.x) {
        int ti = ui;
        if (gridDim.x == 256 && ui < 512) { const int w = ui & 255, rnd = ui >> 8; ti = 256 * (w >> 7) + (rnd == 0 ? 128 : 0) + (w & 127); }
        int b, p0; if (ti < 512) { b = ti >> 8; p0 = 16 + 16 * (ti & 255); } else { b = 0; p0 = 0; }
        int tid_l = tid0; asm volatile("" : "+v"(tid_l));
        const int tid = tid_l, lane = tid & 63, li = lane & 15, fq = lane >> 4;
#pragma unroll 1
        for (int hh = 0; hh < ((PROBE_DUP & 64) ? 4 : 2); ++hh) { f32x4 o0[4];
            sb_attention(proj, b, p0, 2 * wave + (hh & 1), vl, lane, o0);
#pragma unroll
            for (int db = 0; db < 4; ++db) *(LAS f32x4*)(st + (((hh & 1) * 4 + db) * 64 + lane) * 16) = o0[db]; }
        __syncthreads();
        {
            const int c = tid; const bf16* pa = proj + C_CA + c;
            float glu[46];
#pragma unroll
            for (int r = 0; r < 46; ++r) { const int pos = p0 - 30 + r; float gv = 0.f;
                if (pos >= 0) { const size_t row = (size_t)rowidx(b, pos); const float a = bf2f(pa[row * DIN]); const float gt = bf2f(pa[row * DIN + 512]); gv = a * sigmoidf_(gt); }
                glu[r] = gv;
                if ((r & 15) == 15) __builtin_amdgcn_sched_barrier(0); }
            const float* wdc = wdw + c; asm volatile("" : "+v"(wdc));
            float y[16]; const float bias = bdw[c];
#pragma unroll
            for (int t = 0; t < 16; ++t) y[t] = bias;
#pragma unroll
            for (int j = 0; j < 31; ++j) { const float w = wdc[j * 512];
#pragma unroll
                for (int t = 0; t < 16; ++t) y[t] += w * glu[t + j]; }
#pragma unroll
            for (int t = 0; t < 16; ++t) Y[t * 516 + c] = y[t];
        }
        __syncthreads();
#pragma unroll
        for (int tt = 0; tt < 2; ++tt) { const int t = 2 * wave + tt; float v[8]; float sm = 0.f;
#pragma unroll
            for (int i = 0; i < 8; ++i) { v[i] = Y[t * 516 + lane + 64 * i]; sm += v[i]; }
            const float mean = wave_sum(sm) * (1.0f / 512.0f); float q = 0.f;
#pragma unroll
            for (int i = 0; i < 8; ++i) { v[i] -= mean; q += v[i] * v[i]; }
            const float rstd = rsqrtf(wave_sum(q) * (1.0f / 512.0f) + EPS);
#pragma unroll
            for (int i = 0; i < 8; ++i) { const int c = lane + 64 * i; const float yn = v[i] * rstd * lng[c] + lnb_[c]; const float a = yn * sigmoidf_(yn); Ab[t * 520 + c] = (unsigned short)(cvtpk(a, 0.f) & 0xffffu); }
        }
        __syncthreads();
        f32x4 cacc[4];
#pragma unroll
        for (int i = 0; i < 4; ++i) cacc[i] = (f32x4){0.f, 0.f, 0.f, 0.f};
        { const bf16* wp = wpw_t + (size_t)(64 * wave + li) * 512 + 8 * fq; const LAS unsigned char* ab = (const LAS unsigned char*)Ab + li * 1040 + fq * 16;
#pragma unroll 4
            for (int ks = 0; ks < 16; ++ks) { const bf16x8 bfr = *(const LAS bf16x8*)(ab + ks * 64);
#pragma unroll
                for (int nb = 0; nb < 4; ++nb) { const bf16x8 wf = *(const bf16x8*)(wp + (size_t)nb * 16 * 512 + ks * 32); cacc[nb] = mfma16(wf, bfr, cacc[nb]); } } }
        f32x4 pacc[4];
#pragma unroll
        for (int i = 0; i < 4; ++i) pacc[i] = (f32x4){0.f, 0.f, 0.f, 0.f};
        { const int g = wave >> 1, nh = wave & 1;
            const bf16* wpt = wpool_t + (size_t)(g * 128 + 64 * nh + li) * 128 + 8 * fq; const bf16* psrc = proj + C_POOL + 128 * g + 8 * fq;
            if (g == 0) pool_group<2>(psrc, wpt, b, p0 + li, pacc); else if (g == 1) pool_group<4>(psrc, wpt, b, p0 + li, pacc); else if (g == 2) pool_group<8>(psrc, wpt, b, p0 + li, pacc); else pool_group<16>(psrc, wpt, b, p0 + li, pacc); }
        f32x4 oa[2][4];
#pragma unroll
        for (int hh = 0; hh < 2; ++hh)
#pragma unroll
            for (int db = 0; db < 4; ++db) oa[hh][db] = *(const LAS f32x4*)(st + ((hh * 4 + db) * 64 + lane) * 16);
        float ssa = 0.f, ssp = 0.f, ssc = 0.f;
        { const int g = wave >> 1, nh = wave & 1;
#pragma unroll
            for (int nb = 0; nb < 4; ++nb) { const f32x4 sc = *(const f32x4*)(psc + 128 * g + 64 * nh + 16 * nb + 4 * fq); pacc[nb] = pacc[nb] * sc; ssp += dot4(pacc[nb]); ssc += dot4(cacc[nb]); ssa += dot4(oa[0][nb]) + dot4(oa[1][nb]); } }
        ssa += __shfl_xor(ssa, 16); ssa += __shfl_xor(ssa, 32); ssp += __shfl_xor(ssp, 16); ssp += __shfl_xor(ssp, 32); ssc += __shfl_xor(ssc, 16); ssc += __shfl_xor(ssc, 32);
        if (lane < 16) { red[wave * 16 + lane] = ssa; red[128 + wave * 16 + lane] = ssp; red[256 + wave * 16 + lane] = ssc; }
        __syncthreads();
        float ta = 0.f, tp = 0.f, tc = 0.f;
#pragma unroll
        for (int w8 = 0; w8 < 8; ++w8) { ta += red[w8 * 16 + li]; tp += red[128 + w8 * 16 + li]; tc += red[256 + w8 * 16 + li]; }
        const float ra = rsqrtf(ta * (1.0f / DATT) + EPS), rp = rsqrtf(tp * (1.0f / DPOOL) + EPS), rc = rsqrtf(tc * (1.0f / DCONV) + EPS);
        bf16* orow = merged + (size_t)rowidx(b, p0 + li) * DM;
#pragma unroll
        for (int hh = 0; hh < 2; ++hh)
#pragma unroll
            for (int db = 0; db < 4; ++db) { const int col = (2 * wave + hh) * 64 + 16 * db + 4 * fq; const f32x4 gv = *(const f32x4*)(mg + col); const f32x4 v = oa[hh][db] * ra * gv;
                v2u w2; w2.x = cvtpk(v.x, v.y); w2.y = cvtpk(v.z, v.w); *(v2u*)(orow + col) = w2; }
        { const int g = wave >> 1, nh = wave & 1;
#pragma unroll
            for (int nb = 0; nb < 4; ++nb) { const int col = DATT + 128 * g + 64 * nh + 16 * nb + 4 * fq; const f32x4 gv = *(const f32x4*)(mg + col); const f32x4 v = pacc[nb] * rp * gv;
                v2u w2; w2.x = cvtpk(v.x, v.y); w2.y = cvtpk(v.z, v.w); *(v2u*)(orow + col) = w2; } }
#pragma unroll
        for (int nb = 0; nb < 4; ++nb) { const int col = DATT + DPOOL + 64 * wave + 16 * nb + 4 * fq; const f32x4 gv = *(const f32x4*)(mg + col); const f32x4 v = cacc[nb] * rc * gv;
            v2u w2; w2.x = cvtpk(v.x, v.y); w2.y = cvtpk(v.z, v.w); *(v2u*)(orow + col) = w2; }
        __syncthreads();
    }
}

#define XB_TMO      128
#define XB_XCNT(j)  (256  + 64 * (j))
#define XB_XSUB(j)  (1280 + 64 * (j))
#define XB_XGEN(j)  (2304 + 64 * (j))
#define XB_TOP      3328
#define XB_TOPGEN   3392
#define XCD_BAR_WORDS 3456
#define XB_SPIN_CAP (1u << 18)

__device__ __forceinline__ unsigned xb_ld(unsigned* p)              { return __hip_atomic_load(p, __ATOMIC_RELAXED, __HIP_MEMORY_SCOPE_AGENT); }
__device__ __forceinline__ unsigned xb_add(unsigned* p, unsigned v) { return __hip_atomic_fetch_add(p, v, __ATOMIC_RELAXED, __HIP_MEMORY_SCOPE_AGENT); }
__device__ __forceinline__ unsigned xb_xcc_id() { return (unsigned)__builtin_amdgcn_s_getreg((3 << 11) | 20) & 0xFu; }
#define XB_SPIN(cond, bar) do { unsigned _sp = 0; while (cond) { __builtin_amdgcn_s_sleep(1); \
    if ((++_sp & 255u) == 0u) { if (xb_ld(&(bar)[XB_TMO])) break; if (_sp > XB_SPIN_CAP) { atomicAdd(&(bar)[XB_TMO], 1u); break; } } } } while (0)

struct XcdBarrier {
    unsigned* bar; unsigned x;
    volatile LAS unsigned* st;
};

__device__ __forceinline__ XcdBarrier xcd_barrier_post(unsigned* bar, volatile LAS unsigned* st) {
    XcdBarrier b; b.bar = bar; b.x = xb_xcc_id(); b.st = st;
    if (threadIdx.x == 0) (void)xb_add(&bar[XB_XCNT(b.x)], 1u);
    return b;
}
__device__ __forceinline__ void xcd_barrier_complete(unsigned* bar, unsigned x, unsigned& nloc, unsigned& nx) {
    const unsigned G = gridDim.x * gridDim.y * gridDim.z;
    unsigned sum, cnt, mine, sp = 0u;
    for (;;) {
        sum = 0u; cnt = 0u; mine = 0u;
#pragma unroll
        for (unsigned j = 0; j < 16; ++j) { const unsigned c = xb_ld(&bar[XB_XCNT(j)]); sum += c; cnt += (c > 0u) ? 1u : 0u; mine = (j == x) ? c : mine; }
        if (sum == G) break;
        __builtin_amdgcn_s_sleep(1);
        if ((++sp & 255u) == 0u) { if (xb_ld(&bar[XB_TMO])) break; if (sp > XB_SPIN_CAP) { atomicAdd(&bar[XB_TMO], 1u); break; } }
    }
    nloc = mine > 0u ? mine : 1u; nx = cnt > 0u ? cnt : 1u;
}

__device__ __forceinline__ void xcd_barrier(const XcdBarrier& b) {
    asm volatile("s_waitcnt vmcnt(0)" ::: "memory");
    __syncthreads();
    if (threadIdx.x == 0) {
        unsigned* bar = b.bar;
        __builtin_amdgcn_s_waitcnt(0);
        unsigned nloc = b.st[0], nx = b.st[1];
        if (nloc == 0u) { xcd_barrier_complete(bar, b.x, nloc, nx); b.st[0] = nloc; b.st[1] = nx; }
        const unsigned old = xb_add(&bar[XB_XSUB(b.x)], 1u);
        const unsigned gen = old / nloc;
        if (old + 1u == (gen + 1u) * nloc) {
            __builtin_amdgcn_fence(__ATOMIC_RELEASE, "agent");
            asm volatile("s_waitcnt vmcnt(0)" ::: "memory");
            const unsigned og = xb_add(&bar[XB_TOP], 1u);
            const unsigned tg = og / nx;
            if (og + 1u == (tg + 1u) * nx) xb_add(&bar[XB_TOPGEN], 1u);
            else XB_SPIN(xb_ld(&bar[XB_TOPGEN]) == tg, bar);
            __builtin_amdgcn_fence(__ATOMIC_ACQUIRE, "agent");
            xb_add(&bar[XB_XGEN(b.x)], 1u);
            asm volatile("s_waitcnt vmcnt(0)" ::: "memory");
        } else {
            XB_SPIN(xb_ld(&bar[XB_XGEN(b.x)]) == gen, bar);
            __builtin_amdgcn_fence(__ATOMIC_ACQUIRE, "agent");
            asm volatile("s_waitcnt vmcnt(0)" ::: "memory");
        }
    }
    __syncthreads();
}

constexpr int NPHASE = 1 + 7 * DEPTH;
#define PHASE_ENTER() int tid_ = threadIdx.x; asm volatile("" : "+v"(tid_)); const int tid = tid_, lane = tid & 63, wave = __builtin_amdgcn_readfirstlane(tid >> 6); \
    const __attribute__((address_space(4))) Args* ka_ = (const __attribute__((address_space(4))) Args*)__builtin_amdgcn_kernarg_segment_ptr(); asm volatile("" : "+s"(ka_)); Args A; __builtin_memcpy(&A, ka_, sizeof(Args)); \
    const int G = gridDim.x, gw = blockIdx.x * 8 + wave, NGW = G * 8; LAS float* scr = (LAS float*)(lds + wave * 16640); (void)tid; (void)lane; (void)gw; (void)NGW; (void)scr; (void)G;
__global__ void __launch_bounds__(512, 2) fwd_megakernel(Args args) {
    extern __shared__ __attribute__((aligned(16))) unsigned char lds_raw[];
    LAS unsigned char* lds = (LAS unsigned char*)lds_raw;
    cg::grid_group grid = cg::this_grid();
    const int lo = args.ph_lo, hi = args.ph_hi;
    volatile LAS unsigned* bst = (volatile LAS unsigned*)(lds + LDS_BYTES - 64);
    if (threadIdx.x < 16) bst[threadIdx.x] = 0u;
    __syncthreads();
    XcdBarrier bar = xcd_barrier_post((unsigned*)(args.ws + WS_CTL), bst);
#if !MK_SPLIT
    grid.sync();
#endif
#define IN(k) (lo <= (k) && (k) < hi)
#define SEAM(k) do { if (IN(k) && IN((k) + 1)) xcd_barrier(bar); } while (0)
    int k = 0;
    for (int rep = 0; rep < ((PROBE_DUP & 1) ? 2 : 1); ++rep) if (IN(k)) { if (rep) xcd_barrier(bar); PHASE_ENTER(); convert_p0_weights(A, scr, gw, NGW, lane); init_rows(A, gw, NGW, lane); }
    SEAM(k); ++k;
    for (int l = 0; l < DEPTH; ++l) {
        for (int rep = 0; rep < ((PROBE_DUP & 4) ? 2 : 1); ++rep) if (IN(k)) { if (rep) xcd_barrier(bar); PHASE_ENTER(); unsigned char* wsb = gptr(A.ws);
            pg8::Gemm g{(const bf16*)(wsb + WS_U), (const bf16*)(wsb + WS_WIN) + (size_t)l * DIN * DM, MR, DIN, DM}; pg8::StaticOrder S; S.init(MR, DIN, G, (int)blockIdx.x);
            pg8::EpiBf16<0> E{(bf16*)(wsb + WS_PROJ), DIN, nullptr, 1024, 1024, 0.125f};
            pg8::gemm_phase<pg8::EpiBf16<0>, pg8::StaticOrder, PG8_ALIGN, PG8_SP2>(lds, g, S, E);
            __syncthreads();
            { const int ex = ((MR / 256) * (DIN / 256)) % G, c = (int)blockIdx.x;
                if (ex == 0 || c >= ex) { const int c0 = ex == 0 ? 0 : ex, gw2 = (c - c0) * 8 + wave, n2 = (G - c0) * 8; convert_ffn_weights(A, l, scr, gw2, n2, lane); if (l == 0) convert_wout(A, 0, scr, gw2, n2, lane); } }
            __syncthreads(); skinny_gemm<0>((const bf16*)(wsb + WS_U) + (size_t)MR * DM, (const bf16*)(wsb + WS_WIN) + (size_t)l * DIN * DM, DIN, DM, (void*)(wsb + WS_PROJ), DIN, lds, lane, wave);
        }
        SEAM(k); ++k;
        for (int rep = 0; rep < ((PROBE_DUP & 2) ? 2 : 1); ++rep) if (IN(k)) { if (rep) xcd_barrier(bar); PHASE_ENTER(); mixer_phase(A, l, lds, tid, wave); }
        SEAM(k); ++k;
        for (int rep = 0; rep < ((PROBE_DUP & 16) ? 2 : 1); ++rep) if (IN(k)) { if (rep) xcd_barrier(bar); PHASE_ENTER(); unsigned char* wsb = gptr(A.ws);
            pg8::Gemm g{(const bf16*)(wsb + WS_MERGED), (const bf16*)(wsb + WS_WOUT) + (size_t)l * DM * DM, MR, DM, DM}; pg8::StaticOrder S; S.init(MR, DM, G, (int)blockIdx.x);
            pg8::EpiF32 E{(float*)(wsb + WS_OUT), DM};
            pg8::gemm_phase<pg8::EpiF32, pg8::StaticOrder, PG8_ALIGN, PG8_SP2>(lds, g, S, E);
            __syncthreads(); if (l + 1 < DEPTH) skinny_gemm<1>((const bf16*)(wsb + WS_MERGED) + (size_t)MR * DM, (const bf16*)(wsb + WS_WOUT) + (size_t)l * DM * DM, DM, DM, (void*)(wsb + WS_OUT), DM, lds, lane, wave);
        }
        SEAM(k); ++k;
        if (IN(k)) { PHASE_ENTER(); row_phase(A, A.post_mix_g + (size_t)l * DM, A.pre_ffn_g + (size_t)l * DM, nullptr, (l + 1 < DEPTH) ? MV : MR, gw, NGW, lane); }
        SEAM(k); ++k;
        for (int rep = 0; rep < ((PROBE_DUP & 32) ? 2 : 1); ++rep) if (IN(k)) { if (rep) xcd_barrier(bar); PHASE_ENTER(); unsigned char* wsb = gptr(A.ws);
            pg8::Gemm g{(const bf16*)(wsb + WS_U), (const bf16*)(wsb + WS_WGU), MR, 2 * DFF, DM}; pg8::StaticOrder S; S.init(MR, 2 * DFF, G, (int)blockIdx.x);
            pg8::EpiSwiGLU E{(bf16*)(wsb + WS_ACT), DFF};
            pg8::gemm_phase<pg8::EpiSwiGLU, pg8::StaticOrder, PG8_ALIGN, PG8_SP2>(lds, g, S, E);
            __syncthreads();
            if (l + 1 < DEPTH) { const int ex = ((MR / 256) * (2 * DFF / 256)) % G, c = (int)blockIdx.x;
                if (ex == 0 || c >= ex) { const int c0 = ex == 0 ? 0 : ex, gw2 = (c - c0) * 8 + wave, n2 = (G - c0) * 8; convert_win(A, l + 1, scr, gw2, n2, lane); convert_wout(A, l + 1, scr, gw2, n2, lane); } }
            __syncthreads(); if (l + 1 < DEPTH) skinny_gemm<2>((const bf16*)(wsb + WS_U) + (size_t)MR * DM, (const bf16*)(wsb + WS_WGU), 2 * DFF, DM, (void*)(wsb + WS_ACT), DFF, lds, lane, wave);
        }
        SEAM(k); ++k;
        for (int rep = 0; rep < ((PROBE_DUP & 8) ? 2 : 1); ++rep) if (IN(k)) { if (rep) xcd_barrier(bar); PHASE_ENTER(); unsigned char* wsb = gptr(A.ws);
            pg8::Gemm g{(const bf16*)(wsb + WS_ACT), (const bf16*)(wsb + WS_WD), MR, DM, DFF}; pg8::StaticOrder S; S.init(MR, DM, G, (int)blockIdx.x);
            pg8::EpiF32 E{(float*)(wsb + WS_OUT), DM};
            pg8::gemm_phase<pg8::EpiF32, pg8::StaticOrder, PG8_ALIGN, PG8_SP2>(lds, g, S, E);
            __syncthreads(); if (l + 1 < DEPTH) skinny_gemm<1>((const bf16*)(wsb + WS_ACT) + (size_t)MR * DFF, (const bf16*)(wsb + WS_WD), DM, DFF, (void*)(wsb + WS_OUT), DM, lds, lane, wave);
        }
        SEAM(k); ++k;
        if (IN(k)) { PHASE_ENTER();
            if (l + 1 < DEPTH) { row_phase(A, A.post_ffn_g + (size_t)l * DM, A.pre_mix_g + (size_t)(l + 1) * DM, nullptr, MV, gw, NGW, lane); }
            else row_phase(A, A.post_ffn_g + (size_t)l * DM, nullptr, A.out, MR, gw, NGW, lane);
        }
        if (l + 1 < DEPTH) { SEAM(k); } ++k;
    }
#undef IN
#undef SEAM
}

extern "C" void kernel_launch(void* const* d_in, const int* in_sizes, int n_in, void* d_out, int out_size, void* d_ws, size_t ws_size, hipStream_t stream) {
    static int grid = 0;
    if (grid == 0) {
        if (n_in != 19 || in_sizes[0] != MR * DM || out_size != MR * DM || ws_size < WS_END) { fprintf(stderr, "kernel_launch: unexpected problem (n_in %d, in0 %d, out %d, ws %zu, need %zu)\n", n_in, n_in > 0 ? in_sizes[0] : -1, out_size, ws_size, (size_t)WS_END); grid = -1; return; }
        int dev = 0, cus = 0, per_cu = 0;
        if (hipGetDevice(&dev) != hipSuccess || hipDeviceGetAttribute(&cus, hipDeviceAttributeMultiprocessorCount, dev) != hipSuccess) { grid = -1; return; }
        if (hipFuncSetAttribute((const void*)fwd_megakernel, hipFuncAttributeMaxDynamicSharedMemorySize, LDS_BYTES) != hipSuccess) { fprintf(stderr, "kernel_launch: hipFuncSetAttribute failed\n"); grid = -1; return; }
        if (hipOccupancyMaxActiveBlocksPerMultiprocessor(&per_cu, (const void*)fwd_megakernel, 512, LDS_BYTES) != hipSuccess || per_cu < 1) { fprintf(stderr, "kernel_launch: occupancy query says %d blocks per CU\n", per_cu); per_cu = 1; }
        (void)hipGetLastError();
        grid = cus;
    }
    if (grid < 0) return;
    if (hipMemsetAsync((unsigned char*)d_ws + WS_CTL, 0, CTL_BYTES, stream) != hipSuccess) { fprintf(stderr, "kernel_launch: hipMemsetAsync failed\n"); return; }
    Args a{};
    const float** ap = (const float**)&a;
    for (int i = 0; i < 19; ++i) ap[i] = (const float*)d_in[i];
    a.out = (float*)d_out; a.ws = (unsigned char*)d_ws;
#if MK_SPLIT
    for (int ph = 0; ph < NPHASE; ++ph) { a.ph_lo = ph; a.ph_hi = ph + 1; hipLaunchKernelGGL(fwd_megakernel, dim3(grid), dim3(512), LDS_BYTES, stream, a); }
#else
    a.ph_lo = 0; a.ph_hi = NPHASE;
    void* kargs[] = {(void*)&a};
    const hipError_t e = hipLaunchCooperativeKernel((const void*)fwd_megakernel, dim3(grid), dim3(512), kargs, LDS_BYTES, stream);
    if (e != hipSuccess) fprintf(stderr, "kernel_launch: cooperative launch failed: %s (grid %d)\n", hipGetErrorString(e), grid);
#endif
}
```

```cpp
#include <hip/hip_runtime.h>
#include <hip/hip_cooperative_groups.h>
#include <cstdio>
#include <cstdint>
namespace cg = cooperative_groups;
namespace pg8 {
#define PG8_LAS __attribute__((address_space(3)))
typedef unsigned short bf16_t;
typedef short bf16x8 __attribute__((ext_vector_type(8)));
typedef float f32x4 __attribute__((ext_vector_type(4)));
typedef unsigned u32x4 __attribute__((ext_vector_type(4)));
constexpr int BM = 256, BK = 64, HALF = 128, HTB = HALF * BK * 2  , STAGE_BYTES = 8 * HTB, NXCD = 8, WGM = 8;

__host__ __device__ __forceinline__ int lds_byte(int r, int c) { const int st = (r >> 4) * 2 + (c >> 5), rr = r & 15, cc = c & 31, ob = rr * 64 + cc * 2; return st * 1024 + (ob ^ (((ob >> 9) & 1) << 5)); }
__host__ __device__ __forceinline__ void stage_rc(int b, int& R, int& C) { const int st = b / 1024, sb = b % 1024, swz = sb ^ (((sb >> 9) & 1) << 5); R = (st >> 1) * 16 + swz / 64; C = (st & 1) * 32 + (swz % 64) / 2; }
__host__ __device__ __forceinline__ int perm32(int rho) { const int n = rho >> 4, i = rho & 15; return 8 * (i >> 2) + 4 * n + (i & 3); }

struct Unit { int pm, pn; };
struct Gemm { const bf16_t* A; const bf16_t* Bt; int M, N, K; };

struct StaticOrder {
    int nM, nN, nwg, G, c;
    __host__ __device__ void init(int M, int N, int G_, int c_) { nM = M / BM; nN = N / BM; nwg = nM * nN; G = G_; c = c_; }
    __host__ __device__ bool next(int i, Unit& u) const {
        const long L = (long)i * G + c; if (L >= nwg) return false;
        int wgid = (int)L; { const int q = nwg / NXCD, r = nwg % NXCD, xcd = wgid % NXCD, off = wgid / NXCD; wgid = (xcd < r ? xcd * (q + 1) : r * (q + 1) + (xcd - r) * q) + off; }
        const int nig = WGM * nN, gid = wgid / nig, fm = gid * WGM, gsz = (nM - fm) < WGM ? (nM - fm) : WGM;
        u.pm = fm + ((wgid % nig) % gsz); u.pn = (wgid % nig) / gsz; return true;
    }
    __device__ __forceinline__ void a_ready(const Unit&) const {}
    __device__ __forceinline__ void done(const Unit&) const {}
};

__device__ __forceinline__ unsigned cvt_pk_bf16(float lo, float hi) { unsigned r; asm volatile("v_cvt_pk_bf16_f32 %0, %1, %2" : "=v"(r) : "v"(lo), "v"(hi)); return r; }
typedef float f32x2 __attribute__((ext_vector_type(2)));
__device__ __forceinline__ f32x2 gelu_pk(f32x2 v) {
    const f32x2 av = __builtin_elementwise_abs(v), d = av * 0.2316418882f + 1.0f;
    f32x2 t; t.x = __builtin_amdgcn_rcpf(d.x); t.y = __builtin_amdgcn_rcpf(d.y);
    f32x2 q = t * 0.5307027145f + (-0.7265760135f); q = q * t + 0.7107068705f; q = q * t + (-0.142248368f); q = q * t + 0.127414796f; q = q * t;
    const f32x2 s = (v * v) * (-0.72134752044f);
    f32x2 e; e.x = __builtin_amdgcn_exp2f(s.x); e.y = __builtin_amdgcn_exp2f(s.y);
    const f32x2 m = v * (q * e), r = v - m;
    f32x2 o; o.x = v.x < 0.f ? m.x : r.x; o.y = v.y < 0.f ? m.y : r.y; return o;
}

template <int ACT  > struct EpiBf16 {
    static constexpr bool PERM = true, AFTER_DRAIN = false; static_assert(ACT == 0 || ACT == 1, "EpiBf16: ACT is 0 (none) or 1 (gelu_pk)");
    bf16_t* O; int ldc; const float* bias; int split_cols; size_t split_stride; float scale0;
    __device__ __forceinline__ void operator()(const f32x4 (&acc)[2][2][4][2], const Unit& u, int wr, int wc, int fr, int fq) const {
        const int row0 = u.pm * BM + wr * 64 + fr; int colt = u.pn * BM; bf16_t* base = O;
        float sc = 1.f; if (split_cols) { const int t = colt / split_cols; base += (size_t)t * split_stride; colt -= t * split_cols; if (t == 0) sc = scale0; }
        const int col0 = colt + wc * 32 + 8 * fq, bcol0 = u.pn * BM + wc * 32 + 8 * fq;
        f32x4 bv[2][2];
#pragma unroll
        for (int bj = 0; bj < 2; ++bj)
#pragma unroll
            for (int n = 0; n < 2; ++n) bv[bj][n] = bias ? *(const f32x4*)(bias + bcol0 + bj * HALF + 4 * n) : (f32x4){0.f, 0.f, 0.f, 0.f};
#pragma unroll
        for (int ai = 0; ai < 2; ++ai)
#pragma unroll
            for (int m = 0; m < 4; ++m) { bf16_t* rowp = base + (size_t)(row0 + ai * HALF + m * 16) * ldc + col0;
#pragma unroll
                for (int bj = 0; bj < 2; ++bj) { f32x4 v0 = acc[ai][bj][m][0] + bv[bj][0], v1 = acc[ai][bj][m][1] + bv[bj][1];
                    if (ACT == 1) { f32x2 a = gelu_pk((f32x2){v0[0], v0[1]}), b = gelu_pk((f32x2){v0[2], v0[3]}), c = gelu_pk((f32x2){v1[0], v1[1]}), d = gelu_pk((f32x2){v1[2], v1[3]});
                        v0 = (f32x4){a.x, a.y, b.x, b.y}; v1 = (f32x4){c.x, c.y, d.x, d.y}; }
                    v0 = v0 * sc; v1 = v1 * sc; u32x4 w; w.x = cvt_pk_bf16(v0[0], v0[1]); w.y = cvt_pk_bf16(v0[2], v0[3]); w.z = cvt_pk_bf16(v1[0], v1[1]); w.w = cvt_pk_bf16(v1[2], v1[3]);
                    *(u32x4*)(rowp + bj * HALF) = w; } }
    }
};
__device__ __forceinline__ unsigned cvtpk_rne(float lo, float hi) { typedef float f32x2_t __attribute__((ext_vector_type(2))); typedef __bf16 bf16x2_t __attribute__((ext_vector_type(2)));
    f32x2_t v = {lo, hi}; bf16x2_t b = __builtin_convertvector(v, bf16x2_t); return __builtin_bit_cast(unsigned, b); }
struct EpiF32 {
    static constexpr bool PERM = false, AFTER_DRAIN = false;
    float* O; int ldc;
    __device__ __forceinline__ void operator()(const f32x4 (&acc)[2][2][4][2], const Unit& u, int wr, int wc, int fr, int fq) const {
        const int row0 = u.pm * BM + wr * 64 + fr, col0 = u.pn * BM + wc * 32 + 4 * fq;
#pragma unroll
        for (int ai = 0; ai < 2; ++ai)
#pragma unroll
            for (int m = 0; m < 4; ++m) { float* rowp = O + (size_t)(row0 + ai * HALF + m * 16) * ldc + col0;
#pragma unroll
                for (int bj = 0; bj < 2; ++bj)
#pragma unroll
                    for (int n = 0; n < 2; ++n) *(f32x4*)(rowp + bj * HALF + n * 16) = acc[ai][bj][m][n]; }
    }
};
struct EpiSwiGLU {
    static constexpr bool PERM = true, AFTER_DRAIN = false;
    bf16_t* O; int ldc;
    __device__ __forceinline__ void operator()(const f32x4 (&acc)[2][2][4][2], const Unit& u, int wr, int wc, int fr, int fq) const {
        typedef unsigned u32x2 __attribute__((ext_vector_type(2)));
        const int row0 = u.pm * BM + wr * 64 + fr, col0 = u.pn * (BM / 2) + wc * 16 + 4 * fq;
#pragma unroll
        for (int ai = 0; ai < 2; ++ai)
#pragma unroll
            for (int m = 0; m < 4; ++m) { bf16_t* rowp = O + (size_t)(row0 + ai * HALF + m * 16) * ldc + col0;
#pragma unroll
                for (int bj = 0; bj < 2; ++bj) { const f32x4 g = acc[ai][bj][m][0], up = acc[ai][bj][m][1]; float a[4];
#pragma unroll
                    for (int e = 0; e < 4; ++e) a[e] = g[e] * __builtin_amdgcn_rcpf(1.0f + __builtin_amdgcn_exp2f(-1.4426950408889634f * g[e])) * up[e];
                    u32x2 w; w.x = cvtpk_rne(a[0], a[1]); w.y = cvtpk_rne(a[2], a[3]); *(u32x2*)(rowp + bj * (HALF / 2)) = w; } }
    }
};

template <class Epi, class Sched, bool ALIGN_EPI = false, bool SP2 = false>
__device__ __forceinline__ void gemm_phase(PG8_LAS unsigned char* lds, const Gemm g, const Sched& S, const Epi& E) {
    int tid_ = threadIdx.x; asm volatile("" : "+v"(tid_));
    const int tid = tid_, wid = __builtin_amdgcn_readfirstlane(tid >> 6), lane = tid & 63, wr = wid >> 2, wc = wid & 3, fr = lane & 15, fq = lane >> 4;
    const int K = g.K, nt = K / BK;
    unsigned voffA[2], voffB[2];
#pragma unroll
    for (int i = 0; i < 2; ++i) { int R, C; stage_rc(tid * 16 + i * 8192, R, C); const int Rb = Epi::PERM ? ((R & ~31) + perm32(R & 31)) : R;
        voffA[i] = (unsigned)(R * K + C) * 2u; voffB[i] = (unsigned)(Rb * K + C) * 2u; }
    const size_t kstep = (size_t)(BK * 2);
    const size_t hstep = (size_t)HALF * K * 2;
    const size_t tstep = 2 * hstep;
    const unsigned ldsw = (unsigned)wid * 1024u;
    const int aoff = lds_byte(wr * 64 + fr, fq * 8), boff = lds_byte(wc * 32 + fr, fq * 8);
#define PG8_SA(b, h) (((b) * 2 + (h)) * HTB)
#define PG8_SB(b, h) ((4 + (b) * 2 + (h)) * HTB)
#define PG8_STAGE(bufoff, gbase, voff) do { _Pragma("unroll") for (int _i = 0; _i < 2; ++_i) \
        __builtin_amdgcn_global_load_lds((const unsigned*)((const char*)(gbase) + (voff)[_i]), (PG8_LAS unsigned*)(lds + (bufoff) + ldsw + _i * 8192), 16, 0, 0); } while (0)
#define PG8_LDA(dst, b, h) do { _Pragma("unroll") for (int m = 0; m < 4; ++m) _Pragma("unroll") for (int k = 0; k < 2; ++k) dst[m][k] = *(const PG8_LAS bf16x8*)(lds + PG8_SA(b, h) + aoff + m * 2048 + k * 1024); } while (0)
#define PG8_LDB(dst, b, h) do { _Pragma("unroll") for (int n = 0; n < 2; ++n) _Pragma("unroll") for (int k = 0; k < 2; ++k) dst[n][k] = *(const PG8_LAS bf16x8*)(lds + PG8_SB(b, h) + boff + n * 2048 + k * 1024); } while (0)
#define PG8_MMA(ai, bj, At, Bt) do { __builtin_amdgcn_s_setprio(1); _Pragma("unroll") for (int m = 0; m < 4; ++m) _Pragma("unroll") for (int n = 0; n < 2; ++n) _Pragma("unroll") for (int k = 0; k < 2; ++k) \
        acc[ai][bj][m][n] = __builtin_amdgcn_mfma_f32_16x16x32_bf16(Bt[n][k], At[m][k], acc[ai][bj][m][n], 0, 0, 0); __builtin_amdgcn_s_setprio(0); } while (0)
#define PG8_WAIT_V(n) asm volatile("s_waitcnt vmcnt(" #n ")" ::: "memory")
#define PG8_WAIT_L(n) asm volatile("s_waitcnt lgkmcnt(" #n ")" ::: "memory")
#define PG8_BAR __builtin_amdgcn_s_barrier()
#define PG8_SCHED __builtin_amdgcn_sched_barrier(0)
    Unit cur, nxt; int ui = 0;
    if (!S.next(0, cur)) return;
    f32x4 acc[2][2][4][2];
#pragma unroll
    for (int a = 0; a < 2; ++a)
#pragma unroll
        for (int b = 0; b < 2; ++b)
#pragma unroll
            for (int m = 0; m < 4; ++m)
#pragma unroll
                for (int n = 0; n < 2; ++n) acc[a][b][m][n] = (f32x4){0.f, 0.f, 0.f, 0.f};
    bf16x8 At[4][2], B0[2][2], B1[2][2];
    const char* cA = (const char*)g.A + (size_t)cur.pm * tstep; const char* cB = (const char*)g.Bt + (size_t)cur.pn * tstep;
    S.a_ready(cur);
    if constexpr (SP2) {
        PG8_STAGE(PG8_SB(0, 0), cB, voffB); PG8_STAGE(PG8_SB(0, 1), cB + hstep, voffB); PG8_STAGE(PG8_SA(0, 0), cA, voffA); PG8_STAGE(PG8_SA(0, 1), cA + hstep, voffA);
        if (wr == 1) PG8_BAR;
        PG8_WAIT_V(2); PG8_BAR;
        PG8_STAGE(PG8_SB(1, 0), cB + kstep, voffB); PG8_STAGE(PG8_SA(1, 0), cA + kstep, voffA); PG8_STAGE(PG8_SB(1, 1), cB + hstep + kstep, voffB);
        PG8_WAIT_V(6); PG8_BAR;
    } else {
        PG8_STAGE(PG8_SB(0, 0), cB, voffB); PG8_STAGE(PG8_SA(0, 0), cA, voffA); PG8_STAGE(PG8_SB(0, 1), cB + hstep, voffB); PG8_STAGE(PG8_SA(0, 1), cA + hstep, voffA);
        if (wr == 1) PG8_BAR;
        PG8_WAIT_V(4); PG8_BAR;
        PG8_STAGE(PG8_SB(1, 0), cB + kstep, voffB); PG8_STAGE(PG8_SA(1, 0), cA + kstep, voffA); PG8_STAGE(PG8_SB(1, 1), cB + hstep + kstep, voffB);
        PG8_WAIT_V(6); PG8_BAR;
    }
    for (;;) {
        const bool has_next = S.next(ui + 1, nxt);
        const char* nA = has_next ? (const char*)g.A + (size_t)nxt.pm * tstep : cA; const char* nB = has_next ? (const char*)g.Bt + (size_t)nxt.pn * tstep : cB;
        for (int t = 0; t < nt; t += 2) {
            const bool last = (t == nt - 2);
            const char* a1 = cA + (size_t)(t + 1) * kstep;
            const char* a2 = last ? nA : cA + (size_t)(t + 2) * kstep; const char* b2 = last ? nB : cB + (size_t)(t + 2) * kstep;
            const char* a3 = a2 + kstep; const char* b3 = b2 + kstep;
            if (last && has_next) S.a_ready(nxt);
            if constexpr (SP2) {
            PG8_LDB(B0, 0, 0); PG8_LDB(B1, 0, 1); PG8_SCHED; PG8_LDA(At, 0, 0); PG8_STAGE(PG8_SA(1, 1), a1 + hstep, voffA);
            PG8_WAIT_V(8); PG8_WAIT_L(0); PG8_BAR; PG8_MMA(0, 0, At, B0); PG8_MMA(0, 1, At, B1); PG8_BAR; PG8_SCHED;
            PG8_LDA(At, 0, 1); PG8_STAGE(PG8_SB(0, 0), b2, voffB); PG8_STAGE(PG8_SB(0, 1), b2 + hstep, voffB); PG8_STAGE(PG8_SA(0, 0), a2, voffA);
            PG8_WAIT_V(8); PG8_WAIT_L(0); PG8_BAR; PG8_MMA(1, 0, At, B0); PG8_MMA(1, 1, At, B1); PG8_BAR; PG8_SCHED;
            PG8_LDB(B0, 1, 0); PG8_LDB(B1, 1, 1); PG8_SCHED; PG8_LDA(At, 1, 0); PG8_STAGE(PG8_SA(0, 1), a2 + hstep, voffA);
            PG8_WAIT_V(8); PG8_WAIT_L(0); PG8_BAR; PG8_MMA(0, 0, At, B0); PG8_MMA(0, 1, At, B1); PG8_BAR; PG8_SCHED;
            PG8_LDA(At, 1, 1); PG8_STAGE(PG8_SB(1, 0), b3, voffB); PG8_STAGE(PG8_SB(1, 1), b3 + hstep, voffB); PG8_STAGE(PG8_SA(1, 0), a3, voffA);
            PG8_WAIT_V(8); PG8_WAIT_L(0); PG8_BAR; PG8_MMA(1, 0, At, B0); PG8_MMA(1, 1, At, B1); PG8_BAR; PG8_SCHED;
            } else {
            PG8_LDB(B0, 0, 0); PG8_SCHED; PG8_LDA(At, 0, 0); PG8_STAGE(PG8_SA(1, 1), a1 + hstep, voffA);
            PG8_WAIT_L(8); PG8_BAR; PG8_WAIT_L(0); PG8_MMA(0, 0, At, B0); PG8_BAR; PG8_SCHED;
            PG8_LDB(B1, 0, 1); PG8_STAGE(PG8_SB(0, 0), b2, voffB);
            PG8_BAR; PG8_WAIT_L(0); PG8_MMA(0, 1, At, B1); PG8_BAR;
            PG8_LDA(At, 0, 1); PG8_STAGE(PG8_SA(0, 0), a2, voffA);
            PG8_BAR; PG8_WAIT_L(0); PG8_MMA(1, 0, At, B0); PG8_BAR; PG8_SCHED;
            PG8_STAGE(PG8_SB(0, 1), b2 + hstep, voffB);
            PG8_WAIT_V(6); PG8_BAR; PG8_MMA(1, 1, At, B1); PG8_BAR;
            PG8_LDB(B0, 1, 0); PG8_SCHED; PG8_LDA(At, 1, 0); PG8_STAGE(PG8_SA(0, 1), a2 + hstep, voffA);
            PG8_WAIT_L(8); PG8_BAR; PG8_WAIT_L(0); PG8_MMA(0, 0, At, B0); PG8_BAR; PG8_SCHED;
            PG8_LDB(B1, 1, 1); PG8_STAGE(PG8_SB(1, 0), b3, voffB);
            PG8_BAR; PG8_WAIT_L(0); PG8_MMA(0, 1, At, B1); PG8_BAR;
            PG8_LDA(At, 1, 1); PG8_STAGE(PG8_SA(1, 0), a3, voffA);
            PG8_BAR; PG8_WAIT_L(0); PG8_MMA(1, 0, At, B0); PG8_BAR; PG8_SCHED;
            PG8_STAGE(PG8_SB(1, 1), b3 + hstep, voffB);
            PG8_WAIT_V(6); PG8_BAR; PG8_MMA(1, 1, At, B1); PG8_BAR;
            }
        }
        if constexpr (ALIGN_EPI) { if (wr == 0) PG8_BAR; }
        if constexpr (!Epi::AFTER_DRAIN) { E(acc, cur, wr, wc, fr, fq); S.done(cur); }
        if (!has_next) break;
#pragma unroll
        for (int a = 0; a < 2; ++a)
#pragma unroll
            for (int b = 0; b < 2; ++b)
#pragma unroll
                for (int m = 0; m < 4; ++m)
#pragma unroll
                    for (int n = 0; n < 2; ++n) acc[a][b][m][n] = (f32x4){0.f, 0.f, 0.f, 0.f};
        cur = nxt; cA = nA; cB = nB; ++ui;
        if constexpr (ALIGN_EPI) { if (wr == 1) PG8_BAR; }
    }
    PG8_WAIT_V(0);
    if constexpr (!ALIGN_EPI) { if (wr == 0) PG8_BAR; }
    PG8_BAR;
    if constexpr (Epi::AFTER_DRAIN) { E.fused(acc, cur, wr, wc, fr, fq, lds, wid, lane); S.done(cur); }
#undef PG8_SA
#undef PG8_SB
#undef PG8_STAGE
#undef PG8_LDA
#undef PG8_LDB
#undef PG8_MMA
#undef PG8_WAIT_V
#undef PG8_WAIT_L
#undef PG8_BAR
#undef PG8_SCHED
}
}

#ifndef PG8_SP2
#define PG8_SP2 true
#endif
#ifndef PG8_ALIGN
#define PG8_ALIGN true
#endif
#ifndef PROBE_DUP
#define PROBE_DUP 0
#endif
#ifndef MK_SPLIT
#define MK_SPLIT 0
#endif

constexpr int NB = 2, SEQ = 4096, DM = 2048, NMETA = 16, LSEQ = SEQ + NMETA, DEPTH = 2;
constexpr int MR = NB * SEQ;
constexpr int MV = MR + NMETA;
constexpr int MP = 33 * 256;
constexpr int DIN = 4608, DFF = 5632, DATT = 1024, DPOOL = 512, DCONV = 512, NHEAD = 16;
constexpr int C_K = 1024, C_V = 2048, C_POOL = 3072, C_CA = 3584, C_CG = 4096;
constexpr float EPS = 1e-6f, LOG2E = 1.4426950408889634f, LN2 = 0.6931471805599453f;
constexpr float SB_EXIT = -104.0f;

constexpr size_t MiB = 1u << 20;
constexpr size_t WS_WIN = 0;
constexpr size_t WS_WOUT = WS_WIN + 36 * MiB;
constexpr size_t WS_WGU = WS_WOUT + 16 * MiB;
constexpr size_t WS_WD = WS_WGU + 44 * MiB;
constexpr size_t WS_WSM = WS_WD + 22 * MiB;
constexpr size_t WS_H = WS_WSM + 2 * MiB;
constexpr size_t WS_U = WS_H + 66 * MiB;
constexpr size_t WS_OUT = WS_U + 33 * MiB;
constexpr size_t WS_PROJ = WS_OUT + 66 * MiB;
constexpr size_t WS_MERGED = WS_PROJ + (size_t)MP * DIN * 2;
constexpr size_t WS_ACT = WS_PROJ;
constexpr size_t WS_CTL = WS_MERGED + 33 * MiB;
constexpr size_t CTL_BYTES = 65536;
constexpr size_t WS_END = WS_CTL + 1 * MiB;
static_assert((size_t)MP * DFF * 2 <= WS_END - WS_PROJ, "act overlay");

constexpr int LDS_BYTES = 147456;

#define GAS __attribute__((address_space(1)))
#define LAS __attribute__((address_space(3)))
typedef unsigned short bf16;
typedef unsigned v4u __attribute__((ext_vector_type(4)));
typedef unsigned v2u __attribute__((ext_vector_type(2)));
typedef float f32x4 __attribute__((ext_vector_type(4)));
typedef short bf16x8 __attribute__((ext_vector_type(8)));
typedef short v4i16_t __attribute__((ext_vector_type(4)));
#define LDS_WAIT() asm volatile("s_waitcnt lgkmcnt(0)" ::: "memory")

__device__ __forceinline__ unsigned cvtpk(float lo, float hi) { return pg8::cvtpk_rne(lo, hi); }
__device__ __forceinline__ float bflo(unsigned u) { return __uint_as_float(u << 16); }
__device__ __forceinline__ float bfhi(unsigned u) { return __uint_as_float(u & 0xffff0000u); }
__device__ __forceinline__ float bf2f(bf16 v) { return __uint_as_float((unsigned)v << 16); }
__device__ __forceinline__ float wave_sum(float v) {
#pragma unroll
    for (int o = 1; o < 64; o <<= 1) v += __shfl_xor(v, o);
    return v;
}
__device__ __forceinline__ float sigmoidf_(float x) { return __builtin_amdgcn_rcpf(1.0f + __builtin_amdgcn_exp2f(-LOG2E * x)); }
template <class T> __device__ __forceinline__ T* gptr(T* p) { GAS T* g = (GAS T*)p; asm volatile("" : "+s"(g)); return (T*)g; }
__device__ __forceinline__ int rowidx(int b, int pos) { return pos < NMETA ? MR + pos : b * SEQ + pos - NMETA; }
__device__ __forceinline__ f32x4 mfma16(bf16x8 a, bf16x8 b, f32x4 c) { return __builtin_amdgcn_mfma_f32_16x16x32_bf16(a, b, c, 0, 0, 0); }

struct Args {
    const float *x, *meta, *pre_mix_g, *w_in, *w_pool, *pool_scale, *w_dw, *b_dw, *conv_ln_g, *conv_ln_b, *w_pw, *mix_out_g, *w_out, *post_mix_g, *pre_ffn_g, *w_gate, *w_up, *w_down, *post_ffn_g;
    float* out; unsigned char* ws; int ph_lo, ph_hi;
};

__device__ __forceinline__ void transpose_item(const float* __restrict__ W, int K, int N, bf16* WT, int mode, LAS float* scr, int item, int lane) {
    W = gptr(W); WT = gptr(WT);
    const int nblk = N >> 6, kb = item / nblk, nb = item - kb * nblk, k0 = kb << 6, n0 = nb << 6;
    const int r4 = lane >> 4, c4 = (lane & 15) * 4;
    f32x4 tv[16];
#pragma unroll
    for (int i = 0; i < 16; ++i) tv[i] = *(const f32x4*)(W + (size_t)(k0 + 4 * i + r4) * N + n0 + c4);
#pragma unroll
    for (int i = 0; i < 16; ++i) { LAS float* s = scr + (4 * i + r4) * 65 + c4; s[0] = tv[i].x; s[1] = tv[i].y; s[2] = tv[i].z; s[3] = tv[i].w; }
    LDS_WAIT();
    const int c = lane & 7;
#pragma unroll
    for (int j = 0; j < 8; ++j) { const int n = (lane >> 3) + 8 * j; const LAS float* s = scr + (8 * c) * 65 + n;
        v4u o; o.x = cvtpk(s[0 * 65], s[1 * 65]); o.y = cvtpk(s[2 * 65], s[3 * 65]); o.z = cvtpk(s[4 * 65], s[5 * 65]); o.w = cvtpk(s[6 * 65], s[7 * 65]);
        const int ng = n0 + n; const int R = mode == 0 ? ng : ((ng >> 2) * 8 + (ng & 3) + (mode == 2 ? 4 : 0));
        *(v4u*)(WT + (size_t)R * K + k0 + 8 * c) = o; }
    LDS_WAIT();
}
#define TJOB(Wp, Kk, Nn, WTp, mode) { const int ni_ = ((Kk) / 64) * ((Nn) / 64); if (r < ni_) { transpose_item((Wp), (Kk), (Nn), (WTp), (mode), scr, r, lane); continue; } r -= ni_; }

__device__ __forceinline__ void convert_ffn_weights(const Args& A, int l, LAS float* scr, int gw, int NGW, int lane) {
    bf16* wgu = (bf16*)(A.ws + WS_WGU); bf16* wd = (bf16*)(A.ws + WS_WD);
    constexpr int NI = 3 * (DM / 64) * (DFF / 64);
    for (int it = gw; it < NI; it += NGW) { int r = it;
        TJOB(A.w_gate + (size_t)l * DM * DFF, DM, DFF, wgu, 1)
        TJOB(A.w_up + (size_t)l * DM * DFF, DM, DFF, wgu, 2)
        TJOB(A.w_down + (size_t)l * DFF * DM, DFF, DM, wd, 0)
    }
}
__device__ __forceinline__ void convert_p0_weights(const Args& A, LAS float* scr, int gw, int NGW, int lane) {
    constexpr int I_IN = (DM / 64) * (DIN / 64), I_PW = 64, I_POOL = 16, NI = I_IN + DEPTH * (I_PW + I_POOL);
    for (int it = gw; it < NI; it += NGW) { int r = it;
        if (r < I_IN) { transpose_item(A.w_in, DM, DIN, (bf16*)(A.ws + WS_WIN), 0, scr, r, lane); continue; } r -= I_IN;
        const int l = r / (I_PW + I_POOL); r -= l * (I_PW + I_POOL);
        if (r < I_PW) { transpose_item(A.w_pw + (size_t)l * 512 * 512, 512, 512, (bf16*)(A.ws + WS_WSM + 256 * 1024) + (size_t)l * 512 * 512, 0, scr, r, lane); continue; } r -= I_PW;
        { const int g = r >> 2; transpose_item(A.w_pool + (size_t)(l * 4 + g) * 128 * 128, 128, 128, (bf16*)(A.ws + WS_WSM) + (size_t)(l * 4 + g) * 128 * 128, 0, scr, r & 3, lane); }
    }
}
__device__ __forceinline__ void convert_wout(const Args& A, int l, LAS float* scr, int gw, int NGW, int lane) {
    constexpr int NI = (DM / 64) * (DM / 64);
    for (int it = gw; it < NI; it += NGW) transpose_item(A.w_out + (size_t)l * DM * DM, DM, DM, (bf16*)(A.ws + WS_WOUT) + (size_t)l * DM * DM, 0, scr, it, lane);
}
__device__ __forceinline__ void convert_win(const Args& A, int l, LAS float* scr, int gw, int NGW, int lane) {
    constexpr int NI = (DM / 64) * (DIN / 64);
    for (int it = gw; it < NI; it += NGW) transpose_item(A.w_in + (size_t)l * DM * DIN, DM, DIN, (bf16*)(A.ws + WS_WIN) + (size_t)l * DIN * DM, 0, scr, it, lane);
}

__device__ __forceinline__ float dot4(f32x4 a) { return (a.x * a.x + a.y * a.y) + (a.z * a.z + a.w * a.w); }
__device__ __forceinline__ void store_u_row(bf16* urow, const f32x4 (&hv)[8], float r, const float* g, int lane) {
#pragma unroll
    for (int j = 0; j < 8; ++j) { const f32x4 gv = ((const f32x4*)g)[lane + 64 * j]; v2u w; w.x = cvtpk(hv[j].x * r * gv.x, hv[j].y * r * gv.y); w.y = cvtpk(hv[j].z * r * gv.z, hv[j].w * r * gv.w);
        ((v2u*)urow)[lane + 64 * j] = w; }
}
__device__ __forceinline__ void init_rows(const Args& A, int gw, int NGW, int lane) {
    unsigned char* wsb = gptr(A.ws); float* h = (float*)(wsb + WS_H); bf16* u = (bf16*)(wsb + WS_U); const float* pg = gptr(A.pre_mix_g);
    for (int m = gw; m < MV; m += NGW) {
        const float* src = m < MR ? gptr(A.x) + (size_t)m * DM : gptr(A.meta) + (size_t)(m - MR) * DM;
        f32x4 hv[8]; float ss = 0.f;
#pragma unroll
        for (int j = 0; j < 8; ++j) { hv[j] = ((const f32x4*)src)[lane + 64 * j]; ss += dot4(hv[j]); ((f32x4*)(h + (size_t)m * DM))[lane + 64 * j] = hv[j]; }
        const float r = rsqrtf(wave_sum(ss) * (1.0f / DM) + EPS);
        store_u_row(u + (size_t)m * DM, hv, r, pg, lane);
    }
}
__device__ __forceinline__ void row_phase(const Args& A, const float* g1, const float* g2, float* dout, int nrows, int gw, int NGW, int lane) {
    unsigned char* wsb = gptr(A.ws); float* h = (float*)(wsb + WS_H); bf16* u = (bf16*)(wsb + WS_U); const float* src = (const float*)(wsb + WS_OUT); g1 = gptr(g1); g2 = gptr(g2); dout = gptr(dout);
    for (int m0 = gw; m0 < nrows; m0 += 2 * NGW) {
        const int m1 = m0 + NGW; const bool two = m1 < nrows; const int mb = two ? m1 : m0;
        f32x4 oA[8], hA[8], oB[8], hB[8]; float ssA = 0.f, ssB = 0.f;
#pragma unroll
        for (int j = 0; j < 8; ++j) { oA[j] = ((const f32x4*)(src + (size_t)m0 * DM))[lane + 64 * j]; hA[j] = ((const f32x4*)(h + (size_t)m0 * DM))[lane + 64 * j]; }
#pragma unroll
        for (int j = 0; j < 8; ++j) { oB[j] = ((const f32x4*)(src + (size_t)mb * DM))[lane + 64 * j]; hB[j] = ((const f32x4*)(h + (size_t)mb * DM))[lane + 64 * j]; }
#pragma unroll
        for (int j = 0; j < 8; ++j) { ssA += dot4(oA[j]); ssB += dot4(oB[j]); }
        const float rA = rsqrtf(wave_sum(ssA) * (1.0f / DM) + EPS), rB = rsqrtf(wave_sum(ssB) * (1.0f / DM) + EPS);
        float s2A = 0.f, s2B = 0.f;
#pragma unroll
        for (int j = 0; j < 8; ++j) { const f32x4 gv = ((const f32x4*)g1)[lane + 64 * j]; hA[j] = hA[j] + oA[j] * rA * gv; hB[j] = hB[j] + oB[j] * rB * gv; s2A += dot4(hA[j]); s2B += dot4(hB[j]); }
        if (dout) {
            if (m0 < MR) {
#pragma unroll
                for (int j = 0; j < 8; ++j) ((f32x4*)(dout + (size_t)m0 * DM))[lane + 64 * j] = hA[j];
            }
            if (two && m1 < MR) {
#pragma unroll
                for (int j = 0; j < 8; ++j) ((f32x4*)(dout + (size_t)m1 * DM))[lane + 64 * j] = hB[j];
            }
        } else {
#pragma unroll
            for (int j = 0; j < 8; ++j) ((f32x4*)(h + (size_t)m0 * DM))[lane + 64 * j] = hA[j];
            if (two) {
#pragma unroll
                for (int j = 0; j < 8; ++j) ((f32x4*)(h + (size_t)m1 * DM))[lane + 64 * j] = hB[j];
            }
            const float r2A = rsqrtf(wave_sum(s2A) * (1.0f / DM) + EPS), r2B = rsqrtf(wave_sum(s2B) * (1.0f / DM) + EPS);
            store_u_row(u + (size_t)m0 * DM, hA, r2A, g2, lane);
            if (two) store_u_row(u + (size_t)m1 * DM, hB, r2B, g2, lane);
        }
    }
}

template <int MODE> __device__ __forceinline__ void skinny_gemm(const bf16* __restrict__ Arows, const bf16* __restrict__ Bt, int N, int K, void* O, int ldc, LAS unsigned char* lds, int lane, int wave) {
    const int li = lane & 15, fq = lane >> 4; const int nks = K >> 5;
    LAS f32x4* part = (LAS f32x4*)lds;
    for (int blk = blockIdx.x; blk < (N >> 4); blk += gridDim.x) {
        const bf16* bp = Bt + (size_t)(blk * 16 + li) * K + 8 * fq; const bf16* ap = Arows + (size_t)li * K + 8 * fq;
        f32x4 acc = (f32x4){0.f, 0.f, 0.f, 0.f};
#pragma unroll 8
        for (int ks = wave; ks < nks; ks += 8) { const bf16x8 wf = *(const bf16x8*)(bp + ks * 32); const bf16x8 af = *(const bf16x8*)(ap + ks * 32); acc = mfma16(wf, af, acc); }
        part[wave * 64 + lane] = acc;
        __syncthreads();
        if (wave == 0) {
            f32x4 v = part[lane];
#pragma unroll
            for (int w8 = 1; w8 < 8; ++w8) v = v + part[w8 * 64 + lane];
            const int n0 = blk * 16 + 4 * fq;
            if (MODE == 0) { const float sc = n0 < 1024 ? 0.125f : 1.0f; v2u w; w.x = cvtpk(v.x * sc, v.y * sc); w.y = cvtpk(v.z * sc, v.w * sc); *(v2u*)((bf16*)O + (size_t)(MR + li) * ldc + n0) = w; }
            else if (MODE == 1) { *(f32x4*)((float*)O + (size_t)(MR + li) * ldc + n0) = v; }
            else { f32x4 up; up.x = __shfl_xor(v.x, 16); up.y = __shfl_xor(v.y, 16); up.z = __shfl_xor(v.z, 16); up.w = __shfl_xor(v.w, 16);
                if ((fq & 1) == 0) { v2u w; w.x = cvtpk(v.x * sigmoidf_(v.x) * up.x, v.y * sigmoidf_(v.y) * up.y); w.y = cvtpk(v.z * sigmoidf_(v.z) * up.z, v.w * sigmoidf_(v.w) * up.w);
                    *(v2u*)((bf16*)O + (size_t)(MR + li) * ldc + blk * 8 + 4 * (fq >> 1)) = w; } }
        }
        __syncthreads();
    }
}

constexpr int VPITCH = 128;
constexpr int ML_V = 0, ML_ST = 8 * 64 * VPITCH  , ML_RED = ML_ST + 65536, ML_Y = 0  , ML_AB = ML_Y + 16 * 516 * 4;
static_assert(ML_RED + 3 * 512 <= LDS_BYTES && ML_AB + 16 * 1040 <= ML_ST, "mixer LDS");

__device__ __forceinline__ float softplus_(float z) { const float t = __builtin_amdgcn_exp2f(-LOG2E * __builtin_fabsf(z)); return __builtin_fmaxf(z, 0.f) + LN2 * __builtin_amdgcn_logf(1.0f + t); }
__device__ __forceinline__ void split_pack(const f32x4& a, const f32x4& b, bf16x8& hi, bf16x8& lo) {
    v4u h, l;
    h.x = cvtpk(a[0], a[1]); h.y = cvtpk(a[2], a[3]); h.z = cvtpk(b[0], b[1]); h.w = cvtpk(b[2], b[3]);
    l.x = cvtpk(a[0] - bflo(h.x), a[1] - bfhi(h.x)); l.y = cvtpk(a[2] - bflo(h.y), a[3] - bfhi(h.y));
    l.z = cvtpk(b[0] - bflo(h.z), b[1] - bfhi(h.z)); l.w = cvtpk(b[2] - bflo(h.w), b[3] - bfhi(h.w));
    hi = __builtin_bit_cast(bf16x8, h); lo = __builtin_bit_cast(bf16x8, l);
}
__device__ __forceinline__ void sb_attention(const bf16* __restrict__ proj, int b, int p0, int hd, LAS unsigned char* vl, int lane, f32x4 (&o)[4]) {
    const int li = lane & 15, fq = lane >> 4;
    const int qpos = p0 + li;
    const bf16* qp = proj + (size_t)rowidx(b, qpos) * DIN + hd * 64 + fq * 8;
    const bf16x8 qf0 = *(const bf16x8*)qp, qf1 = *(const bf16x8*)(qp + 32);
    unsigned d0 = 0u, d1 = 0u;
    { const unsigned one = 0x3F80u; d0 = ((4 * fq + 0 >= li) ? one : 0u) | ((4 * fq + 1 >= li) ? (one << 16) : 0u); d1 = ((4 * fq + 2 >= li) ? one : 0u) | ((4 * fq + 3 >= li) ? (one << 16) : 0u); }
    const unsigned ONE2 = 0x3F803F80u;
    const bf16x8 F_D1 = __builtin_bit_cast(bf16x8, (v4u){d0, d1, ONE2, ONE2});
    const bf16x8 F_11 = __builtin_bit_cast(bf16x8, (v4u){ONE2, ONE2, ONE2, ONE2});
    const bf16x8 F_0D = __builtin_bit_cast(bf16x8, (v4u){0u, 0u, d0, d1});
#pragma unroll
    for (int i = 0; i < 4; ++i) o[i] = (f32x4){0.f, 0.f, 0.f, 0.f};
    float carry = 0.f;
    const int ktd = p0 >> 6, kbmax = (p0 & 63) >> 4;
    const unsigned trbase = (unsigned)((4 * fq + (li >> 2)) * VPITCH + (lane & 3) * 8);
    bf16x8 kf[4][2];
#define SB_LOADK(KT) do { _Pragma("unroll") for (int kb = 0; kb < 4; ++kb) { int kp = 64 * (KT) + 16 * kb + li; kp = kp < LSEQ ? kp : LSEQ - 1; const bf16* kr = proj + (size_t)rowidx(b, kp) * DIN + C_K + hd * 64 + fq * 8; \
        kf[kb][0] = *(const bf16x8*)kr; kf[kb][1] = *(const bf16x8*)(kr + 32); } } while (0)
    SB_LOADK(ktd);
    for (int kt = ktd; kt >= 0; --kt) {
        const bool diag = (kt == ktd);
#pragma unroll
        for (int it = 0; it < 8; ++it) { const int key = it * 8 + (lane >> 3); int kp = 64 * kt + key; kp = kp < LSEQ ? kp : LSEQ - 1;
            __builtin_amdgcn_global_load_lds((const unsigned*)(proj + (size_t)rowidx(b, kp) * DIN + C_V + hd * 64 + (lane & 7) * 8), (LAS unsigned*)(vl + it * 1024), 16, 0, 0); }
        f32x4 s[4], lnb[4];
#pragma unroll
        for (int kb = 0; kb < 4; ++kb) { s[kb] = mfma16(kf[kb][0], qf0, (f32x4){0.f, 0.f, 0.f, 0.f}); s[kb] = mfma16(kf[kb][1], qf1, s[kb]); }
        { const int ktn = kt > 0 ? kt - 1 : 0; SB_LOADK(ktn); }
#pragma unroll
        for (int kb = 0; kb < 4; ++kb)
#pragma unroll
            for (int e = 0; e < 4; ++e) { const bool m = !diag || (64 * kt + 16 * kb + 4 * fq + e < qpos); lnb[kb][e] = (diag && kb > kbmax) ? 0.f : (m ? -softplus_(s[kb][e]) : 0.f); }
        bf16x8 bh[2], bl[2];
        split_pack(lnb[0], lnb[1], bh[0], bl[0]); split_pack(lnb[2], lnb[3], bh[1], bl[1]);
        f32x4 c[4];
#pragma unroll
        for (int i = 0; i < 4; ++i) c[i] = (f32x4){carry, carry, carry, carry};
        c[0] = mfma16(F_D1, bh[0], c[0]); c[0] = mfma16(F_D1, bl[0], c[0]); c[0] = mfma16(F_11, bh[1], c[0]); c[0] = mfma16(F_11, bl[1], c[0]);
        c[1] = mfma16(F_0D, bh[0], c[1]); c[1] = mfma16(F_0D, bl[0], c[1]); c[1] = mfma16(F_11, bh[1], c[1]); c[1] = mfma16(F_11, bl[1], c[1]);
        c[2] = mfma16(F_D1, bh[1], c[2]); c[2] = mfma16(F_D1, bl[1], c[2]);
        c[3] = mfma16(F_0D, bh[1], c[3]); c[3] = mfma16(F_0D, bl[1], c[3]);
        f32x4 w[4];
#pragma unroll
        for (int kb = 0; kb < 4; ++kb)
#pragma unroll
            for (int e = 0; e < 4; ++e) { const bool m = !diag || (64 * kt + 16 * kb + 4 * fq + e < qpos); w[kb][e] = (diag && kb > kbmax) ? 0.f : (m ? __builtin_amdgcn_exp2f(LOG2E * (s[kb][e] + c[kb][e])) : 0.f); }
        carry = __shfl(c[0][0], li);
        v4u p0v, p1v;
        p0v.x = cvtpk(w[0][0], w[0][1]); p0v.y = cvtpk(w[0][2], w[0][3]); p0v.z = cvtpk(w[1][0], w[1][1]); p0v.w = cvtpk(w[1][2], w[1][3]);
        p1v.x = cvtpk(w[2][0], w[2][1]); p1v.y = cvtpk(w[2][2], w[2][3]); p1v.z = cvtpk(w[3][0], w[3][1]); p1v.w = cvtpk(w[3][2], w[3][3]);
        const bf16x8 pf0 = __builtin_bit_cast(bf16x8, p0v), pf1 = __builtin_bit_cast(bf16x8, p1v);
        asm volatile("s_waitcnt vmcnt(0)" ::: "memory");
#pragma unroll
        for (int db = 0; db < 4; ++db) {
#pragma unroll
            for (int s2 = 0; s2 < 2; ++s2) {
                const v4i16_t lo = __builtin_amdgcn_ds_read_tr16_b64_v4i16((LAS v4i16_t*)(vl + trbase + (32 * s2) * VPITCH + db * 32));
                const v4i16_t hi = __builtin_amdgcn_ds_read_tr16_b64_v4i16((LAS v4i16_t*)(vl + trbase + (32 * s2 + 16) * VPITCH + db * 32));
                const bf16x8 vf = (bf16x8){lo[0], lo[1], lo[2], lo[3], hi[0], hi[1], hi[2], hi[3]};
                o[db] = mfma16(vf, s2 == 0 ? pf0 : pf1, o[db]);
            }
        }
        if (__all(carry < SB_EXIT)) break;
    }
#undef SB_LOADK
}

template <int W> __device__ __forceinline__ void pool_group(const bf16* __restrict__ psrc, const bf16* __restrict__ wpt, int b, int pos, f32x4 (&pacc)[4]) {
    const int cnt = (pos + 1 < W) ? pos + 1 : W; const float inv = 1.0f / (float)cnt;
    constexpr int BW = W;
#pragma unroll 1
    for (int ks = 0; ks < 4; ++ks) {
        bf16x8 wf[4];
#pragma unroll
        for (int nb = 0; nb < 4; ++nb) wf[nb] = *(const bf16x8*)(wpt + (size_t)nb * 16 * 128 + 32 * ks);
        float sum[8], self[8];
#pragma unroll
        for (int e = 0; e < 8; ++e) { sum[e] = 0.f; self[e] = 0.f; }
#pragma unroll
        for (int j0 = 0; j0 < W; j0 += BW) {
            v4u v[BW];
#pragma unroll
            for (int j = 0; j < BW; ++j) { const int pp = pos - j0 - j; v[j] = *(const v4u*)(psrc + (size_t)rowidx(b, pp >= 0 ? pp : 0) * DIN + 32 * ks); }
#pragma unroll
            for (int j = 0; j < BW; ++j) { const float f = (pos - j0 - j) >= 0 ? 1.0f : 0.0f;
                sum[0] += f * bflo(v[j].x); sum[1] += f * bfhi(v[j].x); sum[2] += f * bflo(v[j].y); sum[3] += f * bfhi(v[j].y);
                sum[4] += f * bflo(v[j].z); sum[5] += f * bfhi(v[j].z); sum[6] += f * bflo(v[j].w); sum[7] += f * bfhi(v[j].w); }
            if (j0 == 0) { self[0] = bflo(v[0].x); self[1] = bfhi(v[0].x); self[2] = bflo(v[0].y); self[3] = bfhi(v[0].y); self[4] = bflo(v[0].z); self[5] = bfhi(v[0].z); self[6] = bflo(v[0].w); self[7] = bfhi(v[0].w); }
            if (j0 + BW < W) __builtin_amdgcn_sched_barrier(0);
        }
        v4u pk; pk.x = cvtpk(sum[0] * inv - self[0], sum[1] * inv - self[1]); pk.y = cvtpk(sum[2] * inv - self[2], sum[3] * inv - self[3]);
        pk.z = cvtpk(sum[4] * inv - self[4], sum[5] * inv - self[5]); pk.w = cvtpk(sum[6] * inv - self[6], sum[7] * inv - self[7]);
        const bf16x8 pf = __builtin_bit_cast(bf16x8, pk);
#pragma unroll
        for (int nb = 0; nb < 4; ++nb) pacc[nb] = mfma16(wf[nb], pf, pacc[nb]);
    }
}

__device__ __forceinline__ void mixer_phase(const Args& A, int l, LAS unsigned char* lds, int tid0, int wave) {
    unsigned char* wsb = gptr(A.ws);
    const bf16* proj = (const bf16*)(wsb + WS_PROJ); bf16* merged = (bf16*)(wsb + WS_MERGED);
    const bf16* wpool_t = (const bf16*)(wsb + WS_WSM) + (size_t)l * 4 * 128 * 128;
    const bf16* wpw_t = (const bf16*)(wsb + WS_WSM + 256 * 1024) + (size_t)l * 512 * 512;
    const float* wdw = gptr(A.w_dw) + (size_t)l * 31 * 512; const float* bdw = gptr(A.b_dw) + l * 512; const float* lng = gptr(A.conv_ln_g) + l * 512; const float* lnb_ = gptr(A.conv_ln_b) + l * 512;
    const float* psc = gptr(A.pool_scale) + l * 512; const float* mg = gptr(A.mix_out_g) + (size_t)l * DM;
    LAS float* Y = (LAS float*)(lds + ML_Y); LAS unsigned short* Ab = (LAS unsigned short*)(lds + ML_AB); LAS float* red = (LAS float*)(lds + ML_RED);
    LAS unsigned char* vl = lds + ML_V + wave * (64 * VPITCH); LAS unsigned char* st = lds + ML_ST + wave * 8192;
    const int nunits = (l + 1 < DEPTH) ? 513 : 512;
    const int vcu = (gridDim.x % 8 == 0) ? ((int)blockIdx.x % 8) * ((int)gridDim.x / 8) + (int)blockIdx.x / 8 : (int)blockIdx.x;
    for (int ui = vcu; ui < nunits; ui += gridDim.x) {
        int ti = ui;
        if (gridDim.x == 256 && ui < 512) { const int w = ui & 255, rnd = ui >> 8; ti = 256 * (w >> 7) + (rnd == 0 ? 128 : 0) + (w & 127); }
        int b, p0; if (ti < 512) { b = ti >> 8; p0 = 16 + 16 * (ti & 255); } else { b = 0; p0 = 0; }
        int tid_l = tid0; asm volatile("" : "+v"(tid_l));
        const int tid = tid_l, lane = tid & 63, li = lane & 15, fq = lane >> 4;
#pragma unroll 1
        for (int hh = 0; hh < ((PROBE_DUP & 64) ? 4 : 2); ++hh) { f32x4 o0[4];
            sb_attention(proj, b, p0, 2 * wave + (hh & 1), vl, lane, o0);
#pragma unroll
            for (int db = 0; db < 4; ++db) *(LAS f32x4*)(st + (((hh & 1) * 4 + db) * 64 + lane) * 16) = o0[db]; }
        __syncthreads();
        f32x4 cacc[4];
        for (int crep = 0; crep < ((PROBE_DUP & 128) ? 2 : 1); ++crep) {
            if (crep) __syncthreads();
        {
            const int c = tid; const bf16* pa = proj + C_CA + c;
            float glu[46];
#pragma unroll
            for (int r = 0; r < 46; ++r) { const int pos = p0 - 30 + r; float gv = 0.f;
                if (pos >= 0) { const size_t row = (size_t)rowidx(b, pos); const float a = bf2f(pa[row * DIN]); const float gt = bf2f(pa[row * DIN + 512]); gv = a * sigmoidf_(gt); }
                glu[r] = gv;
                if ((r & 15) == 15) __builtin_amdgcn_sched_barrier(0); }
            const float* wdc = wdw + c; asm volatile("" : "+v"(wdc));
            float y[16]; const float bias = bdw[c];
#pragma unroll
            for (int t = 0; t < 16; ++t) y[t] = bias;
#pragma unroll
            for (int j = 0; j < 31; ++j) { const float w = wdc[j * 512];
#pragma unroll
                for (int t = 0; t < 16; ++t) y[t] += w * glu[t + j]; }
#pragma unroll
            for (int t = 0; t < 16; ++t) Y[t * 516 + c] = y[t];
        }
        __syncthreads();
#pragma unroll
        for (int tt = 0; tt < 2; ++tt) { const int t = 2 * wave + tt; float v[8]; float sm = 0.f;
#pragma unroll
            for (int i = 0; i < 8; ++i) { v[i] = Y[t * 516 + lane + 64 * i]; sm += v[i]; }
            const float mean = wave_sum(sm) * (1.0f / 512.0f); float q = 0.f;
#pragma unroll
            for (int i = 0; i < 8; ++i) { v[i] -= mean; q += v[i] * v[i]; }
            const float rstd = rsqrtf(wave_sum(q) * (1.0f / 512.0f) + EPS);
#pragma unroll
            for (int i = 0; i < 8; ++i) { const int c = lane + 64 * i; const float yn = v[i] * rstd * lng[c] + lnb_[c]; const float a = yn * sigmoidf_(yn); Ab[t * 520 + c] = (unsigned short)(cvtpk(a, 0.f) & 0xffffu); }
        }
        __syncthreads();
#pragma unroll
        for (int i = 0; i < 4; ++i) cacc[i] = (f32x4){0.f, 0.f, 0.f, 0.f};
        { const bf16* wp = wpw_t + (size_t)(64 * wave + li) * 512 + 8 * fq; const LAS unsigned char* ab = (const LAS unsigned char*)Ab + li * 1040 + fq * 16;
#pragma unroll 8
            for (int ks = 0; ks < 16; ++ks) { const bf16x8 bfr = *(const LAS bf16x8*)(ab + ks * 64);
#pragma unroll
                for (int nb = 0; nb < 4; ++nb) { const bf16x8 wf = *(const bf16x8*)(wp + (size_t)nb * 16 * 512 + ks * 32); cacc[nb] = mfma16(wf, bfr, cacc[nb]); } } }
        }
        f32x4 pacc[4];
        for (int prep = 0; prep < ((PROBE_DUP & 256) ? 2 : 1); ++prep) {
#pragma unroll
        for (int i = 0; i < 4; ++i) pacc[i] = (f32x4){0.f, 0.f, 0.f, 0.f};
        { const int g = wave >> 1, nh = wave & 1;
            const bf16* wpt = wpool_t + (size_t)(g * 128 + 64 * nh + li) * 128 + 8 * fq; const bf16* psrc = proj + C_POOL + 128 * g + 8 * fq;
            if (g == 0) pool_group<2>(psrc, wpt, b, p0 + li, pacc); else if (g == 1) pool_group<4>(psrc, wpt, b, p0 + li, pacc); else if (g == 2) pool_group<8>(psrc, wpt, b, p0 + li, pacc); else pool_group<16>(psrc, wpt, b, p0 + li, pacc); }
        }
        f32x4 oa[2][4];
#pragma unroll
        for (int hh = 0; hh < 2; ++hh)
#pragma unroll
            for (int db = 0; db < 4; ++db) oa[hh][db] = *(const LAS f32x4*)(st + ((hh * 4 + db) * 64 + lane) * 16);
        float ssa = 0.f, ssp = 0.f, ssc = 0.f;
        { const int g = wave >> 1, nh = wave & 1;
#pragma unroll
            for (int nb = 0; nb < 4; ++nb) { const f32x4 sc = *(const f32x4*)(psc + 128 * g + 64 * nh + 16 * nb + 4 * fq); pacc[nb] = pacc[nb] * sc; ssp += dot4(pacc[nb]); ssc += dot4(cacc[nb]); ssa += dot4(oa[0][nb]) + dot4(oa[1][nb]); } }
        ssa += __shfl_xor(ssa, 16); ssa += __shfl_xor(ssa, 32); ssp += __shfl_xor(ssp, 16); ssp += __shfl_xor(ssp, 32); ssc += __shfl_xor(ssc, 16); ssc += __shfl_xor(ssc, 32);
        if (lane < 16) { red[wave * 16 + lane] = ssa; red[128 + wave * 16 + lane] = ssp; red[256 + wave * 16 + lane] = ssc; }
        __syncthreads();
        float ta = 0.f, tp = 0.f, tc = 0.f;
#pragma unroll
        for (int w8 = 0; w8 < 8; ++w8) { ta += red[w8 * 16 + li]; tp += red[128 + w8 * 16 + li]; tc += red[256 + w8 * 16 + li]; }
        const float ra = rsqrtf(ta * (1.0f / DATT) + EPS), rp = rsqrtf(tp * (1.0f / DPOOL) + EPS), rc = rsqrtf(tc * (1.0f / DCONV) + EPS);
        bf16* orow = merged + (size_t)rowidx(b, p0 + li) * DM;
#pragma unroll
        for (int hh = 0; hh < 2; ++hh)
#pragma unroll
            for (int db = 0; db < 4; ++db) { const int col = (2 * wave + hh) * 64 + 16 * db + 4 * fq; const f32x4 gv = *(const f32x4*)(mg + col); const f32x4 v = oa[hh][db] * ra * gv;
                v2u w2; w2.x = cvtpk(v.x, v.y); w2.y = cvtpk(v.z, v.w); *(v2u*)(orow + col) = w2; }
        { const int g = wave >> 1, nh = wave & 1;
#pragma unroll
            for (int nb = 0; nb < 4; ++nb) { const int col = DATT + 128 * g + 64 * nh + 16 * nb + 4 * fq; const f32x4 gv = *(const f32x4*)(mg + col); const f32x4 v = pacc[nb] * rp * gv;
                v2u w2; w2.x = cvtpk(v.x, v.y); w2.y = cvtpk(v.z, v.w); *(v2u*)(orow + col) = w2; } }
#pragma unroll
        for (int nb = 0; nb < 4; ++nb) { const int col = DATT + DPOOL + 64 * wave + 16 * nb + 4 * fq; const f32x4 gv = *(const f32x4*)(mg + col); const f32x4 v = cacc[nb] * rc * gv;
            v2u w2; w2.x = cvtpk(v.x, v.y); w2.y = cvtpk(v.z, v.w); *(v2u*)(orow + col) = w2; }
        __syncthreads();
    }
}

#define XB_TMO      128
#define XB_XCNT(j)  (256  + 64 * (j))
#define XB_XSUB(j)  (1280 + 64 * (j))
#define XB_XGEN(j)  (2304 + 64 * (j))
#define XB_TOP      3328
#define XB_TOPGEN   3392
#define XCD_BAR_WORDS 3456
#define XB_SPIN_CAP (1u << 18)

__device__ __forceinline__ unsigned xb_ld(unsigned* p)              { return __hip_atomic_load(p, __ATOMIC_RELAXED, __HIP_MEMORY_SCOPE_AGENT); }
__device__ __forceinline__ unsigned xb_add(unsigned* p, unsigned v) { return __hip_atomic_fetch_add(p, v, __ATOMIC_RELAXED, __HIP_MEMORY_SCOPE_AGENT); }
__device__ __forceinline__ unsigned xb_xcc_id() { return (unsigned)__builtin_amdgcn_s_getreg((3 << 11) | 20) & 0xFu; }
#define XB_SPIN(cond, bar) do { unsigned _sp = 0; while (cond) { __builtin_amdgcn_s_sleep(1); \
    if ((++_sp & 255u) == 0u) { if (xb_ld(&(bar)[XB_TMO])) break; if (_sp > XB_SPIN_CAP) { atomicAdd(&(bar)[XB_TMO], 1u); break; } } } } while (0)

struct XcdBarrier {
    unsigned* bar; unsigned x;
    volatile LAS unsigned* st;
};

__device__ __forceinline__ XcdBarrier xcd_barrier_post(unsigned* bar, volatile LAS unsigned* st) {
    XcdBarrier b; b.bar = bar; b.x = xb_xcc_id(); b.st = st;
    if (threadIdx.x == 0) (void)xb_add(&bar[XB_XCNT(b.x)], 1u);
    return b;
}
__device__ __forceinline__ void xcd_barrier_complete(unsigned* bar, unsigned x, unsigned& nloc, unsigned& nx) {
    const unsigned G = gridDim.x * gridDim.y * gridDim.z;
    unsigned sum, cnt, mine, sp = 0u;
    for (;;) {
        sum = 0u; cnt = 0u; mine = 0u;
#pragma unroll
        for (unsigned j = 0; j < 16; ++j) { const unsigned c = xb_ld(&bar[XB_XCNT(j)]); sum += c; cnt += (c > 0u) ? 1u : 0u; mine = (j == x) ? c : mine; }
        if (sum == G) break;
        __builtin_amdgcn_s_sleep(1);
        if ((++sp & 255u) == 0u) { if (xb_ld(&bar[XB_TMO])) break; if (sp > XB_SPIN_CAP) { atomicAdd(&bar[XB_TMO], 1u); break; } }
    }
    nloc = mine > 0u ? mine : 1u; nx = cnt > 0u ? cnt : 1u;
}

__device__ __forceinline__ void xcd_barrier(const XcdBarrier& b) {
    asm volatile("s_waitcnt vmcnt(0)" ::: "memory");
    __syncthreads();
    if (threadIdx.x == 0) {
        unsigned* bar = b.bar;
        __builtin_amdgcn_s_waitcnt(0);
        unsigned nloc = b.st[0], nx = b.st[1];
        if (nloc == 0u) { xcd_barrier_complete(bar, b.x, nloc, nx); b.st[0] = nloc; b.st[1] = nx; }
        const unsigned old = xb_add(&bar[XB_XSUB(b.x)], 1u);
        const unsigned gen = old / nloc;
        if (old + 1u == (gen + 1u) * nloc) {
            __builtin_amdgcn_fence(__ATOMIC_RELEASE, "agent");
            asm volatile("s_waitcnt vmcnt(0)" ::: "memory");
            const unsigned og = xb_add(&bar[XB_TOP], 1u);
            const unsigned tg = og / nx;
            if (og + 1u == (tg + 1u) * nx) xb_add(&bar[XB_TOPGEN], 1u);
            else XB_SPIN(xb_ld(&bar[XB_TOPGEN]) == tg, bar);
            __builtin_amdgcn_fence(__ATOMIC_ACQUIRE, "agent");
            xb_add(&bar[XB_XGEN(b.x)], 1u);
            asm volatile("s_waitcnt vmcnt(0)" ::: "memory");
        } else {
            XB_SPIN(xb_ld(&bar[XB_XGEN(b.x)]) == gen, bar);
            __builtin_amdgcn_fence(__ATOMIC_ACQUIRE, "agent");
            asm volatile("s_waitcnt vmcnt(0)" ::: "memory");
        }
    }
    __syncthreads();
}

constexpr int NPHASE = 1 + 7 * DEPTH;
#define PHASE_ENTER() int tid_ = threadIdx.x; asm volatile("" : "+v"(tid_)); const int tid = tid_, lane = tid & 63, wave = __builtin_amdgcn_readfirstlane(tid >> 6); \
    const __attribute__((address_space(4))) Args* ka_ = (const __attribute__((address_space(4))) Args*)__builtin_amdgcn_kernarg_segment_ptr(); asm volatile("" : "+s"(ka_)); Args A; __builtin_memcpy(&A, ka_, sizeof(Args)); \
    const int G = gridDim.x, gw = blockIdx.x * 8 + wave, NGW = G * 8; LAS float* scr = (LAS float*)(lds + wave * 16640); (void)tid; (void)lane; (void)gw; (void)NGW; (void)scr; (void)G;
__global__ void __launch_bounds__(512, 2) fwd_megakernel(Args args) {
    extern __shared__ __attribute__((aligned(16))) unsigned char lds_raw[];
    LAS unsigned char* lds = (LAS unsigned char*)lds_raw;
    cg::grid_group grid = cg::this_grid();
    const int lo = args.ph_lo, hi = args.ph_hi;
    volatile LAS unsigned* bst = (volatile LAS unsigned*)(lds + LDS_BYTES - 64);
    if (threadIdx.x < 16) bst[threadIdx.x] = 0u;
    __syncthreads();
    XcdBarrier bar = xcd_barrier_post((unsigned*)(args.ws + WS_CTL), bst);
#if !MK_SPLIT
    grid.sync();
#endif
#define IN(k) (lo <= (k) && (k) < hi)
#define SEAM(k) do { if (IN(k) && IN((k) + 1)) xcd_barrier(bar); } while (0)
    int k = 0;
    for (int rep = 0; rep < ((PROBE_DUP & 1) ? 2 : 1); ++rep) if (IN(k)) { if (rep) xcd_barrier(bar); PHASE_ENTER(); convert_p0_weights(A, scr, gw, NGW, lane); init_rows(A, gw, NGW, lane); }
    SEAM(k); ++k;
    for (int l = 0; l < DEPTH; ++l) {
        for (int rep = 0; rep < ((PROBE_DUP & 4) ? 2 : 1); ++rep) if (IN(k)) { if (rep) xcd_barrier(bar); PHASE_ENTER(); unsigned char* wsb = gptr(A.ws);
            pg8::Gemm g{(const bf16*)(wsb + WS_U), (const bf16*)(wsb + WS_WIN) + (size_t)l * DIN * DM, MR, DIN, DM}; pg8::StaticOrder S; S.init(MR, DIN, G, (int)blockIdx.x);
            pg8::EpiBf16<0> E{(bf16*)(wsb + WS_PROJ), DIN, nullptr, 1024, 1024, 0.125f};
            pg8::gemm_phase<pg8::EpiBf16<0>, pg8::StaticOrder, PG8_ALIGN, PG8_SP2>(lds, g, S, E);
            __syncthreads();
            { const int ex = ((MR / 256) * (DIN / 256)) % G, c = (int)blockIdx.x;
                if (ex == 0 || c >= ex) { const int c0 = ex == 0 ? 0 : ex, gw2 = (c - c0) * 8 + wave, n2 = (G - c0) * 8; convert_ffn_weights(A, l, scr, gw2, n2, lane); if (l == 0) convert_wout(A, 0, scr, gw2, n2, lane); } }
            __syncthreads(); skinny_gemm<0>((const bf16*)(wsb + WS_U) + (size_t)MR * DM, (const bf16*)(wsb + WS_WIN) + (size_t)l * DIN * DM, DIN, DM, (void*)(wsb + WS_PROJ), DIN, lds, lane, wave);
        }
        SEAM(k); ++k;
        for (int rep = 0; rep < ((PROBE_DUP & 2) ? 2 : 1); ++rep) if (IN(k)) { if (rep) xcd_barrier(bar); PHASE_ENTER(); mixer_phase(A, l, lds, tid, wave); }
        SEAM(k); ++k;
        for (int rep = 0; rep < ((PROBE_DUP & 16) ? 2 : 1); ++rep) if (IN(k)) { if (rep) xcd_barrier(bar); PHASE_ENTER(); unsigned char* wsb = gptr(A.ws);
            pg8::Gemm g{(const bf16*)(wsb + WS_MERGED), (const bf16*)(wsb + WS_WOUT) + (size_t)l * DM * DM, MR, DM, DM}; pg8::StaticOrder S; S.init(MR, DM, G, (int)blockIdx.x);
            pg8::EpiF32 E{(float*)(wsb + WS_OUT), DM};
            pg8::gemm_phase<pg8::EpiF32, pg8::StaticOrder, PG8_ALIGN, PG8_SP2>(lds, g, S, E);
            __syncthreads(); if (l + 1 < DEPTH) skinny_gemm<1>((const bf16*)(wsb + WS_MERGED) + (size_t)MR * DM, (const bf16*)(wsb + WS_WOUT) + (size_t)l * DM * DM, DM, DM, (void*)(wsb + WS_OUT), DM, lds, lane, wave);
        }
        SEAM(k); ++k;
        if (IN(k)) { PHASE_ENTER(); row_phase(A, A.post_mix_g + (size_t)l * DM, A.pre_ffn_g + (size_t)l * DM, nullptr, (l + 1 < DEPTH) ? MV : MR, gw, NGW, lane); }
        SEAM(k); ++k;
        for (int rep = 0; rep < ((PROBE_DUP & 32) ? 2 : 1); ++rep) if (IN(k)) { if (rep) xcd_barrier(bar); PHASE_ENTER(); unsigned char* wsb = gptr(A.ws);
            pg8::Gemm g{(const bf16*)(wsb + WS_U), (const bf16*)(wsb + WS_WGU), MR, 2 * DFF, DM}; pg8::StaticOrder S; S.init(MR, 2 * DFF, G, (int)blockIdx.x);
            pg8::EpiSwiGLU E{(bf16*)(wsb + WS_ACT), DFF};
            pg8::gemm_phase<pg8::EpiSwiGLU, pg8::StaticOrder, PG8_ALIGN, PG8_SP2>(lds, g, S, E);
            __syncthreads();
            if (l + 1 < DEPTH) { const int ex = ((MR / 256) * (2 * DFF / 256)) % G, c = (int)blockIdx.x;
                if (ex == 0 || c >= ex) { const int c0 = ex == 0 ? 0 : ex, gw2 = (c - c0) * 8 + wave, n2 = (G - c0) * 8; convert_win(A, l + 1, scr, gw2, n2, lane); convert_wout(A, l + 1, scr, gw2, n2, lane); } }
            __syncthreads(); if (l + 1 < DEPTH) skinny_gemm<2>((const bf16*)(wsb + WS_U) + (size_t)MR * DM, (const bf16*)(wsb + WS_WGU), 2 * DFF, DM, (void*)(wsb + WS_ACT), DFF, lds, lane, wave);
        }
        SEAM(k); ++k;
        for (int rep = 0; rep < ((PROBE_DUP & 8) ? 2 : 1); ++rep) if (IN(k)) { if (rep) xcd_barrier(bar); PHASE_ENTER(); unsigned char* wsb = gptr(A.ws);
            pg8::Gemm g{(const bf16*)(wsb + WS_ACT), (const bf16*)(wsb + WS_WD), MR, DM, DFF}; pg8::StaticOrder S; S.init(MR, DM, G, (int)blockIdx.x);
            pg8::EpiF32 E{(float*)(wsb + WS_OUT), DM};
            pg8::gemm_phase<pg8::EpiF32, pg8::StaticOrder, PG8_ALIGN, PG8_SP2>(lds, g, S, E);
            __syncthreads(); if (l + 1 < DEPTH) skinny_gemm<1>((const bf16*)(wsb + WS_ACT) + (size_t)MR * DFF, (const bf16*)(wsb + WS_WD), DM, DFF, (void*)(wsb + WS_OUT), DM, lds, lane, wave);
        }
        SEAM(k); ++k;
        if (IN(k)) { PHASE_ENTER();
            if (l + 1 < DEPTH) { row_phase(A, A.post_ffn_g + (size_t)l * DM, A.pre_mix_g + (size_t)(l + 1) * DM, nullptr, MV, gw, NGW, lane); }
            else row_phase(A, A.post_ffn_g + (size_t)l * DM, nullptr, A.out, MR, gw, NGW, lane);
        }
        if (l + 1 < DEPTH) { SEAM(k); } ++k;
    }
#undef IN
#undef SEAM
}

extern "C" void kernel_launch(void* const* d_in, const int* in_sizes, int n_in, void* d_out, int out_size, void* d_ws, size_t ws_size, hipStream_t stream) {
    static int grid = 0;
    if (grid == 0) {
        if (n_in != 19 || in_sizes[0] != MR * DM || out_size != MR * DM || ws_size < WS_END) { fprintf(stderr, "kernel_launch: unexpected problem (n_in %d, in0 %d, out %d, ws %zu, need %zu)\n", n_in, n_in > 0 ? in_sizes[0] : -1, out_size, ws_size, (size_t)WS_END); grid = -1; return; }
        int dev = 0, cus = 0, per_cu = 0;
        if (hipGetDevice(&dev) != hipSuccess || hipDeviceGetAttribute(&cus, hipDeviceAttributeMultiprocessorCount, dev) != hipSuccess) { grid = -1; return; }
        if (hipFuncSetAttribute((const void*)fwd_megakernel, hipFuncAttributeMaxDynamicSharedMemorySize, LDS_BYTES) != hipSuccess) { fprintf(stderr, "kernel_launch: hipFuncSetAttribute failed\n"); grid = -1; return; }
        if (hipOccupancyMaxActiveBlocksPerMultiprocessor(&per_cu, (const void*)fwd_megakernel, 512, LDS_BYTES) != hipSuccess || per_cu < 1) { fprintf(stderr, "kernel_launch: occupancy query says %d blocks per CU\n", per_cu); per_cu = 1; }
        (void)hipGetLastError();
        grid = cus;
    }
    if (grid < 0) return;
    if (hipMemsetAsync((unsigned char*)d_ws + WS_CTL, 0, CTL_BYTES, stream) != hipSuccess) { fprintf(stderr, "kernel_launch: hipMemsetAsync failed\n"); return; }
    Args a{};
    const float** ap = (const float**)&a;
    for (int i = 0; i < 19; ++i) ap[i] = (const float*)d_in[i];
    a.out = (float*)d_out; a.ws = (unsigned char*)d_ws;
#if MK_SPLIT
    for (int ph = 0; ph < NPHASE; ++ph) { a.ph_lo = ph; a.ph_hi = ph + 1; hipLaunchKernelGGL(fwd_megakernel, dim3(grid), dim3(512), LDS_BYTES, stream, a); }
#else
    a.ph_lo = 0; a.ph_hi = NPHASE;
    void* kargs[] = {(void*)&a};
    const hipError_t e = hipLaunchCooperativeKernel((const void*)fwd_megakernel, dim3(grid), dim3(512), kargs, LDS_BYTES, stream);
    if (e != hipSuccess) fprintf(stderr, "kernel_launch: cooperative launch failed: %s (grid %d)\n", hipGetErrorString(e), grid);
#endif
}
```

```cpp
#include <hip/hip_runtime.h>
#include <hip/hip_cooperative_groups.h>
#include <cstdio>
#include <cstdint>
namespace cg = cooperative_groups;
namespace pg8 {
#define PG8_LAS __attribute__((address_space(3)))
typedef unsigned short bf16_t;
typedef short bf16x8 __attribute__((ext_vector_type(8)));
typedef float f32x4 __attribute__((ext_vector_type(4)));
typedef unsigned u32x4 __attribute__((ext_vector_type(4)));
constexpr int BM = 256, BK = 64, HALF = 128, HTB = HALF * BK * 2  , STAGE_BYTES = 8 * HTB, NXCD = 8, WGM = 8;

__host__ __device__ __forceinline__ int lds_byte(int r, int c) { const int st = (r >> 4) * 2 + (c >> 5), rr = r & 15, cc = c & 31, ob = rr * 64 + cc * 2; return st * 1024 + (ob ^ (((ob >> 9) & 1) << 5)); }
__host__ __device__ __forceinline__ void stage_rc(int b, int& R, int& C) { const int st = b / 1024, sb = b % 1024, swz = sb ^ (((sb >> 9) & 1) << 5); R = (st >> 1) * 16 + swz / 64; C = (st & 1) * 32 + (swz % 64) / 2; }
__host__ __device__ __forceinline__ int perm32(int rho) { const int n = rho >> 4, i = rho & 15; return 8 * (i >> 2) + 4 * n + (i & 3); }

struct Unit { int pm, pn; };
struct Gemm { const bf16_t* A; const bf16_t* Bt; int M, N, K; };

struct StaticOrder {
    int nM, nN, nwg, G, c;
    __host__ __device__ void init(int M, int N, int G_, int c_) { nM = M / BM; nN = N / BM; nwg = nM * nN; G = G_; c = c_; }
    __host__ __device__ bool next(int i, Unit& u) const {
        const long L = (long)i * G + c; if (L >= nwg) return false;
        int wgid = (int)L; { const int q = nwg / NXCD, r = nwg % NXCD, xcd = wgid % NXCD, off = wgid / NXCD; wgid = (xcd < r ? xcd * (q + 1) : r * (q + 1) + (xcd - r) * q) + off; }
        const int nig = WGM * nN, gid = wgid / nig, fm = gid * WGM, gsz = (nM - fm) < WGM ? (nM - fm) : WGM;
        u.pm = fm + ((wgid % nig) % gsz); u.pn = (wgid % nig) / gsz; return true;
    }
    __device__ __forceinline__ void a_ready(const Unit&) const {}
    __device__ __forceinline__ void done(const Unit&) const {}
};

__device__ __forceinline__ unsigned cvt_pk_bf16(float lo, float hi) { unsigned r; asm volatile("v_cvt_pk_bf16_f32 %0, %1, %2" : "=v"(r) : "v"(lo), "v"(hi)); return r; }
typedef float f32x2 __attribute__((ext_vector_type(2)));
__device__ __forceinline__ f32x2 gelu_pk(f32x2 v) {
    const f32x2 av = __builtin_elementwise_abs(v), d = av * 0.2316418882f + 1.0f;
    f32x2 t; t.x = __builtin_amdgcn_rcpf(d.x); t.y = __builtin_amdgcn_rcpf(d.y);
    f32x2 q = t * 0.5307027145f + (-0.7265760135f); q = q * t + 0.7107068705f; q = q * t + (-0.142248368f); q = q * t + 0.127414796f; q = q * t;
    const f32x2 s = (v * v) * (-0.72134752044f);
    f32x2 e; e.x = __builtin_amdgcn_exp2f(s.x); e.y = __builtin_amdgcn_exp2f(s.y);
    const f32x2 m = v * (q * e), r = v - m;
    f32x2 o; o.x = v.x < 0.f ? m.x : r.x; o.y = v.y < 0.f ? m.y : r.y; return o;
}

template <int ACT  > struct EpiBf16 {
    static constexpr bool PERM = true, AFTER_DRAIN = false; static_assert(ACT == 0 || ACT == 1, "EpiBf16: ACT is 0 (none) or 1 (gelu_pk)");
    bf16_t* O; int ldc; const float* bias; int split_cols; size_t split_stride; float scale0;
    __device__ __forceinline__ void operator()(const f32x4 (&acc)[2][2][4][2], const Unit& u, int wr, int wc, int fr, int fq) const {
        const int row0 = u.pm * BM + wr * 64 + fr; int colt = u.pn * BM; bf16_t* base = O;
        float sc = 1.f; if (split_cols) { const int t = colt / split_cols; base += (size_t)t * split_stride; colt -= t * split_cols; if (t == 0) sc = scale0; }
        const int col0 = colt + wc * 32 + 8 * fq, bcol0 = u.pn * BM + wc * 32 + 8 * fq;
        f32x4 bv[2][2];
#pragma unroll
        for (int bj = 0; bj < 2; ++bj)
#pragma unroll
            for (int n = 0; n < 2; ++n) bv[bj][n] = bias ? *(const f32x4*)(bias + bcol0 + bj * HALF + 4 * n) : (f32x4){0.f, 0.f, 0.f, 0.f};
#pragma unroll
        for (int ai = 0; ai < 2; ++ai)
#pragma unroll
            for (int m = 0; m < 4; ++m) { bf16_t* rowp = base + (size_t)(row0 + ai * HALF + m * 16) * ldc + col0;
#pragma unroll
                for (int bj = 0; bj < 2; ++bj) { f32x4 v0 = acc[ai][bj][m][0] + bv[bj][0], v1 = acc[ai][bj][m][1] + bv[bj][1];
                    if (ACT == 1) { f32x2 a = gelu_pk((f32x2){v0[0], v0[1]}), b = gelu_pk((f32x2){v0[2], v0[3]}), c = gelu_pk((f32x2){v1[0], v1[1]}), d = gelu_pk((f32x2){v1[2], v1[3]});
                        v0 = (f32x4){a.x, a.y, b.x, b.y}; v1 = (f32x4){c.x, c.y, d.x, d.y}; }
                    v0 = v0 * sc; v1 = v1 * sc; u32x4 w; w.x = cvt_pk_bf16(v0[0], v0[1]); w.y = cvt_pk_bf16(v0[2], v0[3]); w.z = cvt_pk_bf16(v1[0], v1[1]); w.w = cvt_pk_bf16(v1[2], v1[3]);
                    *(u32x4*)(rowp + bj * HALF) = w; } }
    }
};
__device__ __forceinline__ unsigned cvtpk_rne(float lo, float hi) { typedef float f32x2_t __attribute__((ext_vector_type(2))); typedef __bf16 bf16x2_t __attribute__((ext_vector_type(2)));
    f32x2_t v = {lo, hi}; bf16x2_t b = __builtin_convertvector(v, bf16x2_t); return __builtin_bit_cast(unsigned, b); }
struct EpiF32 {
    static constexpr bool PERM = false, AFTER_DRAIN = false;
    float* O; int ldc;
    __device__ __forceinline__ void operator()(const f32x4 (&acc)[2][2][4][2], const Unit& u, int wr, int wc, int fr, int fq) const {
        const int row0 = u.pm * BM + wr * 64 + fr, col0 = u.pn * BM + wc * 32 + 4 * fq;
#pragma unroll
        for (int ai = 0; ai < 2; ++ai)
#pragma unroll
            for (int m = 0; m < 4; ++m) { float* rowp = O + (size_t)(row0 + ai * HALF + m * 16) * ldc + col0;
#pragma unroll
                for (int bj = 0; bj < 2; ++bj)
#pragma unroll
                    for (int n = 0; n < 2; ++n) *(f32x4*)(rowp + bj * HALF + n * 16) = acc[ai][bj][m][n]; }
    }
};
struct EpiSwiGLU {
    static constexpr bool PERM = true, AFTER_DRAIN = false;
    bf16_t* O; int ldc;
    __device__ __forceinline__ void operator()(const f32x4 (&acc)[2][2][4][2], const Unit& u, int wr, int wc, int fr, int fq) const {
        typedef unsigned u32x2 __attribute__((ext_vector_type(2)));
        const int row0 = u.pm * BM + wr * 64 + fr, col0 = u.pn * (BM / 2) + wc * 16 + 4 * fq;
#pragma unroll
        for (int ai = 0; ai < 2; ++ai)
#pragma unroll
            for (int m = 0; m < 4; ++m) { bf16_t* rowp = O + (size_t)(row0 + ai * HALF + m * 16) * ldc + col0;
#pragma unroll
                for (int bj = 0; bj < 2; ++bj) { const f32x4 g = acc[ai][bj][m][0], up = acc[ai][bj][m][1]; float a[4];
#pragma unroll
                    for (int e = 0; e < 4; ++e) a[e] = g[e] * __builtin_amdgcn_rcpf(1.0f + __builtin_amdgcn_exp2f(-1.4426950408889634f * g[e])) * up[e];
                    u32x2 w; w.x = cvtpk_rne(a[0], a[1]); w.y = cvtpk_rne(a[2], a[3]); *(u32x2*)(rowp + bj * (HALF / 2)) = w; } }
    }
};

template <class Epi, class Sched, bool ALIGN_EPI = false, bool SP2 = false>
__device__ __forceinline__ void gemm_phase(PG8_LAS unsigned char* lds, const Gemm g, const Sched& S, const Epi& E) {
    int tid_ = threadIdx.x; asm volatile("" : "+v"(tid_));
    const int tid = tid_, wid = __builtin_amdgcn_readfirstlane(tid >> 6), lane = tid & 63, wr = wid >> 2, wc = wid & 3, fr = lane & 15, fq = lane >> 4;
    const int K = g.K, nt = K / BK;
    unsigned voffA[2], voffB[2];
#pragma unroll
    for (int i = 0; i < 2; ++i) { int R, C; stage_rc(tid * 16 + i * 8192, R, C); const int Rb = Epi::PERM ? ((R & ~31) + perm32(R & 31)) : R;
        voffA[i] = (unsigned)(R * K + C) * 2u; voffB[i] = (unsigned)(Rb * K + C) * 2u; }
    const size_t kstep = (size_t)(BK * 2);
    const size_t hstep = (size_t)HALF * K * 2;
    const size_t tstep = 2 * hstep;
    const unsigned ldsw = (unsigned)wid * 1024u;
    const int aoff = lds_byte(wr * 64 + fr, fq * 8), boff = lds_byte(wc * 32 + fr, fq * 8);
#define PG8_SA(b, h) (((b) * 2 + (h)) * HTB)
#define PG8_SB(b, h) ((4 + (b) * 2 + (h)) * HTB)
#define PG8_STAGE(bufoff, gbase, voff) do { _Pragma("unroll") for (int _i = 0; _i < 2; ++_i) \
        __builtin_amdgcn_global_load_lds((const unsigned*)((const char*)(gbase) + (voff)[_i]), (PG8_LAS unsigned*)(lds + (bufoff) + ldsw + _i * 8192), 16, 0, 0); } while (0)
#define PG8_LDA(dst, b, h) do { _Pragma("unroll") for (int m = 0; m < 4; ++m) _Pragma("unroll") for (int k = 0; k < 2; ++k) dst[m][k] = *(const PG8_LAS bf16x8*)(lds + PG8_SA(b, h) + aoff + m * 2048 + k * 1024); } while (0)
#define PG8_LDB(dst, b, h) do { _Pragma("unroll") for (int n = 0; n < 2; ++n) _Pragma("unroll") for (int k = 0; k < 2; ++k) dst[n][k] = *(const PG8_LAS bf16x8*)(lds + PG8_SB(b, h) + boff + n * 2048 + k * 1024); } while (0)
#define PG8_MMA(ai, bj, At, Bt) do { __builtin_amdgcn_s_setprio(1); _Pragma("unroll") for (int m = 0; m < 4; ++m) _Pragma("unroll") for (int n = 0; n < 2; ++n) _Pragma("unroll") for (int k = 0; k < 2; ++k) \
        acc[ai][bj][m][n] = __builtin_amdgcn_mfma_f32_16x16x32_bf16(Bt[n][k], At[m][k], acc[ai][bj][m][n], 0, 0, 0); __builtin_amdgcn_s_setprio(0); } while (0)
#define PG8_WAIT_V(n) asm volatile("s_waitcnt vmcnt(" #n ")" ::: "memory")
#define PG8_WAIT_L(n) asm volatile("s_waitcnt lgkmcnt(" #n ")" ::: "memory")
#define PG8_BAR __builtin_amdgcn_s_barrier()
#define PG8_SCHED __builtin_amdgcn_sched_barrier(0)
    Unit cur, nxt; int ui = 0;
    if (!S.next(0, cur)) return;
    f32x4 acc[2][2][4][2];
#pragma unroll
    for (int a = 0; a < 2; ++a)
#pragma unroll
        for (int b = 0; b < 2; ++b)
#pragma unroll
            for (int m = 0; m < 4; ++m)
#pragma unroll
                for (int n = 0; n < 2; ++n) acc[a][b][m][n] = (f32x4){0.f, 0.f, 0.f, 0.f};
    bf16x8 At[4][2], B0[2][2], B1[2][2];
    const char* cA = (const char*)g.A + (size_t)cur.pm * tstep; const char* cB = (const char*)g.Bt + (size_t)cur.pn * tstep;
    S.a_ready(cur);
    if constexpr (SP2) {
        PG8_STAGE(PG8_SB(0, 0), cB, voffB); PG8_STAGE(PG8_SB(0, 1), cB + hstep, voffB); PG8_STAGE(PG8_SA(0, 0), cA, voffA); PG8_STAGE(PG8_SA(0, 1), cA + hstep, voffA);
        if (wr == 1) PG8_BAR;
        PG8_WAIT_V(2); PG8_BAR;
        PG8_STAGE(PG8_SB(1, 0), cB + kstep, voffB); PG8_STAGE(PG8_SA(1, 0), cA + kstep, voffA); PG8_STAGE(PG8_SB(1, 1), cB + hstep + kstep, voffB);
        PG8_WAIT_V(6); PG8_BAR;
    } else {
        PG8_STAGE(PG8_SB(0, 0), cB, voffB); PG8_STAGE(PG8_SA(0, 0), cA, voffA); PG8_STAGE(PG8_SB(0, 1), cB + hstep, voffB); PG8_STAGE(PG8_SA(0, 1), cA + hstep, voffA);
        if (wr == 1) PG8_BAR;
        PG8_WAIT_V(4); PG8_BAR;
        PG8_STAGE(PG8_SB(1, 0), cB + kstep, voffB); PG8_STAGE(PG8_SA(1, 0), cA + kstep, voffA); PG8_STAGE(PG8_SB(1, 1), cB + hstep + kstep, voffB);
        PG8_WAIT_V(6); PG8_BAR;
    }
    for (;;) {
        const bool has_next = S.next(ui + 1, nxt);
        const char* nA = has_next ? (const char*)g.A + (size_t)nxt.pm * tstep : cA; const char* nB = has_next ? (const char*)g.Bt + (size_t)nxt.pn * tstep : cB;
        for (int t = 0; t < nt; t += 2) {
            const bool last = (t == nt - 2);
            const char* a1 = cA + (size_t)(t + 1) * kstep;
            const char* a2 = last ? nA : cA + (size_t)(t + 2) * kstep; const char* b2 = last ? nB : cB + (size_t)(t + 2) * kstep;
            const char* a3 = a2 + kstep; const char* b3 = b2 + kstep;
            if (last && has_next) S.a_ready(nxt);
            if constexpr (SP2) {
            PG8_LDB(B0, 0, 0); PG8_LDB(B1, 0, 1); PG8_SCHED; PG8_LDA(At, 0, 0); PG8_STAGE(PG8_SA(1, 1), a1 + hstep, voffA);
            PG8_WAIT_V(8); PG8_WAIT_L(0); PG8_BAR; PG8_MMA(0, 0, At, B0); PG8_MMA(0, 1, At, B1); PG8_BAR; PG8_SCHED;
            PG8_LDA(At, 0, 1); PG8_STAGE(PG8_SB(0, 0), b2, voffB); PG8_STAGE(PG8_SB(0, 1), b2 + hstep, voffB); PG8_STAGE(PG8_SA(0, 0), a2, voffA);
            PG8_WAIT_V(8); PG8_WAIT_L(0); PG8_BAR; PG8_MMA(1, 0, At, B0); PG8_MMA(1, 1, At, B1); PG8_BAR; PG8_SCHED;
            PG8_LDB(B0, 1, 0); PG8_LDB(B1, 1, 1); PG8_SCHED; PG8_LDA(At, 1, 0); PG8_STAGE(PG8_SA(0, 1), a2 + hstep, voffA);
            PG8_WAIT_V(8); PG8_WAIT_L(0); PG8_BAR; PG8_MMA(0, 0, At, B0); PG8_MMA(0, 1, At, B1); PG8_BAR; PG8_SCHED;
            PG8_LDA(At, 1, 1); PG8_STAGE(PG8_SB(1, 0), b3, voffB); PG8_STAGE(PG8_SB(1, 1), b3 + hstep, voffB); PG8_STAGE(PG8_SA(1, 0), a3, voffA);
            PG8_WAIT_V(8); PG8_WAIT_L(0); PG8_BAR; PG8_MMA(1, 0, At, B0); PG8_MMA(1, 1, At, B1); PG8_BAR; PG8_SCHED;
            } else {
            PG8_LDB(B0, 0, 0); PG8_SCHED; PG8_LDA(At, 0, 0); PG8_STAGE(PG8_SA(1, 1), a1 + hstep, voffA);
            PG8_WAIT_L(8); PG8_BAR; PG8_WAIT_L(0); PG8_MMA(0, 0, At, B0); PG8_BAR; PG8_SCHED;
            PG8_LDB(B1, 0, 1); PG8_STAGE(PG8_SB(0, 0), b2, voffB);
            PG8_BAR; PG8_WAIT_L(0); PG8_MMA(0, 1, At, B1); PG8_BAR;
            PG8_LDA(At, 0, 1); PG8_STAGE(PG8_SA(0, 0), a2, voffA);
            PG8_BAR; PG8_WAIT_L(0); PG8_MMA(1, 0, At, B0); PG8_BAR; PG8_SCHED;
            PG8_STAGE(PG8_SB(0, 1), b2 + hstep, voffB);
            PG8_WAIT_V(6); PG8_BAR; PG8_MMA(1, 1, At, B1); PG8_BAR;
            PG8_LDB(B0, 1, 0); PG8_SCHED; PG8_LDA(At, 1, 0); PG8_STAGE(PG8_SA(0, 1), a2 + hstep, voffA);
            PG8_WAIT_L(8); PG8_BAR; PG8_WAIT_L(0); PG8_MMA(0, 0, At, B0); PG8_BAR; PG8_SCHED;
            PG8_LDB(B1, 1, 1); PG8_STAGE(PG8_SB(1, 0), b3, voffB);
            PG8_BAR; PG8_WAIT_L(0); PG8_MMA(0, 1, At, B1); PG8_BAR;
            PG8_LDA(At, 1, 1); PG8_STAGE(PG8_SA(1, 0), a3, voffA);
            PG8_BAR; PG8_WAIT_L(0); PG8_MMA(1, 0, At, B0); PG8_BAR; PG8_SCHED;
            PG8_STAGE(PG8_SB(1, 1), b3 + hstep, voffB);
            PG8_WAIT_V(6); PG8_BAR; PG8_MMA(1, 1, At, B1); PG8_BAR;
            }
        }
        if constexpr (ALIGN_EPI) { if (wr == 0) PG8_BAR; }
        if constexpr (!Epi::AFTER_DRAIN) { E(acc, cur, wr, wc, fr, fq); S.done(cur); }
        if (!has_next) break;
#pragma unroll
        for (int a = 0; a < 2; ++a)
#pragma unroll
            for (int b = 0; b < 2; ++b)
#pragma unroll
                for (int m = 0; m < 4; ++m)
#pragma unroll
                    for (int n = 0; n < 2; ++n) acc[a][b][m][n] = (f32x4){0.f, 0.f, 0.f, 0.f};
        cur = nxt; cA = nA; cB = nB; ++ui;
        if constexpr (ALIGN_EPI) { if (wr == 1) PG8_BAR; }
    }
    PG8_WAIT_V(0);
    if constexpr (!ALIGN_EPI) { if (wr == 0) PG8_BAR; }
    PG8_BAR;
    if constexpr (Epi::AFTER_DRAIN) { E.fused(acc, cur, wr, wc, fr, fq, lds, wid, lane); S.done(cur); }
#undef PG8_SA
#undef PG8_SB
#undef PG8_STAGE
#undef PG8_LDA
#undef PG8_LDB
#undef PG8_MMA
#undef PG8_WAIT_V
#undef PG8_WAIT_L
#undef PG8_BAR
#undef PG8_SCHED
}
}

#ifndef PG8_SP2
#define PG8_SP2 true
#endif
#ifndef PG8_ALIGN
#define PG8_ALIGN true
#endif
#ifndef PROBE_DUP
#define PROBE_DUP 0
#endif
#ifndef MK_SPLIT
#define MK_SPLIT 0
#endif

constexpr int NB = 2, SEQ = 4096, DM = 2048, NMETA = 16, LSEQ = SEQ + NMETA, DEPTH = 2;
constexpr int MR = NB * SEQ;
constexpr int MV = MR + NMETA;
constexpr int MP = 33 * 256;
constexpr int DIN = 4608, DFF = 5632, DATT = 1024, DPOOL = 512, DCONV = 512, NHEAD = 16;
constexpr int C_K = 1024, C_V = 2048, C_POOL = 3072, C_CA = 3584, C_CG = 4096;
constexpr float EPS = 1e-6f, LOG2E = 1.4426950408889634f, LN2 = 0.6931471805599453f;
constexpr float SB_EXIT = -104.0f;

constexpr size_t MiB = 1u << 20;
constexpr size_t WS_WIN = 0;
constexpr size_t WS_WOUT = WS_WIN + 36 * MiB;
constexpr size_t WS_WGU = WS_WOUT + 16 * MiB;
constexpr size_t WS_WD = WS_WGU + 44 * MiB;
constexpr size_t WS_WSM = WS_WD + 22 * MiB;
constexpr size_t WS_H = WS_WSM + 2 * MiB;
constexpr size_t WS_U = WS_H + 66 * MiB;
constexpr size_t WS_OUT = WS_U + 33 * MiB;
constexpr size_t WS_PROJ = WS_OUT + 66 * MiB;
constexpr size_t WS_MERGED = WS_PROJ + (size_t)MP * DIN * 2;
constexpr size_t WS_ACT = WS_PROJ;
constexpr size_t WS_CTL = WS_MERGED + 33 * MiB;
constexpr size_t CTL_BYTES = 65536;
constexpr size_t WS_END = WS_CTL + 1 * MiB;
static_assert((size_t)MP * DFF * 2 <= WS_END - WS_PROJ, "act overlay");

constexpr int LDS_BYTES = 147456;

#define GAS __attribute__((address_space(1)))
#define LAS __attribute__((address_space(3)))
typedef unsigned short bf16;
typedef unsigned v4u __attribute__((ext_vector_type(4)));
typedef unsigned v2u __attribute__((ext_vector_type(2)));
typedef float f32x4 __attribute__((ext_vector_type(4)));
typedef short bf16x8 __attribute__((ext_vector_type(8)));
typedef short v4i16_t __attribute__((ext_vector_type(4)));
#define LDS_WAIT() asm volatile("s_waitcnt lgkmcnt(0)" ::: "memory")

__device__ __forceinline__ unsigned cvtpk(float lo, float hi) { return pg8::cvtpk_rne(lo, hi); }
__device__ __forceinline__ float bflo(unsigned u) { return __uint_as_float(u << 16); }
__device__ __forceinline__ float bfhi(unsigned u) { return __uint_as_float(u & 0xffff0000u); }
__device__ __forceinline__ float bf2f(bf16 v) { return __uint_as_float((unsigned)v << 16); }
__device__ __forceinline__ float wave_sum(float v) {
#pragma unroll
    for (int o = 1; o < 64; o <<= 1) v += __shfl_xor(v, o);
    return v;
}
__device__ __forceinline__ float sigmoidf_(float x) { return __builtin_amdgcn_rcpf(1.0f + __builtin_amdgcn_exp2f(-LOG2E * x)); }
template <class T> __device__ __forceinline__ T* gptr(T* p) { GAS T* g = (GAS T*)p; asm volatile("" : "+s"(g)); return (T*)g; }
__device__ __forceinline__ int rowidx(int b, int pos) { return pos < NMETA ? MR + pos : b * SEQ + pos - NMETA; }
__device__ __forceinline__ f32x4 mfma16(bf16x8 a, bf16x8 b, f32x4 c) { return __builtin_amdgcn_mfma_f32_16x16x32_bf16(a, b, c, 0, 0, 0); }

struct Args {
    const float *x, *meta, *pre_mix_g, *w_in, *w_pool, *pool_scale, *w_dw, *b_dw, *conv_ln_g, *conv_ln_b, *w_pw, *mix_out_g, *w_out, *post_mix_g, *pre_ffn_g, *w_gate, *w_up, *w_down, *post_ffn_g;
    float* out; unsigned char* ws; int ph_lo, ph_hi;
};

__device__ __forceinline__ void transpose_item(const float* __restrict__ W, int K, int N, bf16* WT, int mode, LAS float* scr, int item, int lane) {
    W = gptr(W); WT = gptr(WT);
    const int nblk = N >> 6, kb = item / nblk, nb = item - kb * nblk, k0 = kb << 6, n0 = nb << 6;
    const int r4 = lane >> 4, c4 = (lane & 15) * 4;
    f32x4 tv[16];
#pragma unroll
    for (int i = 0; i < 16; ++i) tv[i] = *(const f32x4*)(W + (size_t)(k0 + 4 * i + r4) * N + n0 + c4);
#pragma unroll
    for (int i = 0; i < 16; ++i) { LAS float* s = scr + (4 * i + r4) * 65 + c4; s[0] = tv[i].x; s[1] = tv[i].y; s[2] = tv[i].z; s[3] = tv[i].w; }
    LDS_WAIT();
    const int c = lane & 7;
#pragma unroll
    for (int j = 0; j < 8; ++j) { const int n = (lane >> 3) + 8 * j; const LAS float* s = scr + (8 * c) * 65 + n;
        v4u o; o.x = cvtpk(s[0 * 65], s[1 * 65]); o.y = cvtpk(s[2 * 65], s[3 * 65]); o.z = cvtpk(s[4 * 65], s[5 * 65]); o.w = cvtpk(s[6 * 65], s[7 * 65]);
        const int ng = n0 + n; const int R = mode == 0 ? ng : ((ng >> 2) * 8 + (ng & 3) + (mode == 2 ? 4 : 0));
        *(v4u*)(WT + (size_t)R * K + k0 + 8 * c) = o; }
    LDS_WAIT();
}
#define TJOB(Wp, Kk, Nn, WTp, mode) { const int ni_ = ((Kk) / 64) * ((Nn) / 64); if (r < ni_) { transpose_item((Wp), (Kk), (Nn), (WTp), (mode), scr, r, lane); continue; } r -= ni_; }

__device__ __forceinline__ void convert_ffn_weights(const Args& A, int l, LAS float* scr, int gw, int NGW, int lane) {
    bf16* wgu = (bf16*)(A.ws + WS_WGU); bf16* wd = (bf16*)(A.ws + WS_WD);
    constexpr int NI = 3 * (DM / 64) * (DFF / 64);
    for (int it = gw; it < NI; it += NGW) { int r = it;
        TJOB(A.w_gate + (size_t)l * DM * DFF, DM, DFF, wgu, 1)
        TJOB(A.w_up + (size_t)l * DM * DFF, DM, DFF, wgu, 2)
        TJOB(A.w_down + (size_t)l * DFF * DM, DFF, DM, wd, 0)
    }
}
__device__ __forceinline__ void convert_p0_weights(const Args& A, LAS float* scr, int gw, int NGW, int lane) {
    constexpr int I_IN = (DM / 64) * (DIN / 64), I_PW = 64, I_POOL = 16, NI = I_IN + DEPTH * (I_PW + I_POOL);
    for (int it = gw; it < NI; it += NGW) { int r = it;
        if (r < I_IN) { transpose_item(A.w_in, DM, DIN, (bf16*)(A.ws + WS_WIN), 0, scr, r, lane); continue; } r -= I_IN;
        const int l = r / (I_PW + I_POOL); r -= l * (I_PW + I_POOL);
        if (r < I_PW) { transpose_item(A.w_pw + (size_t)l * 512 * 512, 512, 512, (bf16*)(A.ws + WS_WSM + 256 * 1024) + (size_t)l * 512 * 512, 0, scr, r, lane); continue; } r -= I_PW;
        { const int g = r >> 2; transpose_item(A.w_pool + (size_t)(l * 4 + g) * 128 * 128, 128, 128, (bf16*)(A.ws + WS_WSM) + (size_t)(l * 4 + g) * 128 * 128, 0, scr, r & 3, lane); }
    }
}
__device__ __forceinline__ void convert_wout(const Args& A, int l, LAS float* scr, int gw, int NGW, int lane) {
    constexpr int NI = (DM / 64) * (DM / 64);
    for (int it = gw; it < NI; it += NGW) transpose_item(A.w_out + (size_t)l * DM * DM, DM, DM, (bf16*)(A.ws + WS_WOUT) + (size_t)l * DM * DM, 0, scr, it, lane);
}
__device__ __forceinline__ void convert_win(const Args& A, int l, LAS float* scr, int gw, int NGW, int lane) {
    constexpr int NI = (DM / 64) * (DIN / 64);
    for (int it = gw; it < NI; it += NGW) transpose_item(A.w_in + (size_t)l * DM * DIN, DM, DIN, (bf16*)(A.ws + WS_WIN) + (size_t)l * DIN * DM, 0, scr, it, lane);
}

__device__ __forceinline__ float dot4(f32x4 a) { return (a.x * a.x + a.y * a.y) + (a.z * a.z + a.w * a.w); }
__device__ __forceinline__ void store_u_row(bf16* urow, const f32x4 (&hv)[8], float r, const float* g, int lane) {
#pragma unroll
    for (int j = 0; j < 8; ++j) { const f32x4 gv = ((const f32x4*)g)[lane + 64 * j]; v2u w; w.x = cvtpk(hv[j].x * r * gv.x, hv[j].y * r * gv.y); w.y = cvtpk(hv[j].z * r * gv.z, hv[j].w * r * gv.w);
        ((v2u*)urow)[lane + 64 * j] = w; }
}
__device__ __forceinline__ void init_rows(const Args& A, int gw, int NGW, int lane) {
    unsigned char* wsb = gptr(A.ws); float* h = (float*)(wsb + WS_H); bf16* u = (bf16*)(wsb + WS_U); const float* pg = gptr(A.pre_mix_g);
    for (int m = gw; m < MV; m += NGW) {
        const float* src = m < MR ? gptr(A.x) + (size_t)m * DM : gptr(A.meta) + (size_t)(m - MR) * DM;
        f32x4 hv[8]; float ss = 0.f;
#pragma unroll
        for (int j = 0; j < 8; ++j) { hv[j] = ((const f32x4*)src)[lane + 64 * j]; ss += dot4(hv[j]); ((f32x4*)(h + (size_t)m * DM))[lane + 64 * j] = hv[j]; }
        const float r = rsqrtf(wave_sum(ss) * (1.0f / DM) + EPS);
        store_u_row(u + (size_t)m * DM, hv, r, pg, lane);
    }
}
__device__ __forceinline__ void row_phase(const Args& A, const float* g1, const float* g2, float* dout, int nrows, int gw, int NGW, int lane) {
    unsigned char* wsb = gptr(A.ws); float* h = (float*)(wsb + WS_H); bf16* u = (bf16*)(wsb + WS_U); const float* src = (const float*)(wsb + WS_OUT); g1 = gptr(g1); g2 = gptr(g2); dout = gptr(dout);
    for (int m0 = gw; m0 < nrows; m0 += 2 * NGW) {
        const int m1 = m0 + NGW; const bool two = m1 < nrows; const int mb = two ? m1 : m0;
        f32x4 oA[8], hA[8], oB[8], hB[8]; float ssA = 0.f, ssB = 0.f;
#pragma unroll
        for (int j = 0; j < 8; ++j) { oA[j] = ((const f32x4*)(src + (size_t)m0 * DM))[lane + 64 * j]; hA[j] = ((const f32x4*)(h + (size_t)m0 * DM))[lane + 64 * j]; }
#pragma unroll
        for (int j = 0; j < 8; ++j) { oB[j] = ((const f32x4*)(src + (size_t)mb * DM))[lane + 64 * j]; hB[j] = ((const f32x4*)(h + (size_t)mb * DM))[lane + 64 * j]; }
#pragma unroll
        for (int j = 0; j < 8; ++j) { ssA += dot4(oA[j]); ssB += dot4(oB[j]); }
        const float rA = rsqrtf(wave_sum(ssA) * (1.0f / DM) + EPS), rB = rsqrtf(wave_sum(ssB) * (1.0f / DM) + EPS);
        float s2A = 0.f, s2B = 0.f;
#pragma unroll
        for (int j = 0; j < 8; ++j) { const f32x4 gv = ((const f32x4*)g1)[lane + 64 * j]; hA[j] = hA[j] + oA[j] * rA * gv; hB[j] = hB[j] + oB[j] * rB * gv; s2A += dot4(hA[j]); s2B += dot4(hB[j]); }
        if (dout) {
            if (m0 < MR) {
#pragma unroll
                for (int j = 0; j < 8; ++j) ((f32x4*)(dout + (size_t)m0 * DM))[lane + 64 * j] = hA[j];
            }
            if (two && m1 < MR) {
#pragma unroll
                for (int j = 0; j < 8; ++j) ((f32x4*)(dout + (size_t)m1 * DM))[lane + 64 * j] = hB[j];
            }
        } else {
#pragma unroll
            for (int j = 0; j < 8; ++j) ((f32x4*)(h + (size_t)m0 * DM))[lane + 64 * j] = hA[j];
            if (two) {
#pragma unroll
                for (int j = 0; j < 8; ++j) ((f32x4*)(h + (size_t)m1 * DM))[lane + 64 * j] = hB[j];
            }
            const float r2A = rsqrtf(wave_sum(s2A) * (1.0f / DM) + EPS), r2B = rsqrtf(wave_sum(s2B) * (1.0f / DM) + EPS);
            store_u_row(u + (size_t)m0 * DM, hA, r2A, g2, lane);
            if (two) store_u_row(u + (size_t)m1 * DM, hB, r2B, g2, lane);
        }
    }
}

template <int MODE> __device__ __forceinline__ void skinny_gemm(const bf16* __restrict__ Arows, const bf16* __restrict__ Bt, int N, int K, void* O, int ldc, LAS unsigned char* lds, int lane, int wave) {
    const int li = lane & 15, fq = lane >> 4; const int nks = K >> 5;
    LAS f32x4* part = (LAS f32x4*)lds;
    for (int blk = blockIdx.x; blk < (N >> 4); blk += gridDim.x) {
        const bf16* bp = Bt + (size_t)(blk * 16 + li) * K + 8 * fq; const bf16* ap = Arows + (size_t)li * K + 8 * fq;
        f32x4 acc = (f32x4){0.f, 0.f, 0.f, 0.f};
#pragma unroll 8
        for (int ks = wave; ks < nks; ks += 8) { const bf16x8 wf = *(const bf16x8*)(bp + ks * 32); const bf16x8 af = *(const bf16x8*)(ap + ks * 32); acc = mfma16(wf, af, acc); }
        part[wave * 64 + lane] = acc;
        __syncthreads();
        if (wave == 0) {
            f32x4 v = part[lane];
#pragma unroll
            for (int w8 = 1; w8 < 8; ++w8) v = v + part[w8 * 64 + lane];
            const int n0 = blk * 16 + 4 * fq;
            if (MODE == 0) { const float sc = n0 < 1024 ? 0.125f : 1.0f; v2u w; w.x = cvtpk(v.x * sc, v.y * sc); w.y = cvtpk(v.z * sc, v.w * sc); *(v2u*)((bf16*)O + (size_t)(MR + li) * ldc + n0) = w; }
            else if (MODE == 1) { *(f32x4*)((float*)O + (size_t)(MR + li) * ldc + n0) = v; }
            else { f32x4 up; up.x = __shfl_xor(v.x, 16); up.y = __shfl_xor(v.y, 16); up.z = __shfl_xor(v.z, 16); up.w = __shfl_xor(v.w, 16);
                if ((fq & 1) == 0) { v2u w; w.x = cvtpk(v.x * sigmoidf_(v.x) * up.x, v.y * sigmoidf_(v.y) * up.y); w.y = cvtpk(v.z * sigmoidf_(v.z) * up.z, v.w * sigmoidf_(v.w) * up.w);
                    *(v2u*)((bf16*)O + (size_t)(MR + li) * ldc + blk * 8 + 4 * (fq >> 1)) = w; } }
        }
        __syncthreads();
    }
}

constexpr int VPITCH = 128;
constexpr int ML_V = 0, ML_ST = 8 * 64 * VPITCH  , ML_RED = ML_ST + 65536, ML_Y = 0  , ML_AB = ML_Y + 16 * 516 * 4;
static_assert(ML_RED + 3 * 512 <= LDS_BYTES && ML_AB + 16 * 1040 <= ML_ST, "mixer LDS");

__device__ __forceinline__ float softplus_(float z) { const float t = __builtin_amdgcn_exp2f(-LOG2E * __builtin_fabsf(z)); return __builtin_fmaxf(z, 0.f) + LN2 * __builtin_amdgcn_logf(1.0f + t); }
__device__ __forceinline__ void split_pack(const f32x4& a, const f32x4& b, bf16x8& hi, bf16x8& lo) {
    v4u h, l;
    h.x = cvtpk(a[0], a[1]); h.y = cvtpk(a[2], a[3]); h.z = cvtpk(b[0], b[1]); h.w = cvtpk(b[2], b[3]);
    l.x = cvtpk(a[0] - bflo(h.x), a[1] - bfhi(h.x)); l.y = cvtpk(a[2] - bflo(h.y), a[3] - bfhi(h.y));
    l.z = cvtpk(b[0] - bflo(h.z), b[1] - bfhi(h.z)); l.w = cvtpk(b[2] - bflo(h.w), b[3] - bfhi(h.w));
    hi = __builtin_bit_cast(bf16x8, h); lo = __builtin_bit_cast(bf16x8, l);
}
__device__ __forceinline__ void sb_attention(const bf16* __restrict__ proj, int b, int p0, int hd, LAS unsigned char* vl, int lane, f32x4 (&o)[4]) {
    const int li = lane & 15, fq = lane >> 4;
    const int qpos = p0 + li;
    const bf16* qp = proj + (size_t)rowidx(b, qpos) * DIN + hd * 64 + fq * 8;
    const bf16x8 qf0 = *(const bf16x8*)qp, qf1 = *(const bf16x8*)(qp + 32);
    unsigned d0 = 0u, d1 = 0u;
    { const unsigned one = 0x3F80u; d0 = ((4 * fq + 0 >= li) ? one : 0u) | ((4 * fq + 1 >= li) ? (one << 16) : 0u); d1 = ((4 * fq + 2 >= li) ? one : 0u) | ((4 * fq + 3 >= li) ? (one << 16) : 0u); }
    const unsigned ONE2 = 0x3F803F80u;
    const bf16x8 F_D1 = __builtin_bit_cast(bf16x8, (v4u){d0, d1, ONE2, ONE2});
    const bf16x8 F_11 = __builtin_bit_cast(bf16x8, (v4u){ONE2, ONE2, ONE2, ONE2});
    const bf16x8 F_0D = __builtin_bit_cast(bf16x8, (v4u){0u, 0u, d0, d1});
#pragma unroll
    for (int i = 0; i < 4; ++i) o[i] = (f32x4){0.f, 0.f, 0.f, 0.f};
    float carry = 0.f;
    const int ktd = p0 >> 6, kbmax = (p0 & 63) >> 4;
    const unsigned trbase = (unsigned)((4 * fq + (li >> 2)) * VPITCH + (lane & 3) * 8);
    bf16x8 kf[4][2];
#define SB_LOADK(KT) do { _Pragma("unroll") for (int kb = 0; kb < 4; ++kb) { int kp = 64 * (KT) + 16 * kb + li; kp = kp < LSEQ ? kp : LSEQ - 1; const bf16* kr = proj + (size_t)rowidx(b, kp) * DIN + C_K + hd * 64 + fq * 8; \
        kf[kb][0] = *(const bf16x8*)kr; kf[kb][1] = *(const bf16x8*)(kr + 32); } } while (0)
    SB_LOADK(ktd);
    for (int kt = ktd; kt >= 0; --kt) {
        const bool diag = (kt == ktd);
        f32x4 s[4], lnb[4];
#pragma unroll
        for (int kb = 0; kb < 4; ++kb) { s[kb] = mfma16(kf[kb][0], qf0, (f32x4){0.f, 0.f, 0.f, 0.f}); s[kb] = mfma16(kf[kb][1], qf1, s[kb]); }
#pragma unroll
        for (int it = 0; it < 8; ++it) { const int key = it * 8 + (lane >> 3); int kp = 64 * kt + key; kp = kp < LSEQ ? kp : LSEQ - 1;
            __builtin_amdgcn_global_load_lds((const unsigned*)(proj + (size_t)rowidx(b, kp) * DIN + C_V + hd * 64 + (lane & 7) * 8), (LAS unsigned*)(vl + it * 1024), 16, 0, 0); }
        { const int ktn = kt > 0 ? kt - 1 : 0; SB_LOADK(ktn); }
        __builtin_amdgcn_sched_barrier(0);
#pragma unroll
        for (int kb = 0; kb < 4; ++kb)
#pragma unroll
            for (int e = 0; e < 4; ++e) { const bool m = !diag || (64 * kt + 16 * kb + 4 * fq + e < qpos); lnb[kb][e] = (diag && kb > kbmax) ? 0.f : (m ? -softplus_(s[kb][e]) : 0.f); }
        bf16x8 bh[2], bl[2];
        split_pack(lnb[0], lnb[1], bh[0], bl[0]); split_pack(lnb[2], lnb[3], bh[1], bl[1]);
        f32x4 c[4];
#pragma unroll
        for (int i = 0; i < 4; ++i) c[i] = (f32x4){carry, carry, carry, carry};
        c[0] = mfma16(F_D1, bh[0], c[0]); c[0] = mfma16(F_D1, bl[0], c[0]); c[0] = mfma16(F_11, bh[1], c[0]); c[0] = mfma16(F_11, bl[1], c[0]);
        c[1] = mfma16(F_0D, bh[0], c[1]); c[1] = mfma16(F_0D, bl[0], c[1]); c[1] = mfma16(F_11, bh[1], c[1]); c[1] = mfma16(F_11, bl[1], c[1]);
        c[2] = mfma16(F_D1, bh[1], c[2]); c[2] = mfma16(F_D1, bl[1], c[2]);
        c[3] = mfma16(F_0D, bh[1], c[3]); c[3] = mfma16(F_0D, bl[1], c[3]);
        f32x4 w[4];
#pragma unroll
        for (int kb = 0; kb < 4; ++kb)
#pragma unroll
            for (int e = 0; e < 4; ++e) { const bool m = !diag || (64 * kt + 16 * kb + 4 * fq + e < qpos); w[kb][e] = (diag && kb > kbmax) ? 0.f : (m ? __builtin_amdgcn_exp2f(LOG2E * (s[kb][e] + c[kb][e])) : 0.f); }
        carry = __shfl(c[0][0], li);
        v4u p0v, p1v;
        p0v.x = cvtpk(w[0][0], w[0][1]); p0v.y = cvtpk(w[0][2], w[0][3]); p0v.z = cvtpk(w[1][0], w[1][1]); p0v.w = cvtpk(w[1][2], w[1][3]);
        p1v.x = cvtpk(w[2][0], w[2][1]); p1v.y = cvtpk(w[2][2], w[2][3]); p1v.z = cvtpk(w[3][0], w[3][1]); p1v.w = cvtpk(w[3][2], w[3][3]);
        const bf16x8 pf0 = __builtin_bit_cast(bf16x8, p0v), pf1 = __builtin_bit_cast(bf16x8, p1v);
        __builtin_amdgcn_sched_barrier(0);
        asm volatile("s_waitcnt vmcnt(0)" ::: "memory");
#pragma unroll
        for (int db = 0; db < 4; ++db) {
#pragma unroll
            for (int s2 = 0; s2 < 2; ++s2) {
                const v4i16_t lo = __builtin_amdgcn_ds_read_tr16_b64_v4i16((LAS v4i16_t*)(vl + trbase + (32 * s2) * VPITCH + db * 32));
                const v4i16_t hi = __builtin_amdgcn_ds_read_tr16_b64_v4i16((LAS v4i16_t*)(vl + trbase + (32 * s2 + 16) * VPITCH + db * 32));
                const bf16x8 vf = (bf16x8){lo[0], lo[1], lo[2], lo[3], hi[0], hi[1], hi[2], hi[3]};
                o[db] = mfma16(vf, s2 == 0 ? pf0 : pf1, o[db]);
            }
        }
        if (__all(carry < SB_EXIT)) break;
    }
#undef SB_LOADK
}

template <int W> __device__ __forceinline__ void pool_group(const bf16* __restrict__ psrc, const bf16* __restrict__ wpt, int b, int pos, f32x4 (&pacc)[4]) {
    const int cnt = (pos + 1 < W) ? pos + 1 : W; const float inv = 1.0f / (float)cnt;
    constexpr int BW = W;
#pragma unroll 1
    for (int ks = 0; ks < 4; ++ks) {
        bf16x8 wf[4];
#pragma unroll
        for (int nb = 0; nb < 4; ++nb) wf[nb] = *(const bf16x8*)(wpt + (size_t)nb * 16 * 128 + 32 * ks);
        float sum[8], self[8];
#pragma unroll
        for (int e = 0; e < 8; ++e) { sum[e] = 0.f; self[e] = 0.f; }
#pragma unroll
        for (int j0 = 0; j0 < W; j0 += BW) {
            v4u v[BW];
#pragma unroll
            for (int j = 0; j < BW; ++j) { const int pp = pos - j0 - j; v[j] = *(const v4u*)(psrc + (size_t)rowidx(b, pp >= 0 ? pp : 0) * DIN + 32 * ks); }
#pragma unroll
            for (int j = 0; j < BW; ++j) { const float f = (pos - j0 - j) >= 0 ? 1.0f : 0.0f;
                sum[0] += f * bflo(v[j].x); sum[1] += f * bfhi(v[j].x); sum[2] += f * bflo(v[j].y); sum[3] += f * bfhi(v[j].y);
                sum[4] += f * bflo(v[j].z); sum[5] += f * bfhi(v[j].z); sum[6] += f * bflo(v[j].w); sum[7] += f * bfhi(v[j].w); }
            if (j0 == 0) { self[0] = bflo(v[0].x); self[1] = bfhi(v[0].x); self[2] = bflo(v[0].y); self[3] = bfhi(v[0].y); self[4] = bflo(v[0].z); self[5] = bfhi(v[0].z); self[6] = bflo(v[0].w); self[7] = bfhi(v[0].w); }
            if (j0 + BW < W) __builtin_amdgcn_sched_barrier(0);
        }
        v4u pk; pk.x = cvtpk(sum[0] * inv - self[0], sum[1] * inv - self[1]); pk.y = cvtpk(sum[2] * inv - self[2], sum[3] * inv - self[3]);
        pk.z = cvtpk(sum[4] * inv - self[4], sum[5] * inv - self[5]); pk.w = cvtpk(sum[6] * inv - self[6], sum[7] * inv - self[7]);
        const bf16x8 pf = __builtin_bit_cast(bf16x8, pk);
#pragma unroll
        for (int nb = 0; nb < 4; ++nb) pacc[nb] = mfma16(wf[nb], pf, pacc[nb]);
    }
}

__device__ __forceinline__ void mixer_phase(const Args& A, int l, LAS unsigned char* lds, int tid0, int wave) {
    unsigned char* wsb = gptr(A.ws);
    const bf16* proj = (const bf16*)(wsb + WS_PROJ); bf16* merged = (bf16*)(wsb + WS_MERGED);
    const bf16* wpool_t = (const bf16*)(wsb + WS_WSM) + (size_t)l * 4 * 128 * 128;
    const bf16* wpw_t = (const bf16*)(wsb + WS_WSM + 256 * 1024) + (size_t)l * 512 * 512;
    const float* wdw = gptr(A.w_dw) + (size_t)l * 31 * 512; const float* bdw = gptr(A.b_dw) + l * 512; const float* lng = gptr(A.conv_ln_g) + l * 512; const float* lnb_ = gptr(A.conv_ln_b) + l * 512;
    const float* psc = gptr(A.pool_scale) + l * 512; const float* mg = gptr(A.mix_out_g) + (size_t)l * DM;
    LAS float* Y = (LAS float*)(lds + ML_Y); LAS unsigned short* Ab = (LAS unsigned short*)(lds + ML_AB); LAS float* red = (LAS float*)(lds + ML_RED);
    LAS unsigned char* vl = lds + ML_V + wave * (64 * VPITCH); LAS unsigned char* st = lds + ML_ST + wave * 8192;
    const int nunits = (l + 1 < DEPTH) ? 513 : 512;
    const int vcu = (gridDim.x % 8 == 0) ? ((int)blockIdx.x % 8) * ((int)gridDim.x / 8) + (int)blockIdx.x / 8 : (int)blockIdx.x;
    for (int ui = vcu; ui < nunits; ui += gridDim.x) {
        int ti = ui;
        if (gridDim.x == 256 && ui < 512) { const int w = ui & 255, rnd = ui >> 8; ti = 256 * (w >> 7) + (rnd == 0 ? 128 : 0) + (w & 127); }
        int b, p0; if (ti < 512) { b = ti >> 8; p0 = 16 + 16 * (ti & 255); } else { b = 0; p0 = 0; }
        int tid_l = tid0; asm volatile("" : "+v"(tid_l));
        const int tid = tid_l, lane = tid & 63, li = lane & 15, fq = lane >> 4;
#pragma unroll 1
        for (int hh = 0; hh < ((PROBE_DUP & 64) ? 4 : 2); ++hh) { f32x4 o0[4];
            sb_attention(proj, b, p0, 2 * wave + (hh & 1), vl, lane, o0);
#pragma unroll
            for (int db = 0; db < 4; ++db) *(LAS f32x4*)(st + (((hh & 1) * 4 + db) * 64 + lane) * 16) = o0[db]; }
        __syncthreads();
        f32x4 cacc[4];
        for (int crep = 0; crep < ((PROBE_DUP & 128) ? 2 : 1); ++crep) {
            if (crep) __syncthreads();
        {
            const int c = tid;
            unsigned short ra[46], rg[46];
#pragma unroll
            for (int r = 0; r < 46; ++r) { const int pos = p0 - 30 + r; ra[r] = 0; rg[r] = 0;
                if (pos >= 0) { const bf16* rp = proj + (size_t)rowidx(b, pos) * DIN + C_CA; ra[r] = rp[c]; rg[r] = rp[512 + c]; } }
            __builtin_amdgcn_sched_barrier(0);
            float glu[46];
#pragma unroll
            for (int r = 0; r < 46; ++r) glu[r] = bf2f(ra[r]) * sigmoidf_(bf2f(rg[r]));
            const float* wdc = wdw + c; asm volatile("" : "+v"(wdc));
            float y[16]; const float bias = bdw[c];
#pragma unroll
            for (int t = 0; t < 16; ++t) y[t] = bias;
#pragma unroll
            for (int j = 0; j < 31; ++j) { const float w = wdc[j * 512];
#pragma unroll
                for (int t = 0; t < 16; ++t) y[t] += w * glu[t + j]; }
#pragma unroll
            for (int t = 0; t < 16; ++t) Y[t * 516 + c] = y[t];
        }
        __syncthreads();
#pragma unroll
        for (int tt = 0; tt < 2; ++tt) { const int t = 2 * wave + tt; float v[8]; float sm = 0.f;
#pragma unroll
            for (int i = 0; i < 8; ++i) { v[i] = Y[t * 516 + lane + 64 * i]; sm += v[i]; }
            const float mean = wave_sum(sm) * (1.0f / 512.0f); float q = 0.f;
#pragma unroll
            for (int i = 0; i < 8; ++i) { v[i] -= mean; q += v[i] * v[i]; }
            const float rstd = rsqrtf(wave_sum(q) * (1.0f / 512.0f) + EPS);
#pragma unroll
            for (int i = 0; i < 8; ++i) { const int c = lane + 64 * i; const float yn = v[i] * rstd * lng[c] + lnb_[c]; const float a = yn * sigmoidf_(yn); Ab[t * 520 + c] = (unsigned short)(cvtpk(a, 0.f) & 0xffffu); }
        }
        __syncthreads();
#pragma unroll
        for (int i = 0; i < 4; ++i) cacc[i] = (f32x4){0.f, 0.f, 0.f, 0.f};
        { const bf16* wp = wpw_t + (size_t)(64 * wave + li) * 512 + 8 * fq; const LAS unsigned char* ab = (const LAS unsigned char*)Ab + li * 1040 + fq * 16;
#pragma unroll 8
            for (int ks = 0; ks < 16; ++ks) { const bf16x8 bfr = *(const LAS bf16x8*)(ab + ks * 64);
#pragma unroll
                for (int nb = 0; nb < 4; ++nb) { const bf16x8 wf = *(const bf16x8*)(wp + (size_t)nb * 16 * 512 + ks * 32); cacc[nb] = mfma16(wf, bfr, cacc[nb]); } } }
        }
        f32x4 pacc[4];
        for (int prep = 0; prep < ((PROBE_DUP & 256) ? 2 : 1); ++prep) {
#pragma unroll
        for (int i = 0; i < 4; ++i) pacc[i] = (f32x4){0.f, 0.f, 0.f, 0.f};
        { const int g = wave >> 1, nh = wave & 1;
            const bf16* wpt = wpool_t + (size_t)(g * 128 + 64 * nh + li) * 128 + 8 * fq; const bf16* psrc = proj + C_POOL + 128 * g + 8 * fq;
            if (g == 0) pool_group<2>(psrc, wpt, b, p0 + li, pacc); else if (g == 1) pool_group<4>(psrc, wpt, b, p0 + li, pacc); else if (g == 2) pool_group<8>(psrc, wpt, b, p0 + li, pacc); else pool_group<16>(psrc, wpt, b, p0 + li, pacc); }
        }
        f32x4 oa[2][4];
#pragma unroll
        for (int hh = 0; hh < 2; ++hh)
#pragma unroll
            for (int db = 0; db < 4; ++db) oa[hh][db] = *(const LAS f32x4*)(st + ((hh * 4 + db) * 64 + lane) * 16);
        float ssa = 0.f, ssp = 0.f, ssc = 0.f;
        { const int g = wave >> 1, nh = wave & 1;
#pragma unroll
            for (int nb = 0; nb < 4; ++nb) { const f32x4 sc = *(const f32x4*)(psc + 128 * g + 64 * nh + 16 * nb + 4 * fq); pacc[nb] = pacc[nb] * sc; ssp += dot4(pacc[nb]); ssc += dot4(cacc[nb]); ssa += dot4(oa[0][nb]) + dot4(oa[1][nb]); } }
        ssa += __shfl_xor(ssa, 16); ssa += __shfl_xor(ssa, 32); ssp += __shfl_xor(ssp, 16); ssp += __shfl_xor(ssp, 32); ssc += __shfl_xor(ssc, 16); ssc += __shfl_xor(ssc, 32);
        if (lane < 16) { red[wave * 16 + lane] = ssa; red[128 + wave * 16 + lane] = ssp; red[256 + wave * 16 + lane] = ssc; }
        __syncthreads();
        float ta = 0.f, tp = 0.f, tc = 0.f;
#pragma unroll
        for (int w8 = 0; w8 < 8; ++w8) { ta += red[w8 * 16 + li]; tp += red[128 + w8 * 16 + li]; tc += red[256 + w8 * 16 + li]; }
        const float ra = rsqrtf(ta * (1.0f / DATT) + EPS), rp = rsqrtf(tp * (1.0f / DPOOL) + EPS), rc = rsqrtf(tc * (1.0f / DCONV) + EPS);
        bf16* orow = merged + (size_t)rowidx(b, p0 + li) * DM;
#pragma unroll
        for (int hh = 0; hh < 2; ++hh)
#pragma unroll
            for (int db = 0; db < 4; ++db) { const int col = (2 * wave + hh) * 64 + 16 * db + 4 * fq; const f32x4 gv = *(const f32x4*)(mg + col); const f32x4 v = oa[hh][db] * ra * gv;
                v2u w2; w2.x = cvtpk(v.x, v.y); w2.y = cvtpk(v.z, v.w); *(v2u*)(orow + col) = w2; }
        { const int g = wave >> 1, nh = wave & 1;
#pragma unroll
            for (int nb = 0; nb < 4; ++nb) { const int col = DATT + 128 * g + 64 * nh + 16 * nb + 4 * fq; const f32x4 gv = *(const f32x4*)(mg + col); const f32x4 v = pacc[nb] * rp * gv;
                v2u w2; w2.x = cvtpk(v.x, v.y); w2.y = cvtpk(v.z, v.w); *(v2u*)(orow + col) = w2; } }
#pragma unroll
        for (int nb = 0; nb < 4; ++nb) { const int col = DATT + DPOOL + 64 * wave + 16 * nb + 4 * fq; const f32x4 gv = *(const f32x4*)(mg + col); const f32x4 v = cacc[nb] * rc * gv;
            v2u w2; w2.x = cvtpk(v.x, v.y); w2.y = cvtpk(v.z, v.w); *(v2u*)(orow + col) = w2; }
        __syncthreads();
    }
}

#define XB_TMO      128
#define XB_XCNT(j)  (256  + 64 * (j))
#define XB_XSUB(j)  (1280 + 64 * (j))
#define XB_XGEN(j)  (2304 + 64 * (j))
#define XB_TOP      3328
#define XB_TOPGEN   3392
#define XCD_BAR_WORDS 3456
#define XB_SPIN_CAP (1u << 18)

__device__ __forceinline__ unsigned xb_ld(unsigned* p)              { return __hip_atomic_load(p, __ATOMIC_RELAXED, __HIP_MEMORY_SCOPE_AGENT); }
__device__ __forceinline__ unsigned xb_add(unsigned* p, unsigned v) { return __hip_atomic_fetch_add(p, v, __ATOMIC_RELAXED, __HIP_MEMORY_SCOPE_AGENT); }
__device__ __forceinline__ unsigned xb_xcc_id() { return (unsigned)__builtin_amdgcn_s_getreg((3 << 11) | 20) & 0xFu; }
#define XB_SPIN(cond, bar) do { unsigned _sp = 0; while (cond) { __builtin_amdgcn_s_sleep(1); \
    if ((++_sp & 255u) == 0u) { if (xb_ld(&(bar)[XB_TMO])) break; if (_sp > XB_SPIN_CAP) { atomicAdd(&(bar)[XB_TMO], 1u); break; } } } } while (0)

struct XcdBarrier {
    unsigned* bar; unsigned x;
    volatile LAS unsigned* st;
};

__device__ __forceinline__ XcdBarrier xcd_barrier_post(unsigned* bar, volatile LAS unsigned* st) {
    XcdBarrier b; b.bar = bar; b.x = xb_xcc_id(); b.st = st;
    if (threadIdx.x == 0) (void)xb_add(&bar[XB_XCNT(b.x)], 1u);
    return b;
}
__device__ __forceinline__ void xcd_barrier_complete(unsigned* bar, unsigned x, unsigned& nloc, unsigned& nx) {
    const unsigned G = gridDim.x * gridDim.y * gridDim.z;
    unsigned sum, cnt, mine, sp = 0u;
    for (;;) {
        sum = 0u; cnt = 0u; mine = 0u;
#pragma unroll
        for (unsigned j = 0; j < 16; ++j) { const unsigned c = xb_ld(&bar[XB_XCNT(j)]); sum += c; cnt += (c > 0u) ? 1u : 0u; mine = (j == x) ? c : mine; }
        if (sum == G) break;
        __builtin_amdgcn_s_sleep(1);
        if ((++sp & 255u) == 0u) { if (xb_ld(&bar[XB_TMO])) break; if (sp > XB_SPIN_CAP) { atomicAdd(&bar[XB_TMO], 1u); break; } }
    }
    nloc = mine > 0u ? mine : 1u; nx = cnt > 0u ? cnt : 1u;
}

__device__ __forceinline__ void xcd_barrier(const XcdBarrier& b) {
    asm volatile("s_waitcnt vmcnt(0)" ::: "memory");
    __syncthreads();
    if (threadIdx.x == 0) {
        unsigned* bar = b.bar;
        __builtin_amdgcn_s_waitcnt(0);
        unsigned nloc = b.st[0], nx = b.st[1];
        if (nloc == 0u) { xcd_barrier_complete(bar, b.x, nloc, nx); b.st[0] = nloc; b.st[1] = nx; }
        const unsigned old = xb_add(&bar[XB_XSUB(b.x)], 1u);
        const unsigned gen = old / nloc;
        if (old + 1u == (gen + 1u) * nloc) {
            __builtin_amdgcn_fence(__ATOMIC_RELEASE, "agent");
            asm volatile("s_waitcnt vmcnt(0)" ::: "memory");
            const unsigned og = xb_add(&bar[XB_TOP], 1u);
            const unsigned tg = og / nx;
            if (og + 1u == (tg + 1u) * nx) xb_add(&bar[XB_TOPGEN], 1u);
            else XB_SPIN(xb_ld(&bar[XB_TOPGEN]) == tg, bar);
            __builtin_amdgcn_fence(__ATOMIC_ACQUIRE, "agent");
            xb_add(&bar[XB_XGEN(b.x)], 1u);
            asm volatile("s_waitcnt vmcnt(0)" ::: "memory");
        } else {
            XB_SPIN(xb_ld(&bar[XB_XGEN(b.x)]) == gen, bar);
            __builtin_amdgcn_fence(__ATOMIC_ACQUIRE, "agent");
            asm volatile("s_waitcnt vmcnt(0)" ::: "memory");
        }
    }
    __syncthreads();
}

constexpr int NPHASE = 1 + 7 * DEPTH;
#define PHASE_ENTER() int tid_ = threadIdx.x; asm volatile("" : "+v"(tid_)); const int tid = tid_, lane = tid & 63, wave = __builtin_amdgcn_readfirstlane(tid >> 6); \
    const __attribute__((address_space(4))) Args* ka_ = (const __attribute__((address_space(4))) Args*)__builtin_amdgcn_kernarg_segment_ptr(); asm volatile("" : "+s"(ka_)); Args A; __builtin_memcpy(&A, ka_, sizeof(Args)); \
    const int G = gridDim.x, gw = blockIdx.x * 8 + wave, NGW = G * 8; LAS float* scr = (LAS float*)(lds + wave * 16640); (void)tid; (void)lane; (void)gw; (void)NGW; (void)scr; (void)G;
__global__ void __launch_bounds__(512, 2) fwd_megakernel(Args args) {
    extern __shared__ __attribute__((aligned(16))) unsigned char lds_raw[];
    LAS unsigned char* lds = (LAS unsigned char*)lds_raw;
    cg::grid_group grid = cg::this_grid();
    const int lo = args.ph_lo, hi = args.ph_hi;
    volatile LAS unsigned* bst = (volatile LAS unsigned*)(lds + LDS_BYTES - 64);
    if (threadIdx.x < 16) bst[threadIdx.x] = 0u;
    __syncthreads();
    XcdBarrier bar = xcd_barrier_post((unsigned*)(args.ws + WS_CTL), bst);
#if !MK_SPLIT
    grid.sync();
#endif
#define IN(k) (lo <= (k) && (k) < hi)
#define SEAM(k) do { if (IN(k) && IN((k) + 1)) xcd_barrier(bar); } while (0)
    int k = 0;
    for (int rep = 0; rep < ((PROBE_DUP & 1) ? 2 : 1); ++rep) if (IN(k)) { if (rep) xcd_barrier(bar); PHASE_ENTER(); convert_p0_weights(A, scr, gw, NGW, lane); init_rows(A, gw, NGW, lane); }
    SEAM(k); ++k;
    for (int l = 0; l < DEPTH; ++l) {
        for (int rep = 0; rep < ((PROBE_DUP & 4) ? 2 : 1); ++rep) if (IN(k)) { if (rep) xcd_barrier(bar); PHASE_ENTER(); unsigned char* wsb = gptr(A.ws);
            pg8::Gemm g{(const bf16*)(wsb + WS_U), (const bf16*)(wsb + WS_WIN) + (size_t)l * DIN * DM, MR, DIN, DM}; pg8::StaticOrder S; S.init(MR, DIN, G, (int)blockIdx.x);
            pg8::EpiBf16<0> E{(bf16*)(wsb + WS_PROJ), DIN, nullptr, 1024, 1024, 0.125f};
            pg8::gemm_phase<pg8::EpiBf16<0>, pg8::StaticOrder, PG8_ALIGN, PG8_SP2>(lds, g, S, E);
            __syncthreads();
            { const int ex = ((MR / 256) * (DIN / 256)) % G, c = (int)blockIdx.x;
                if (ex == 0 || c >= ex) { const int c0 = ex == 0 ? 0 : ex, gw2 = (c - c0) * 8 + wave, n2 = (G - c0) * 8; convert_ffn_weights(A, l, scr, gw2, n2, lane); if (l == 0) convert_wout(A, 0, scr, gw2, n2, lane); } }
            __syncthreads(); skinny_gemm<0>((const bf16*)(wsb + WS_U) + (size_t)MR * DM, (const bf16*)(wsb + WS_WIN) + (size_t)l * DIN * DM, DIN, DM, (void*)(wsb + WS_PROJ), DIN, lds, lane, wave);
        }
        SEAM(k); ++k;
        for (int rep = 0; rep < ((PROBE_DUP & 2) ? 2 : 1); ++rep) if (IN(k)) { if (rep) xcd_barrier(bar); PHASE_ENTER(); mixer_phase(A, l, lds, tid, wave); }
        SEAM(k); ++k;
        for (int rep = 0; rep < ((PROBE_DUP & 16) ? 2 : 1); ++rep) if (IN(k)) { if (rep) xcd_barrier(bar); PHASE_ENTER(); unsigned char* wsb = gptr(A.ws);
            pg8::Gemm g{(const bf16*)(wsb + WS_MERGED), (const bf16*)(wsb + WS_WOUT) + (size_t)l * DM * DM, MR, DM, DM}; pg8::StaticOrder S; S.init(MR, DM, G, (int)blockIdx.x);
            pg8::EpiF32 E{(float*)(wsb + WS_OUT), DM};
            pg8::gemm_phase<pg8::EpiF32, pg8::StaticOrder, PG8_ALIGN, PG8_SP2>(lds, g, S, E);
            __syncthreads(); if (l + 1 < DEPTH) skinny_gemm<1>((const bf16*)(wsb + WS_MERGED) + (size_t)MR * DM, (const bf16*)(wsb + WS_WOUT) + (size_t)l * DM * DM, DM, DM, (void*)(wsb + WS_OUT), DM, lds, lane, wave);
        }
        SEAM(k); ++k;
        if (IN(k)) { PHASE_ENTER(); row_phase(A, A.post_mix_g + (size_t)l * DM, A.pre_ffn_g + (size_t)l * DM, nullptr, (l + 1 < DEPTH) ? MV : MR, gw, NGW, lane); }
        SEAM(k); ++k;
        for (int rep = 0; rep < ((PROBE_DUP & 32) ? 2 : 1); ++rep) if (IN(k)) { if (rep) xcd_barrier(bar); PHASE_ENTER(); unsigned char* wsb = gptr(A.ws);
            pg8::Gemm g{(const bf16*)(wsb + WS_U), (const bf16*)(wsb + WS_WGU), MR, 2 * DFF, DM}; pg8::StaticOrder S; S.init(MR, 2 * DFF, G, (int)blockIdx.x);
            pg8::EpiSwiGLU E{(bf16*)(wsb + WS_ACT), DFF};
            pg8::gemm_phase<pg8::EpiSwiGLU, pg8::StaticOrder, PG8_ALIGN, PG8_SP2>(lds, g, S, E);
            __syncthreads();
            if (l + 1 < DEPTH) { const int ex = ((MR / 256) * (2 * DFF / 256)) % G, c = (int)blockIdx.x;
                if (ex == 0 || c >= ex) { const int c0 = ex == 0 ? 0 : ex, gw2 = (c - c0) * 8 + wave, n2 = (G - c0) * 8; convert_win(A, l + 1, scr, gw2, n2, lane); convert_wout(A, l + 1, scr, gw2, n2, lane); } }
            __syncthreads(); if (l + 1 < DEPTH) skinny_gemm<2>((const bf16*)(wsb + WS_U) + (size_t)MR * DM, (const bf16*)(wsb + WS_WGU), 2 * DFF, DM, (void*)(wsb + WS_ACT), DFF, lds, lane, wave);
        }
        SEAM(k); ++k;
        for (int rep = 0; rep < ((PROBE_DUP & 8) ? 2 : 1); ++rep) if (IN(k)) { if (rep) xcd_barrier(bar); PHASE_ENTER(); unsigned char* wsb = gptr(A.ws);
            pg8::Gemm g{(const bf16*)(wsb + WS_ACT), (const bf16*)(wsb + WS_WD), MR, DM, DFF}; pg8::StaticOrder S; S.init(MR, DM, G, (int)blockIdx.x);
            pg8::EpiF32 E{(float*)(wsb + WS_OUT), DM};
            pg8::gemm_phase<pg8::EpiF32, pg8::StaticOrder, PG8_ALIGN, PG8_SP2>(lds, g, S, E);
            __syncthreads(); if (l + 1 < DEPTH) skinny_gemm<1>((const bf16*)(wsb + WS_ACT) + (size_t)MR * DFF, (const bf16*)(wsb + WS_WD), DM, DFF, (void*)(wsb + WS_OUT), DM, lds, lane, wave);
        }
        SEAM(k); ++k;
        if (IN(k)) { PHASE_ENTER();
            if (l + 1 < DEPTH) { row_phase(A, A.post_ffn_g + (size_t)l * DM, A.pre_mix_g + (size_t)(l + 1) * DM, nullptr, MV, gw, NGW, lane); }
            else row_phase(A, A.post_ffn_g + (size_t)l * DM, nullptr, A.out, MR, gw, NGW, lane);
        }
        if (l + 1 < DEPTH) { SEAM(k); } ++k;
    }
#undef IN
#undef SEAM
}

extern "C" void kernel_launch(void* const* d_in, const int* in_sizes, int n_in, void* d_out, int out_size, void* d_ws, size_t ws_size, hipStream_t stream) {
    static int grid = 0;
    if (grid == 0) {
        if (n_in != 19 || in_sizes[0] != MR * DM || out_size != MR * DM || ws_size < WS_END) { fprintf(stderr, "kernel_launch: unexpected problem (n_in %d, in0 %d, out %d, ws %zu, need %zu)\n", n_in, n_in > 0 ? in_sizes[0] : -1, out_size, ws_size, (size_t)WS_END); grid = -1; return; }
        int dev = 0, cus = 0, per_cu = 0;
        if (hipGetDevice(&dev) != hipSuccess || hipDeviceGetAttribute(&cus, hipDeviceAttributeMultiprocessorCount, dev) != hipSuccess) { grid = -1; return; }
        if (hipFuncSetAttribute((const void*)fwd_megakernel, hipFuncAttributeMaxDynamicSharedMemorySize, LDS_BYTES) != hipSuccess) { fprintf(stderr, "kernel_launch: hipFuncSetAttribute failed\n"); grid = -1; return; }
        if (hipOccupancyMaxActiveBlocksPerMultiprocessor(&per_cu, (const void*)fwd_megakernel, 512, LDS_BYTES) != hipSuccess || per_cu < 1) { fprintf(stderr, "kernel_launch: occupancy query says %d blocks per CU\n", per_cu); per_cu = 1; }
        (void)hipGetLastError();
        grid = cus;
    }
    if (grid < 0) return;
    if (hipMemsetAsync((unsigned char*)d_ws + WS_CTL, 0, CTL_BYTES, stream) != hipSuccess) { fprintf(stderr, "kernel_launch: hipMemsetAsync failed\n"); return; }
    Args a{};
    const float** ap = (const float**)&a;
    for (int i = 0; i < 19; ++i) ap[i] = (const float*)d_in[i];
    a.out = (float*)d_out; a.ws = (unsigned char*)d_ws;
#if MK_SPLIT
    for (int ph = 0; ph < NPHASE; ++ph) { a.ph_lo = ph; a.ph_hi = ph + 1; hipLaunchKernelGGL(fwd_megakernel, dim3(grid), dim3(512), LDS_BYTES, stream, a); }
#else
    a.ph_lo = 0; a.ph_hi = NPHASE;
    void* kargs[] = {(void*)&a};
    const hipError_t e = hipLaunchCooperativeKernel((const void*)fwd_megakernel, dim3(grid), dim3(512), kargs, LDS_BYTES, stream);
    if (e != hipSuccess) fprintf(stderr, "kernel_launch: cooperative launch failed: %s (grid %d)\n", hipGetErrorString(e), grid);
#endif
}
```

```cpp
#include <hip/hip_runtime.h>
#include <hip/hip_cooperative_groups.h>
#include <cstdio>
#include <cstdint>
namespace cg = cooperative_groups;
namespace pg8 {
#define PG8_LAS __attribute__((address_space(3)))
typedef unsigned short bf16_t;
typedef short bf16x8 __attribute__((ext_vector_type(8)));
typedef float f32x4 __attribute__((ext_vector_type(4)));
typedef unsigned u32x4 __attribute__((ext_vector_type(4)));
constexpr int BM = 256, BK = 64, HALF = 128, HTB = HALF * BK * 2  , STAGE_BYTES = 8 * HTB, NXCD = 8, WGM = 8;

__host__ __device__ __forceinline__ int lds_byte(int r, int c) { const int st = (r >> 4) * 2 + (c >> 5), rr = r & 15, cc = c & 31, ob = rr * 64 + cc * 2; return st * 1024 + (ob ^ (((ob >> 9) & 1) << 5)); }
__host__ __device__ __forceinline__ void stage_rc(int b, int& R, int& C) { const int st = b / 1024, sb = b % 1024, swz = sb ^ (((sb >> 9) & 1) << 5); R = (st >> 1) * 16 + swz / 64; C = (st & 1) * 32 + (swz % 64) / 2; }
__host__ __device__ __forceinline__ int perm32(int rho) { const int n = rho >> 4, i = rho & 15; return 8 * (i >> 2) + 4 * n + (i & 3); }

struct Unit { int pm, pn; };
struct Gemm { const bf16_t* A; const bf16_t* Bt; int M, N, K; };

struct StaticOrder {
    int nM, nN, nwg, G, c;
    __host__ __device__ void init(int M, int N, int G_, int c_) { nM = M / BM; nN = N / BM; nwg = nM * nN; G = G_; c = c_; }
    __host__ __device__ bool next(int i, Unit& u) const {
        const long L = (long)i * G + c; if (L >= nwg) return false;
        int wgid = (int)L; { const int q = nwg / NXCD, r = nwg % NXCD, xcd = wgid % NXCD, off = wgid / NXCD; wgid = (xcd < r ? xcd * (q + 1) : r * (q + 1) + (xcd - r) * q) + off; }
        const int nig = WGM * nN, gid = wgid / nig, fm = gid * WGM, gsz = (nM - fm) < WGM ? (nM - fm) : WGM;
        u.pm = fm + ((wgid % nig) % gsz); u.pn = (wgid % nig) / gsz; return true;
    }
    __device__ __forceinline__ void a_ready(const Unit&) const {}
    __device__ __forceinline__ void done(const Unit&) const {}
};

__device__ __forceinline__ unsigned cvt_pk_bf16(float lo, float hi) { unsigned r; asm volatile("v_cvt_pk_bf16_f32 %0, %1, %2" : "=v"(r) : "v"(lo), "v"(hi)); return r; }
typedef float f32x2 __attribute__((ext_vector_type(2)));
__device__ __forceinline__ f32x2 gelu_pk(f32x2 v) {
    const f32x2 av = __builtin_elementwise_abs(v), d = av * 0.2316418882f + 1.0f;
    f32x2 t; t.x = __builtin_amdgcn_rcpf(d.x); t.y = __builtin_amdgcn_rcpf(d.y);
    f32x2 q = t * 0.5307027145f + (-0.7265760135f); q = q * t + 0.7107068705f; q = q * t + (-0.142248368f); q = q * t + 0.127414796f; q = q * t;
    const f32x2 s = (v * v) * (-0.72134752044f);
    f32x2 e; e.x = __builtin_amdgcn_exp2f(s.x); e.y = __builtin_amdgcn_exp2f(s.y);
    const f32x2 m = v * (q * e), r = v - m;
    f32x2 o; o.x = v.x < 0.f ? m.x : r.x; o.y = v.y < 0.f ? m.y : r.y; return o;
}

template <int ACT  > struct EpiBf16 {
    static constexpr bool PERM = true, AFTER_DRAIN = false; static_assert(ACT == 0 || ACT == 1, "EpiBf16: ACT is 0 (none) or 1 (gelu_pk)");
    bf16_t* O; int ldc; const float* bias; int split_cols; size_t split_stride; float scale0;
    __device__ __forceinline__ void operator()(const f32x4 (&acc)[2][2][4][2], const Unit& u, int wr, int wc, int fr, int fq) const {
        const int row0 = u.pm * BM + wr * 64 + fr; int colt = u.pn * BM; bf16_t* base = O;
        float sc = 1.f; if (split_cols) { const int t = colt / split_cols; base += (size_t)t * split_stride; colt -= t * split_cols; if (t == 0) sc = scale0; }
        const int col0 = colt + wc * 32 + 8 * fq, bcol0 = u.pn * BM + wc * 32 + 8 * fq;
        f32x4 bv[2][2];
#pragma unroll
        for (int bj = 0; bj < 2; ++bj)
#pragma unroll
            for (int n = 0; n < 2; ++n) bv[bj][n] = bias ? *(const f32x4*)(bias + bcol0 + bj * HALF + 4 * n) : (f32x4){0.f, 0.f, 0.f, 0.f};
#pragma unroll
        for (int ai = 0; ai < 2; ++ai)
#pragma unroll
            for (int m = 0; m < 4; ++m) { bf16_t* rowp = base + (size_t)(row0 + ai * HALF + m * 16) * ldc + col0;
#pragma unroll
                for (int bj = 0; bj < 2; ++bj) { f32x4 v0 = acc[ai][bj][m][0] + bv[bj][0], v1 = acc[ai][bj][m][1] + bv[bj][1];
                    if (ACT == 1) { f32x2 a = gelu_pk((f32x2){v0[0], v0[1]}), b = gelu_pk((f32x2){v0[2], v0[3]}), c = gelu_pk((f32x2){v1[0], v1[1]}), d = gelu_pk((f32x2){v1[2], v1[3]});
                        v0 = (f32x4){a.x, a.y, b.x, b.y}; v1 = (f32x4){c.x, c.y, d.x, d.y}; }
                    v0 = v0 * sc; v1 = v1 * sc; u32x4 w; w.x = cvt_pk_bf16(v0[0], v0[1]); w.y = cvt_pk_bf16(v0[2], v0[3]); w.z = cvt_pk_bf16(v1[0], v1[1]); w.w = cvt_pk_bf16(v1[2], v1[3]);
                    *(u32x4*)(rowp + bj * HALF) = w; } }
    }
};
__device__ __forceinline__ unsigned cvtpk_rne(float lo, float hi) { typedef float f32x2_t __attribute__((ext_vector_type(2))); typedef __bf16 bf16x2_t __attribute__((ext_vector_type(2)));
    f32x2_t v = {lo, hi}; bf16x2_t b = __builtin_convertvector(v, bf16x2_t); return __builtin_bit_cast(unsigned, b); }
struct EpiF32 {
    static constexpr bool PERM = false, AFTER_DRAIN = false;
    float* O; int ldc;
    __device__ __forceinline__ void operator()(const f32x4 (&acc)[2][2][4][2], const Unit& u, int wr, int wc, int fr, int fq) const {
        const int row0 = u.pm * BM + wr * 64 + fr, col0 = u.pn * BM + wc * 32 + 4 * fq;
#pragma unroll
        for (int ai = 0; ai < 2; ++ai)
#pragma unroll
            for (int m = 0; m < 4; ++m) { float* rowp = O + (size_t)(row0 + ai * HALF + m * 16) * ldc + col0;
#pragma unroll
                for (int bj = 0; bj < 2; ++bj)
#pragma unroll
                    for (int n = 0; n < 2; ++n) *(f32x4*)(rowp + bj * HALF + n * 16) = acc[ai][bj][m][n]; }
    }
};
struct EpiSwiGLU {
    static constexpr bool PERM = true, AFTER_DRAIN = false;
    bf16_t* O; int ldc;
    __device__ __forceinline__ void operator()(const f32x4 (&acc)[2][2][4][2], const Unit& u, int wr, int wc, int fr, int fq) const {
        typedef unsigned u32x2 __attribute__((ext_vector_type(2)));
        const int row0 = u.pm * BM + wr * 64 + fr, col0 = u.pn * (BM / 2) + wc * 16 + 4 * fq;
#pragma unroll
        for (int ai = 0; ai < 2; ++ai)
#pragma unroll
            for (int m = 0; m < 4; ++m) { bf16_t* rowp = O + (size_t)(row0 + ai * HALF + m * 16) * ldc + col0;
#pragma unroll
                for (int bj = 0; bj < 2; ++bj) { const f32x4 g = acc[ai][bj][m][0], up = acc[ai][bj][m][1]; float a[4];
#pragma unroll
                    for (int e = 0; e < 4; ++e) a[e] = g[e] * __builtin_amdgcn_rcpf(1.0f + __builtin_amdgcn_exp2f(-1.4426950408889634f * g[e])) * up[e];
                    u32x2 w; w.x = cvtpk_rne(a[0], a[1]); w.y = cvtpk_rne(a[2], a[3]); *(u32x2*)(rowp + bj * (HALF / 2)) = w; } }
    }
};

template <class Epi, class Sched, bool ALIGN_EPI = false, bool SP2 = false>
__device__ __forceinline__ void gemm_phase(PG8_LAS unsigned char* lds, const Gemm g, const Sched& S, const Epi& E) {
    int tid_ = threadIdx.x; asm volatile("" : "+v"(tid_));
    const int tid = tid_, wid = __builtin_amdgcn_readfirstlane(tid >> 6), lane = tid & 63, wr = wid >> 2, wc = wid & 3, fr = lane & 15, fq = lane >> 4;
    const int K = g.K, nt = K / BK;
    unsigned voffA[2], voffB[2];
#pragma unroll
    for (int i = 0; i < 2; ++i) { int R, C; stage_rc(tid * 16 + i * 8192, R, C); const int Rb = Epi::PERM ? ((R & ~31) + perm32(R & 31)) : R;
        voffA[i] = (unsigned)(R * K + C) * 2u; voffB[i] = (unsigned)(Rb * K + C) * 2u; }
    const size_t kstep = (size_t)(BK * 2);
    const size_t hstep = (size_t)HALF * K * 2;
    const size_t tstep = 2 * hstep;
    const unsigned ldsw = (unsigned)wid * 1024u;
    const int aoff = lds_byte(wr * 64 + fr, fq * 8), boff = lds_byte(wc * 32 + fr, fq * 8);
#define PG8_SA(b, h) (((b) * 2 + (h)) * HTB)
#define PG8_SB(b, h) ((4 + (b) * 2 + (h)) * HTB)
#define PG8_STAGE(bufoff, gbase, voff) do { _Pragma("unroll") for (int _i = 0; _i < 2; ++_i) \
        __builtin_amdgcn_global_load_lds((const unsigned*)((const char*)(gbase) + (voff)[_i]), (PG8_LAS unsigned*)(lds + (bufoff) + ldsw + _i * 8192), 16, 0, 0); } while (0)
#define PG8_LDA(dst, b, h) do { _Pragma("unroll") for (int m = 0; m < 4; ++m) _Pragma("unroll") for (int k = 0; k < 2; ++k) dst[m][k] = *(const PG8_LAS bf16x8*)(lds + PG8_SA(b, h) + aoff + m * 2048 + k * 1024); } while (0)
#define PG8_LDB(dst, b, h) do { _Pragma("unroll") for (int n = 0; n < 2; ++n) _Pragma("unroll") for (int k = 0; k < 2; ++k) dst[n][k] = *(const PG8_LAS bf16x8*)(lds + PG8_SB(b, h) + boff + n * 2048 + k * 1024); } while (0)
#define PG8_MMA(ai, bj, At, Bt) do { __builtin_amdgcn_s_setprio(1); _Pragma("unroll") for (int m = 0; m < 4; ++m) _Pragma("unroll") for (int n = 0; n < 2; ++n) _Pragma("unroll") for (int k = 0; k < 2; ++k) \
        acc[ai][bj][m][n] = __builtin_amdgcn_mfma_f32_16x16x32_bf16(Bt[n][k], At[m][k], acc[ai][bj][m][n], 0, 0, 0); __builtin_amdgcn_s_setprio(0); } while (0)
#define PG8_WAIT_V(n) asm volatile("s_waitcnt vmcnt(" #n ")" ::: "memory")
#define PG8_WAIT_L(n) asm volatile("s_waitcnt lgkmcnt(" #n ")" ::: "memory")
#define PG8_BAR __builtin_amdgcn_s_barrier()
#define PG8_SCHED __builtin_amdgcn_sched_barrier(0)
    Unit cur, nxt; int ui = 0;
    if (!S.next(0, cur)) return;
    f32x4 acc[2][2][4][2];
#pragma unroll
    for (int a = 0; a < 2; ++a)
#pragma unroll
        for (int b = 0; b < 2; ++b)
#pragma unroll
            for (int m = 0; m < 4; ++m)
#pragma unroll
                for (int n = 0; n < 2; ++n) acc[a][b][m][n] = (f32x4){0.f, 0.f, 0.f, 0.f};
    bf16x8 At[4][2], B0[2][2], B1[2][2];
    const char* cA = (const char*)g.A + (size_t)cur.pm * tstep; const char* cB = (const char*)g.Bt + (size_t)cur.pn * tstep;
    S.a_ready(cur);
    if constexpr (SP2) {
        PG8_STAGE(PG8_SB(0, 0), cB, voffB); PG8_STAGE(PG8_SB(0, 1), cB + hstep, voffB); PG8_STAGE(PG8_SA(0, 0), cA, voffA); PG8_STAGE(PG8_SA(0, 1), cA + hstep, voffA);
        if (wr == 1) PG8_BAR;
        PG8_WAIT_V(2); PG8_BAR;
        PG8_STAGE(PG8_SB(1, 0), cB + kstep, voffB); PG8_STAGE(PG8_SA(1, 0), cA + kstep, voffA); PG8_STAGE(PG8_SB(1, 1), cB + hstep + kstep, voffB);
        PG8_WAIT_V(6); PG8_BAR;
    } else {
        PG8_STAGE(PG8_SB(0, 0), cB, voffB); PG8_STAGE(PG8_SA(0, 0), cA, voffA); PG8_STAGE(PG8_SB(0, 1), cB + hstep, voffB); PG8_STAGE(PG8_SA(0, 1), cA + hstep, voffA);
        if (wr == 1) PG8_BAR;
        PG8_WAIT_V(4); PG8_BAR;
        PG8_STAGE(PG8_SB(1, 0), cB + kstep, voffB); PG8_STAGE(PG8_SA(1, 0), cA + kstep, voffA); PG8_STAGE(PG8_SB(1, 1), cB + hstep + kstep, voffB);
        PG8_WAIT_V(6); PG8_BAR;
    }
    for (;;) {
        const bool has_next = S.next(ui + 1, nxt);
        const char* nA = has_next ? (const char*)g.A + (size_t)nxt.pm * tstep : cA; const char* nB = has_next ? (const char*)g.Bt + (size_t)nxt.pn * tstep : cB;
        for (int t = 0; t < nt; t += 2) {
            const bool last = (t == nt - 2);
            const char* a1 = cA + (size_t)(t + 1) * kstep;
            const char* a2 = last ? nA : cA + (size_t)(t + 2) * kstep; const char* b2 = last ? nB : cB + (size_t)(t + 2) * kstep;
            const char* a3 = a2 + kstep; const char* b3 = b2 + kstep;
            if (last && has_next) S.a_ready(nxt);
            if constexpr (SP2) {
            PG8_LDB(B0, 0, 0); PG8_LDB(B1, 0, 1); PG8_SCHED; PG8_LDA(At, 0, 0); PG8_STAGE(PG8_SA(1, 1), a1 + hstep, voffA);
            PG8_WAIT_V(8); PG8_WAIT_L(0); PG8_BAR; PG8_MMA(0, 0, At, B0); PG8_MMA(0, 1, At, B1); PG8_BAR; PG8_SCHED;
            PG8_LDA(At, 0, 1); PG8_STAGE(PG8_SB(0, 0), b2, voffB); PG8_STAGE(PG8_SB(0, 1), b2 + hstep, voffB); PG8_STAGE(PG8_SA(0, 0), a2, voffA);
            PG8_WAIT_V(8); PG8_WAIT_L(0); PG8_BAR; PG8_MMA(1, 0, At, B0); PG8_MMA(1, 1, At, B1); PG8_BAR; PG8_SCHED;
            PG8_LDB(B0, 1, 0); PG8_LDB(B1, 1, 1); PG8_SCHED; PG8_LDA(At, 1, 0); PG8_STAGE(PG8_SA(0, 1), a2 + hstep, voffA);
            PG8_WAIT_V(8); PG8_WAIT_L(0); PG8_BAR; PG8_MMA(0, 0, At, B0); PG8_MMA(0, 1, At, B1); PG8_BAR; PG8_SCHED;
            PG8_LDA(At, 1, 1); PG8_STAGE(PG8_SB(1, 0), b3, voffB); PG8_STAGE(PG8_SB(1, 1), b3 + hstep, voffB); PG8_STAGE(PG8_SA(1, 0), a3, voffA);
            PG8_WAIT_V(8); PG8_WAIT_L(0); PG8_BAR; PG8_MMA(1, 0, At, B0); PG8_MMA(1, 1, At, B1); PG8_BAR; PG8_SCHED;
            } else {
            PG8_LDB(B0, 0, 0); PG8_SCHED; PG8_LDA(At, 0, 0); PG8_STAGE(PG8_SA(1, 1), a1 + hstep, voffA);
            PG8_WAIT_L(8); PG8_BAR; PG8_WAIT_L(0); PG8_MMA(0, 0, At, B0); PG8_BAR; PG8_SCHED;
            PG8_LDB(B1, 0, 1); PG8_STAGE(PG8_SB(0, 0), b2, voffB);
            PG8_BAR; PG8_WAIT_L(0); PG8_MMA(0, 1, At, B1); PG8_BAR;
            PG8_LDA(At, 0, 1); PG8_STAGE(PG8_SA(0, 0), a2, voffA);
            PG8_BAR; PG8_WAIT_L(0); PG8_MMA(1, 0, At, B0); PG8_BAR; PG8_SCHED;
            PG8_STAGE(PG8_SB(0, 1), b2 + hstep, voffB);
            PG8_WAIT_V(6); PG8_BAR; PG8_MMA(1, 1, At, B1); PG8_BAR;
            PG8_LDB(B0, 1, 0); PG8_SCHED; PG8_LDA(At, 1, 0); PG8_STAGE(PG8_SA(0, 1), a2 + hstep, voffA);
            PG8_WAIT_L(8); PG8_BAR; PG8_WAIT_L(0); PG8_MMA(0, 0, At, B0); PG8_BAR; PG8_SCHED;
            PG8_LDB(B1, 1, 1); PG8_STAGE(PG8_SB(1, 0), b3, voffB);
            PG8_BAR; PG8_WAIT_L(0); PG8_MMA(0, 1, At, B1); PG8_BAR;
            PG8_LDA(At, 1, 1); PG8_STAGE(PG8_SA(1, 0), a3, voffA);
            PG8_BAR; PG8_WAIT_L(0); PG8_MMA(1, 0, At, B0); PG8_BAR; PG8_SCHED;
            PG8_STAGE(PG8_SB(1, 1), b3 + hstep, voffB);
            PG8_WAIT_V(6); PG8_BAR; PG8_MMA(1, 1, At, B1); PG8_BAR;
            }
        }
        if constexpr (ALIGN_EPI) { if (wr == 0) PG8_BAR; }
        if constexpr (!Epi::AFTER_DRAIN) { E(acc, cur, wr, wc, fr, fq); S.done(cur); }
        if (!has_next) break;
#pragma unroll
        for (int a = 0; a < 2; ++a)
#pragma unroll
            for (int b = 0; b < 2; ++b)
#pragma unroll
                for (int m = 0; m < 4; ++m)
#pragma unroll
                    for (int n = 0; n < 2; ++n) acc[a][b][m][n] = (f32x4){0.f, 0.f, 0.f, 0.f};
        cur = nxt; cA = nA; cB = nB; ++ui;
        if constexpr (ALIGN_EPI) { if (wr == 1) PG8_BAR; }
    }
    PG8_WAIT_V(0);
    if constexpr (!ALIGN_EPI) { if (wr == 0) PG8_BAR; }
    PG8_BAR;
    if constexpr (Epi::AFTER_DRAIN) { E.fused(acc, cur, wr, wc, fr, fq, lds, wid, lane); S.done(cur); }
#undef PG8_SA
#undef PG8_SB
#undef PG8_STAGE
#undef PG8_LDA
#undef PG8_LDB
#undef PG8_MMA
#undef PG8_WAIT_V
#undef PG8_WAIT_L
#undef PG8_BAR
#undef PG8_SCHED
}
}

#ifndef PG8_SP2
#define PG8_SP2 true
#endif
#ifndef PG8_ALIGN
#define PG8_ALIGN true
#endif
#ifndef PROBE_DUP
#define PROBE_DUP 0
#endif
#ifndef MK_SPLIT
#define MK_SPLIT 0
#endif

constexpr int NB = 2, SEQ = 4096, DM = 2048, NMETA = 16, LSEQ = SEQ + NMETA, DEPTH = 2;
constexpr int MR = NB * SEQ;
constexpr int MV = MR + NMETA;
constexpr int MP = 33 * 256;
constexpr int DIN = 4608, DFF = 5632, DATT = 1024, DPOOL = 512, DCONV = 512, NHEAD = 16;
constexpr int C_K = 1024, C_V = 2048, C_POOL = 3072, C_CA = 3584, C_CG = 4096;
constexpr float EPS = 1e-6f, LOG2E = 1.4426950408889634f, LN2 = 0.6931471805599453f;
constexpr float SB_EXIT = -104.0f;

constexpr size_t MiB = 1u << 20;
constexpr size_t WS_WIN = 0;
constexpr size_t WS_WOUT = WS_WIN + 36 * MiB;
constexpr size_t WS_WGU = WS_WOUT + 16 * MiB;
constexpr size_t WS_WD = WS_WGU + 44 * MiB;
constexpr size_t WS_WSM = WS_WD + 22 * MiB;
constexpr size_t WS_H = WS_WSM + 2 * MiB;
constexpr size_t WS_U = WS_H + 66 * MiB;
constexpr size_t WS_OUT = WS_U + 33 * MiB;
constexpr size_t WS_PROJ = WS_OUT + 66 * MiB;
constexpr size_t WS_MERGED = WS_PROJ + (size_t)MP * DIN * 2;
constexpr size_t WS_ACT = WS_PROJ;
constexpr size_t WS_CTL = WS_MERGED + 33 * MiB;
constexpr size_t CTL_BYTES = 65536;
constexpr size_t WS_END = WS_CTL + 1 * MiB;
static_assert((size_t)MP * DFF * 2 <= WS_END - WS_PROJ, "act overlay");

constexpr int LDS_BYTES = 147456;

#define GAS __attribute__((address_space(1)))
#define LAS __attribute__((address_space(3)))
typedef unsigned short bf16;
typedef unsigned v4u __attribute__((ext_vector_type(4)));
typedef unsigned v2u __attribute__((ext_vector_type(2)));
typedef float f32x4 __attribute__((ext_vector_type(4)));
typedef short bf16x8 __attribute__((ext_vector_type(8)));
typedef short v4i16_t __attribute__((ext_vector_type(4)));
#define LDS_WAIT() asm volatile("s_waitcnt lgkmcnt(0)" ::: "memory")

__device__ __forceinline__ unsigned cvtpk(float lo, float hi) { return pg8::cvtpk_rne(lo, hi); }
__device__ __forceinline__ float bflo(unsigned u) { return __uint_as_float(u << 16); }
__device__ __forceinline__ float bfhi(unsigned u) { return __uint_as_float(u & 0xffff0000u); }
__device__ __forceinline__ float bf2f(bf16 v) { return __uint_as_float((unsigned)v << 16); }
__device__ __forceinline__ float wave_sum(float v) {
#pragma unroll
    for (int o = 1; o < 64; o <<= 1) v += __shfl_xor(v, o);
    return v;
}
__device__ __forceinline__ float sigmoidf_(float x) { return __builtin_amdgcn_rcpf(1.0f + __builtin_amdgcn_exp2f(-LOG2E * x)); }
template <class T> __device__ __forceinline__ T* gptr(T* p) { GAS T* g = (GAS T*)p; asm volatile("" : "+s"(g)); return (T*)g; }
__device__ __forceinline__ int rowidx(int b, int pos) { return pos < NMETA ? MR + pos : b * SEQ + pos - NMETA; }
__device__ __forceinline__ f32x4 mfma16(bf16x8 a, bf16x8 b, f32x4 c) { return __builtin_amdgcn_mfma_f32_16x16x32_bf16(a, b, c, 0, 0, 0); }

struct Args {
    const float *x, *meta, *pre_mix_g, *w_in, *w_pool, *pool_scale, *w_dw, *b_dw, *conv_ln_g, *conv_ln_b, *w_pw, *mix_out_g, *w_out, *post_mix_g, *pre_ffn_g, *w_gate, *w_up, *w_down, *post_ffn_g;
    float* out; unsigned char* ws; int ph_lo, ph_hi;
};

__device__ __forceinline__ void transpose_item(const float* __restrict__ W, int K, int N, bf16* WT, int mode, LAS float* scr, int item, int lane) {
    W = gptr(W); WT = gptr(WT);
    const int nblk = N >> 6, kb = item / nblk, nb = item - kb * nblk, k0 = kb << 6, n0 = nb << 6;
    const int r4 = lane >> 4, c4 = (lane & 15) * 4;
    f32x4 tv[16];
#pragma unroll
    for (int i = 0; i < 16; ++i) tv[i] = *(const f32x4*)(W + (size_t)(k0 + 4 * i + r4) * N + n0 + c4);
#pragma unroll
    for (int i = 0; i < 16; ++i) { LAS float* s = scr + (4 * i + r4) * 65 + c4; s[0] = tv[i].x; s[1] = tv[i].y; s[2] = tv[i].z; s[3] = tv[i].w; }
    LDS_WAIT();
    const int c = lane & 7;
#pragma unroll
    for (int j = 0; j < 8; ++j) { const int n = (lane >> 3) + 8 * j; const LAS float* s = scr + (8 * c) * 65 + n;
        v4u o; o.x = cvtpk(s[0 * 65], s[1 * 65]); o.y = cvtpk(s[2 * 65], s[3 * 65]); o.z = cvtpk(s[4 * 65], s[5 * 65]); o.w = cvtpk(s[6 * 65], s[7 * 65]);
        const int ng = n0 + n; const int R = mode == 0 ? ng : ((ng >> 2) * 8 + (ng & 3) + (mode == 2 ? 4 : 0));
        *(v4u*)(WT + (size_t)R * K + k0 + 8 * c) = o; }
    LDS_WAIT();
}
#define TJOB(Wp, Kk, Nn, WTp, mode) { const int ni_ = ((Kk) / 64) * ((Nn) / 64); if (r < ni_) { transpose_item((Wp), (Kk), (Nn), (WTp), (mode), scr, r, lane); continue; } r -= ni_; }

__device__ __forceinline__ void convert_ffn_weights(const Args& A, int l, LAS float* scr, int gw, int NGW, int lane) {
    bf16* wgu = (bf16*)(A.ws + WS_WGU); bf16* wd = (bf16*)(A.ws + WS_WD);
    constexpr int NI = 3 * (DM / 64) * (DFF / 64);
    for (int it = gw; it < NI; it += NGW) { int r = it;
        TJOB(A.w_gate + (size_t)l * DM * DFF, DM, DFF, wgu, 1)
        TJOB(A.w_up + (size_t)l * DM * DFF, DM, DFF, wgu, 2)
        TJOB(A.w_down + (size_t)l * DFF * DM, DFF, DM, wd, 0)
    }
}
__device__ __forceinline__ void convert_p0_weights(const Args& A, LAS float* scr, int gw, int NGW, int lane) {
    constexpr int I_IN = (DM / 64) * (DIN / 64), I_PW = 64, I_POOL = 16, NI = I_IN + DEPTH * (I_PW + I_POOL);
    for (int it = gw; it < NI; it += NGW) { int r = it;
        if (r < I_IN) { transpose_item(A.w_in, DM, DIN, (bf16*)(A.ws + WS_WIN), 0, scr, r, lane); continue; } r -= I_IN;
        const int l = r / (I_PW + I_POOL); r -= l * (I_PW + I_POOL);
        if (r < I_PW) { transpose_item(A.w_pw + (size_t)l * 512 * 512, 512, 512, (bf16*)(A.ws + WS_WSM + 256 * 1024) + (size_t)l * 512 * 512, 0, scr, r, lane); continue; } r -= I_PW;
        { const int g = r >> 2; transpose_item(A.w_pool + (size_t)(l * 4 + g) * 128 * 128, 128, 128, (bf16*)(A.ws + WS_WSM) + (size_t)(l * 4 + g) * 128 * 128, 0, scr, r & 3, lane); }
    }
}
__device__ __forceinline__ void convert_wout(const Args& A, int l, LAS float* scr, int gw, int NGW, int lane) {
    constexpr int NI = (DM / 64) * (DM / 64);
    for (int it = gw; it < NI; it += NGW) transpose_item(A.w_out + (size_t)l * DM * DM, DM, DM, (bf16*)(A.ws + WS_WOUT) + (size_t)l * DM * DM, 0, scr, it, lane);
}
__device__ __forceinline__ void convert_win(const Args& A, int l, LAS float* scr, int gw, int NGW, int lane) {
    constexpr int NI = (DM / 64) * (DIN / 64);
    for (int it = gw; it < NI; it += NGW) transpose_item(A.w_in + (size_t)l * DM * DIN, DM, DIN, (bf16*)(A.ws + WS_WIN) + (size_t)l * DIN * DM, 0, scr, it, lane);
}

__device__ __forceinline__ float dot4(f32x4 a) { return (a.x * a.x + a.y * a.y) + (a.z * a.z + a.w * a.w); }
__device__ __forceinline__ void store_u_row(bf16* urow, const f32x4 (&hv)[8], float r, const float* g, int lane) {
#pragma unroll
    for (int j = 0; j < 8; ++j) { const f32x4 gv = ((const f32x4*)g)[lane + 64 * j]; v2u w; w.x = cvtpk(hv[j].x * r * gv.x, hv[j].y * r * gv.y); w.y = cvtpk(hv[j].z * r * gv.z, hv[j].w * r * gv.w);
        ((v2u*)urow)[lane + 64 * j] = w; }
}
__device__ __forceinline__ void init_rows(const Args& A, int gw, int NGW, int lane) {
    unsigned char* wsb = gptr(A.ws); float* h = (float*)(wsb + WS_H); bf16* u = (bf16*)(wsb + WS_U); const float* pg = gptr(A.pre_mix_g);
    for (int m = gw; m < MV; m += NGW) {
        const float* src = m < MR ? gptr(A.x) + (size_t)m * DM : gptr(A.meta) + (size_t)(m - MR) * DM;
        f32x4 hv[8]; float ss = 0.f;
#pragma unroll
        for (int j = 0; j < 8; ++j) { hv[j] = ((const f32x4*)src)[lane + 64 * j]; ss += dot4(hv[j]); }
        const float r = rsqrtf(wave_sum(ss) * (1.0f / DM) + EPS);
        store_u_row(u + (size_t)m * DM, hv, r, pg, lane);
    }
}
__device__ __forceinline__ void row_phase(const Args& A, const float* g1, const float* g2, float* dout, int nrows, int gw, int NGW, int lane, float bscale = 1.0f, bool h_from_input = false) {
    unsigned char* wsb = gptr(A.ws); float* h = (float*)(wsb + WS_H); bf16* u = (bf16*)(wsb + WS_U); const float* src = (const float*)(wsb + WS_OUT); g1 = gptr(g1); g2 = gptr(g2); dout = gptr(dout);
    const float* xin = gptr(A.x); const float* metain = gptr(A.meta);
    for (int m0 = gw; m0 < nrows; m0 += 2 * NGW) {
        const int m1 = m0 + NGW; const bool two = m1 < nrows; const int mb = two ? m1 : m0;
        const float* hsA = h_from_input ? (m0 < MR ? xin + (size_t)m0 * DM : metain + (size_t)(m0 - MR) * DM) : h + (size_t)m0 * DM;
        const float* hsB = h_from_input ? (mb < MR ? xin + (size_t)mb * DM : metain + (size_t)(mb - MR) * DM) : h + (size_t)mb * DM;
        f32x4 oA[8], hA[8], oB[8], hB[8]; float ssA = 0.f, ssB = 0.f;
#pragma unroll
        for (int j = 0; j < 8; ++j) { oA[j] = ((const f32x4*)(src + (size_t)m0 * DM))[lane + 64 * j]; hA[j] = ((const f32x4*)hsA)[lane + 64 * j]; }
#pragma unroll
        for (int j = 0; j < 8; ++j) { oB[j] = ((const f32x4*)(src + (size_t)mb * DM))[lane + 64 * j]; hB[j] = ((const f32x4*)hsB)[lane + 64 * j]; }
#pragma unroll
        for (int j = 0; j < 8; ++j) { ssA += dot4(oA[j]); ssB += dot4(oB[j]); }
        const float rA = rsqrtf(wave_sum(ssA) * (1.0f / DM) + EPS), rB = rsqrtf(wave_sum(ssB) * (1.0f / DM) + EPS);
        float s2A = 0.f, s2B = 0.f;
#pragma unroll
        for (int j = 0; j < 8; ++j) { const f32x4 gv = ((const f32x4*)g1)[lane + 64 * j]; hA[j] = hA[j] + oA[j] * (rA * bscale) * gv; hB[j] = hB[j] + oB[j] * (rB * bscale) * gv; s2A += dot4(hA[j]); s2B += dot4(hB[j]); }
        if (dout) {
            if (m0 < MR) {
#pragma unroll
                for (int j = 0; j < 8; ++j) ((f32x4*)(dout + (size_t)m0 * DM))[lane + 64 * j] = hA[j];
            }
            if (two && m1 < MR) {
#pragma unroll
                for (int j = 0; j < 8; ++j) ((f32x4*)(dout + (size_t)m1 * DM))[lane + 64 * j] = hB[j];
            }
        } else {
#pragma unroll
            for (int j = 0; j < 8; ++j) ((f32x4*)(h + (size_t)m0 * DM))[lane + 64 * j] = hA[j];
            if (two) {
#pragma unroll
                for (int j = 0; j < 8; ++j) ((f32x4*)(h + (size_t)m1 * DM))[lane + 64 * j] = hB[j];
            }
            const float r2A = rsqrtf(wave_sum(s2A) * (1.0f / DM) + EPS), r2B = rsqrtf(wave_sum(s2B) * (1.0f / DM) + EPS);
            store_u_row(u + (size_t)m0 * DM, hA, r2A, g2, lane);
            if (two) store_u_row(u + (size_t)m1 * DM, hB, r2B, g2, lane);
        }
    }
}

template <int MODE> __device__ __forceinline__ void skinny_gemm(const bf16* __restrict__ Arows, const bf16* __restrict__ Bt, int N, int K, void* O, int ldc, LAS unsigned char* lds, int lane, int wave) {
    const int li = lane & 15, fq = lane >> 4; const int nks = K >> 5;
    LAS f32x4* part = (LAS f32x4*)lds;
    for (int blk = blockIdx.x; blk < (N >> 4); blk += gridDim.x) {
        const bf16* bp = Bt + (size_t)(blk * 16 + li) * K + 8 * fq; const bf16* ap = Arows + (size_t)li * K + 8 * fq;
        f32x4 acc = (f32x4){0.f, 0.f, 0.f, 0.f};
#pragma unroll 8
        for (int ks = wave; ks < nks; ks += 8) { const bf16x8 wf = *(const bf16x8*)(bp + ks * 32); const bf16x8 af = *(const bf16x8*)(ap + ks * 32); acc = mfma16(wf, af, acc); }
        part[wave * 64 + lane] = acc;
        __syncthreads();
        if (wave == 0) {
            f32x4 v = part[lane];
#pragma unroll
            for (int w8 = 1; w8 < 8; ++w8) v = v + part[w8 * 64 + lane];
            const int n0 = blk * 16 + 4 * fq;
            if (MODE == 0) { const float sc = n0 < 1024 ? 0.125f : 1.0f; v2u w; w.x = cvtpk(v.x * sc, v.y * sc); w.y = cvtpk(v.z * sc, v.w * sc); *(v2u*)((bf16*)O + (size_t)(MR + li) * ldc + n0) = w; }
            else if (MODE == 1) { *(f32x4*)((float*)O + (size_t)(MR + li) * ldc + n0) = v; }
            else { f32x4 up; up.x = __shfl_xor(v.x, 16); up.y = __shfl_xor(v.y, 16); up.z = __shfl_xor(v.z, 16); up.w = __shfl_xor(v.w, 16);
                if ((fq & 1) == 0) { v2u w; w.x = cvtpk(v.x * sigmoidf_(v.x) * up.x, v.y * sigmoidf_(v.y) * up.y); w.y = cvtpk(v.z * sigmoidf_(v.z) * up.z, v.w * sigmoidf_(v.w) * up.w);
                    *(v2u*)((bf16*)O + (size_t)(MR + li) * ldc + blk * 8 + 4 * (fq >> 1)) = w; } }
        }
        __syncthreads();
    }
}

constexpr int VPITCH = 128;
constexpr int ML_V = 0, ML_ST = 8 * 64 * VPITCH  , ML_RED = ML_ST + 65536, ML_Y = 0  , ML_AB = ML_Y + 16 * 516 * 4;
static_assert(ML_RED + 3 * 512 <= LDS_BYTES && ML_AB + 16 * 1040 <= ML_ST, "mixer LDS");

__device__ __forceinline__ float softplus_(float z) { const float t = __builtin_amdgcn_exp2f(-LOG2E * __builtin_fabsf(z)); return __builtin_fmaxf(z, 0.f) + LN2 * __builtin_amdgcn_logf(1.0f + t); }
__device__ __forceinline__ void split_pack(const f32x4& a, const f32x4& b, bf16x8& hi, bf16x8& lo) {
    v4u h, l;
    h.x = cvtpk(a[0], a[1]); h.y = cvtpk(a[2], a[3]); h.z = cvtpk(b[0], b[1]); h.w = cvtpk(b[2], b[3]);
    l.x = cvtpk(a[0] - bflo(h.x), a[1] - bfhi(h.x)); l.y = cvtpk(a[2] - bflo(h.y), a[3] - bfhi(h.y));
    l.z = cvtpk(b[0] - bflo(h.z), b[1] - bfhi(h.z)); l.w = cvtpk(b[2] - bflo(h.w), b[3] - bfhi(h.w));
    hi = __builtin_bit_cast(bf16x8, h); lo = __builtin_bit_cast(bf16x8, l);
}
__device__ __forceinline__ void sb_attention(const bf16* __restrict__ proj, int b, int p0, int hd, LAS unsigned char* vl, int lane, f32x4 (&o)[4]) {
    const int li = lane & 15, fq = lane >> 4;
    const int qpos = p0 + li;
    const bf16* qp = proj + (size_t)rowidx(b, qpos) * DIN + hd * 64 + fq * 8;
    const bf16x8 qf0 = *(const bf16x8*)qp, qf1 = *(const bf16x8*)(qp + 32);
    unsigned d0 = 0u, d1 = 0u;
    { const unsigned one = 0x3F80u; d0 = ((4 * fq + 0 >= li) ? one : 0u) | ((4 * fq + 1 >= li) ? (one << 16) : 0u); d1 = ((4 * fq + 2 >= li) ? one : 0u) | ((4 * fq + 3 >= li) ? (one << 16) : 0u); }
    const unsigned ONE2 = 0x3F803F80u;
    const bf16x8 F_D1 = __builtin_bit_cast(bf16x8, (v4u){d0, d1, ONE2, ONE2});
    const bf16x8 F_11 = __builtin_bit_cast(bf16x8, (v4u){ONE2, ONE2, ONE2, ONE2});
    const bf16x8 F_0D = __builtin_bit_cast(bf16x8, (v4u){0u, 0u, d0, d1});
#pragma unroll
    for (int i = 0; i < 4; ++i) o[i] = (f32x4){0.f, 0.f, 0.f, 0.f};
    float carry = 0.f;
    const int ktd = p0 >> 6, kbmax = (p0 & 63) >> 4;
    const unsigned trbase = (unsigned)((4 * fq + (li >> 2)) * VPITCH + (lane & 3) * 8);
    bf16x8 kf[4][2];
#define SB_LOADK(KT) do { _Pragma("unroll") for (int kb = 0; kb < 4; ++kb) { int kp = 64 * (KT) + 16 * kb + li; kp = kp < LSEQ ? kp : LSEQ - 1; const bf16* kr = proj + (size_t)rowidx(b, kp) * DIN + C_K + hd * 64 + fq * 8; \
        kf[kb][0] = *(const bf16x8*)kr; kf[kb][1] = *(const bf16x8*)(kr + 32); } } while (0)
    SB_LOADK(ktd);
    for (int kt = ktd; kt >= 0; --kt) {
        const bool diag = (kt == ktd);
        f32x4 s[4], lnb[4];
#pragma unroll
        for (int kb = 0; kb < 4; ++kb) { s[kb] = mfma16(kf[kb][0], qf0, (f32x4){0.f, 0.f, 0.f, 0.f}); s[kb] = mfma16(kf[kb][1], qf1, s[kb]); }
#pragma unroll
        for (int it = 0; it < 8; ++it) { const int key = it * 8 + (lane >> 3); int kp = 64 * kt + key; kp = kp < LSEQ ? kp : LSEQ - 1;
            __builtin_amdgcn_global_load_lds((const unsigned*)(proj + (size_t)rowidx(b, kp) * DIN + C_V + hd * 64 + (lane & 7) * 8), (LAS unsigned*)(vl + it * 1024), 16, 0, 0); }
        { const int ktn = kt > 0 ? kt - 1 : 0; SB_LOADK(ktn); }
        __builtin_amdgcn_sched_barrier(0);
#pragma unroll
        for (int kb = 0; kb < 4; ++kb)
#pragma unroll
            for (int e = 0; e < 4; ++e) { const bool m = !diag || (64 * kt + 16 * kb + 4 * fq + e < qpos); lnb[kb][e] = (diag && kb > kbmax) ? 0.f : (m ? -softplus_(s[kb][e]) : 0.f); }
        bf16x8 bh[2], bl[2];
        split_pack(lnb[0], lnb[1], bh[0], bl[0]); split_pack(lnb[2], lnb[3], bh[1], bl[1]);
        f32x4 c[4];
#pragma unroll
        for (int i = 0; i < 4; ++i) c[i] = (f32x4){carry, carry, carry, carry};
        c[0] = mfma16(F_D1, bh[0], c[0]); c[0] = mfma16(F_D1, bl[0], c[0]); c[0] = mfma16(F_11, bh[1], c[0]); c[0] = mfma16(F_11, bl[1], c[0]);
        c[1] = mfma16(F_0D, bh[0], c[1]); c[1] = mfma16(F_0D, bl[0], c[1]); c[1] = mfma16(F_11, bh[1], c[1]); c[1] = mfma16(F_11, bl[1], c[1]);
        c[2] = mfma16(F_D1, bh[1], c[2]); c[2] = mfma16(F_D1, bl[1], c[2]);
        c[3] = mfma16(F_0D, bh[1], c[3]); c[3] = mfma16(F_0D, bl[1], c[3]);
        f32x4 w[4];
#pragma unroll
        for (int kb = 0; kb < 4; ++kb)
#pragma unroll
            for (int e = 0; e < 4; ++e) { const bool m = !diag || (64 * kt + 16 * kb + 4 * fq + e < qpos); w[kb][e] = (diag && kb > kbmax) ? 0.f : (m ? __builtin_amdgcn_exp2f(LOG2E * (s[kb][e] + c[kb][e])) : 0.f); }
        carry = __shfl(c[0][0], li);
        v4u p0v, p1v;
        p0v.x = cvtpk(w[0][0], w[0][1]); p0v.y = cvtpk(w[0][2], w[0][3]); p0v.z = cvtpk(w[1][0], w[1][1]); p0v.w = cvtpk(w[1][2], w[1][3]);
        p1v.x = cvtpk(w[2][0], w[2][1]); p1v.y = cvtpk(w[2][2], w[2][3]); p1v.z = cvtpk(w[3][0], w[3][1]); p1v.w = cvtpk(w[3][2], w[3][3]);
        const bf16x8 pf0 = __builtin_bit_cast(bf16x8, p0v), pf1 = __builtin_bit_cast(bf16x8, p1v);
        __builtin_amdgcn_sched_barrier(0);
        asm volatile("s_waitcnt vmcnt(0)" ::: "memory");
#pragma unroll
        for (int db = 0; db < 4; ++db) {
#pragma unroll
            for (int s2 = 0; s2 < 2; ++s2) {
                const v4i16_t lo = __builtin_amdgcn_ds_read_tr16_b64_v4i16((LAS v4i16_t*)(vl + trbase + (32 * s2) * VPITCH + db * 32));
                const v4i16_t hi = __builtin_amdgcn_ds_read_tr16_b64_v4i16((LAS v4i16_t*)(vl + trbase + (32 * s2 + 16) * VPITCH + db * 32));
                const bf16x8 vf = (bf16x8){lo[0], lo[1], lo[2], lo[3], hi[0], hi[1], hi[2], hi[3]};
                o[db] = mfma16(vf, s2 == 0 ? pf0 : pf1, o[db]);
            }
        }
        if (__all(carry < SB_EXIT)) break;
    }
#undef SB_LOADK
}

template <int W> __device__ __forceinline__ void pool_group(const bf16* __restrict__ psrc, const bf16* __restrict__ wpt, int b, int pos, f32x4 (&pacc)[4]) {
    const int cnt = (pos + 1 < W) ? pos + 1 : W; const float inv = 1.0f / (float)cnt;
    constexpr int BW = W;
#pragma unroll 1
    for (int ks = 0; ks < 4; ++ks) {
        bf16x8 wf[4];
#pragma unroll
        for (int nb = 0; nb < 4; ++nb) wf[nb] = *(const bf16x8*)(wpt + (size_t)nb * 16 * 128 + 32 * ks);
        float sum[8], self[8];
#pragma unroll
        for (int e = 0; e < 8; ++e) { sum[e] = 0.f; self[e] = 0.f; }
#pragma unroll
        for (int j0 = 0; j0 < W; j0 += BW) {
            v4u v[BW];
#pragma unroll
            for (int j = 0; j < BW; ++j) { const int pp = pos - j0 - j; v[j] = *(const v4u*)(psrc + (size_t)rowidx(b, pp >= 0 ? pp : 0) * DIN + 32 * ks); }
#pragma unroll
            for (int j = 0; j < BW; ++j) { const float f = (pos - j0 - j) >= 0 ? 1.0f : 0.0f;
                sum[0] += f * bflo(v[j].x); sum[1] += f * bfhi(v[j].x); sum[2] += f * bflo(v[j].y); sum[3] += f * bfhi(v[j].y);
                sum[4] += f * bflo(v[j].z); sum[5] += f * bfhi(v[j].z); sum[6] += f * bflo(v[j].w); sum[7] += f * bfhi(v[j].w); }
            if (j0 == 0) { self[0] = bflo(v[0].x); self[1] = bfhi(v[0].x); self[2] = bflo(v[0].y); self[3] = bfhi(v[0].y); self[4] = bflo(v[0].z); self[5] = bfhi(v[0].z); self[6] = bflo(v[0].w); self[7] = bfhi(v[0].w); }
            if (j0 + BW < W) __builtin_amdgcn_sched_barrier(0);
        }
        v4u pk; pk.x = cvtpk(sum[0] * inv - self[0], sum[1] * inv - self[1]); pk.y = cvtpk(sum[2] * inv - self[2], sum[3] * inv - self[3]);
        pk.z = cvtpk(sum[4] * inv - self[4], sum[5] * inv - self[5]); pk.w = cvtpk(sum[6] * inv - self[6], sum[7] * inv - self[7]);
        const bf16x8 pf = __builtin_bit_cast(bf16x8, pk);
#pragma unroll
        for (int nb = 0; nb < 4; ++nb) pacc[nb] = mfma16(wf[nb], pf, pacc[nb]);
    }
}

__device__ __forceinline__ void mixer_phase(const Args& A, int l, LAS unsigned char* lds, int tid0, int wave) {
    unsigned char* wsb = gptr(A.ws);
    const bf16* proj = (const bf16*)(wsb + WS_PROJ); bf16* merged = (bf16*)(wsb + WS_MERGED);
    const bf16* wpool_t = (const bf16*)(wsb + WS_WSM) + (size_t)l * 4 * 128 * 128;
    const bf16* wpw_t = (const bf16*)(wsb + WS_WSM + 256 * 1024) + (size_t)l * 512 * 512;
    const float* wdw = gptr(A.w_dw) + (size_t)l * 31 * 512; const float* bdw = gptr(A.b_dw) + l * 512; const float* lng = gptr(A.conv_ln_g) + l * 512; const float* lnb_ = gptr(A.conv_ln_b) + l * 512;
    const float* psc = gptr(A.pool_scale) + l * 512; const float* mg = gptr(A.mix_out_g) + (size_t)l * DM;
    LAS float* Y = (LAS float*)(lds + ML_Y); LAS unsigned short* Ab = (LAS unsigned short*)(lds + ML_AB); LAS float* red = (LAS float*)(lds + ML_RED);
    LAS unsigned char* vl = lds + ML_V + wave * (64 * VPITCH); LAS unsigned char* st = lds + ML_ST + wave * 8192;
    const int nunits = (l + 1 < DEPTH) ? 513 : 512;
    const int vcu = (gridDim.x % 8 == 0) ? ((int)blockIdx.x % 8) * ((int)gridDim.x / 8) + (int)blockIdx.x / 8 : (int)blockIdx.x;
    for (int ui = vcu; ui < nunits; ui += gridDim.x) {
        int ti = ui;
        if (gridDim.x == 256 && ui < 512) { const int w = ui & 255, rnd = ui >> 8; ti = 256 * (w >> 7) + (rnd == 0 ? 128 : 0) + (w & 127); }
        int b, p0; if (ti < 512) { b = ti >> 8; p0 = 16 + 16 * (ti & 255); } else { b = 0; p0 = 0; }
        int tid_l = tid0; asm volatile("" : "+v"(tid_l));
        const int tid = tid_l, lane = tid & 63, li = lane & 15, fq = lane >> 4;
#pragma unroll 1
        for (int hh = 0; hh < ((PROBE_DUP & 64) ? 4 : 2); ++hh) { f32x4 o0[4];
            sb_attention(proj, b, p0, 2 * wave + (hh & 1), vl, lane, o0);
#pragma unroll
            for (int db = 0; db < 4; ++db) *(LAS f32x4*)(st + (((hh & 1) * 4 + db) * 64 + lane) * 16) = o0[db]; }
        __syncthreads();
        f32x4 cacc[4];
        for (int crep = 0; crep < ((PROBE_DUP & 128) ? 2 : 1); ++crep) {
            if (crep) __syncthreads();
        {
            const int c = tid;
            unsigned short ra[46], rg[46];
#pragma unroll
            for (int r = 0; r < 46; ++r) { const int pos = p0 - 30 + r; ra[r] = 0; rg[r] = 0;
                if (pos >= 0) { const bf16* rp = proj + (size_t)rowidx(b, pos) * DIN + C_CA; ra[r] = rp[c]; rg[r] = rp[512 + c]; } }
            __builtin_amdgcn_sched_barrier(0);
            float glu[46];
#pragma unroll
            for (int r = 0; r < 46; ++r) glu[r] = bf2f(ra[r]) * sigmoidf_(bf2f(rg[r]));
            const float* wdc = wdw + c; asm volatile("" : "+v"(wdc));
            float y[16]; const float bias = bdw[c];
#pragma unroll
            for (int t = 0; t < 16; ++t) y[t] = bias;
#pragma unroll
            for (int j = 0; j < 31; ++j) { const float w = wdc[j * 512];
#pragma unroll
                for (int t = 0; t < 16; ++t) y[t] += w * glu[t + j]; }
#pragma unroll
            for (int t = 0; t < 16; ++t) Y[t * 516 + c] = y[t];
        }
        float lg[8], lb[8];
#pragma unroll
        for (int i = 0; i < 8; ++i) { lg[i] = lng[lane + 64 * i]; lb[i] = lnb_[lane + 64 * i]; }
        const bf16* wp = wpw_t + (size_t)(64 * wave + li) * 512 + 8 * fq;
        bf16x8 wfa[4][4];
#pragma unroll
        for (int ks = 0; ks < 4; ++ks)
#pragma unroll
            for (int nb = 0; nb < 4; ++nb) wfa[ks][nb] = *(const bf16x8*)(wp + (size_t)nb * 16 * 512 + ks * 32);
        __builtin_amdgcn_sched_barrier(0);
        __syncthreads();
#pragma unroll
        for (int tt = 0; tt < 2; ++tt) { const int t = 2 * wave + tt; float v[8]; float sm = 0.f;
#pragma unroll
            for (int i = 0; i < 8; ++i) { v[i] = Y[t * 516 + lane + 64 * i]; sm += v[i]; }
            const float mean = wave_sum(sm) * (1.0f / 512.0f); float q = 0.f;
#pragma unroll
            for (int i = 0; i < 8; ++i) { v[i] -= mean; q += v[i] * v[i]; }
            const float rstd = rsqrtf(wave_sum(q) * (1.0f / 512.0f) + EPS);
#pragma unroll
            for (int i = 0; i < 8; ++i) { const int c = lane + 64 * i; const float yn = v[i] * rstd * lg[i] + lb[i]; const float a = yn * sigmoidf_(yn); Ab[t * 520 + c] = (unsigned short)(cvtpk(a, 0.f) & 0xffffu); }
        }
        __syncthreads();
#pragma unroll
        for (int i = 0; i < 4; ++i) cacc[i] = (f32x4){0.f, 0.f, 0.f, 0.f};
        { const LAS unsigned char* ab = (const LAS unsigned char*)Ab + li * 1040 + fq * 16;
            bf16x8 wfb[4][4];
#define CV_LOAD(dst, g) do { _Pragma("unroll") for (int ks = 0; ks < 4; ++ks) _Pragma("unroll") for (int nb = 0; nb < 4; ++nb) dst[ks][nb] = *(const bf16x8*)(wp + (size_t)nb * 16 * 512 + ((g) * 4 + ks) * 32); } while (0)
#define CV_MMA(src, g) do { _Pragma("unroll") for (int ks = 0; ks < 4; ++ks) { const bf16x8 bfr = *(const LAS bf16x8*)(ab + ((g) * 4 + ks) * 64); _Pragma("unroll") for (int nb = 0; nb < 4; ++nb) cacc[nb] = mfma16(src[ks][nb], bfr, cacc[nb]); } } while (0)
            CV_LOAD(wfb, 1); __builtin_amdgcn_sched_barrier(0); CV_MMA(wfa, 0); __builtin_amdgcn_sched_barrier(0);
            CV_LOAD(wfa, 2); __builtin_amdgcn_sched_barrier(0); CV_MMA(wfb, 1); __builtin_amdgcn_sched_barrier(0);
            CV_LOAD(wfb, 3); __builtin_amdgcn_sched_barrier(0); CV_MMA(wfa, 2); __builtin_amdgcn_sched_barrier(0);
            CV_MMA(wfb, 3);
#undef CV_LOAD
#undef CV_MMA
        }

        }
        f32x4 pacc[4];
        for (int prep = 0; prep < ((PROBE_DUP & 256) ? 2 : 1); ++prep) {
#pragma unroll
        for (int i = 0; i < 4; ++i) pacc[i] = (f32x4){0.f, 0.f, 0.f, 0.f};
        { const int g = wave >> 1, nh = wave & 1;
            const bf16* wpt = wpool_t + (size_t)(g * 128 + 64 * nh + li) * 128 + 8 * fq; const bf16* psrc = proj + C_POOL + 128 * g + 8 * fq;
            if (g == 0) pool_group<2>(psrc, wpt, b, p0 + li, pacc); else if (g == 1) pool_group<4>(psrc, wpt, b, p0 + li, pacc); else if (g == 2) pool_group<8>(psrc, wpt, b, p0 + li, pacc); else pool_group<16>(psrc, wpt, b, p0 + li, pacc); }
        }
        f32x4 oa[2][4];
#pragma unroll
        for (int hh = 0; hh < 2; ++hh)
#pragma unroll
            for (int db = 0; db < 4; ++db) oa[hh][db] = *(const LAS f32x4*)(st + ((hh * 4 + db) * 64 + lane) * 16);
        float ssa = 0.f, ssp = 0.f, ssc = 0.f;
        { const int g = wave >> 1, nh = wave & 1;
#pragma unroll
            for (int nb = 0; nb < 4; ++nb) { const f32x4 sc = *(const f32x4*)(psc + 128 * g + 64 * nh + 16 * nb + 4 * fq); pacc[nb] = pacc[nb] * sc; ssp += dot4(pacc[nb]); ssc += dot4(cacc[nb]); ssa += dot4(oa[0][nb]) + dot4(oa[1][nb]); } }
        ssa += __shfl_xor(ssa, 16); ssa += __shfl_xor(ssa, 32); ssp += __shfl_xor(ssp, 16); ssp += __shfl_xor(ssp, 32); ssc += __shfl_xor(ssc, 16); ssc += __shfl_xor(ssc, 32);
        if (lane < 16) { red[wave * 16 + lane] = ssa; red[128 + wave * 16 + lane] = ssp; red[256 + wave * 16 + lane] = ssc; }
        __syncthreads();
        float ta = 0.f, tp = 0.f, tc = 0.f;
#pragma unroll
        for (int w8 = 0; w8 < 8; ++w8) { ta += red[w8 * 16 + li]; tp += red[128 + w8 * 16 + li]; tc += red[256 + w8 * 16 + li]; }
        const float ra = rsqrtf(ta * (1.0f / DATT) + EPS), rp = rsqrtf(tp * (1.0f / DPOOL) + EPS), rc = rsqrtf(tc * (1.0f / DCONV) + EPS);
        bf16* orow = merged + (size_t)rowidx(b, p0 + li) * DM;
#pragma unroll
        for (int hh = 0; hh < 2; ++hh)
#pragma unroll
            for (int db = 0; db < 4; ++db) { const int col = (2 * wave + hh) * 64 + 16 * db + 4 * fq; const f32x4 gv = *(const f32x4*)(mg + col); const f32x4 v = oa[hh][db] * ra * gv;
                v2u w2; w2.x = cvtpk(v.x, v.y); w2.y = cvtpk(v.z, v.w); *(v2u*)(orow + col) = w2; }
        { const int g = wave >> 1, nh = wave & 1;
#pragma unroll
            for (int nb = 0; nb < 4; ++nb) { const int col = DATT + 128 * g + 64 * nh + 16 * nb + 4 * fq; const f32x4 gv = *(const f32x4*)(mg + col); const f32x4 v = pacc[nb] * rp * gv;
                v2u w2; w2.x = cvtpk(v.x, v.y); w2.y = cvtpk(v.z, v.w); *(v2u*)(orow + col) = w2; } }
#pragma unroll
        for (int nb = 0; nb < 4; ++nb) { const int col = DATT + DPOOL + 64 * wave + 16 * nb + 4 * fq; const f32x4 gv = *(const f32x4*)(mg + col); const f32x4 v = cacc[nb] * rc * gv;
            v2u w2; w2.x = cvtpk(v.x, v.y); w2.y = cvtpk(v.z, v.w); *(v2u*)(orow + col) = w2; }
        __syncthreads();
    }
}

#define XB_TMO      128
#define XB_XCNT(j)  (256  + 64 * (j))
#define XB_XSUB(j)  (1280 + 64 * (j))
#define XB_XGEN(j)  (2304 + 64 * (j))
#define XB_TOP      3328
#define XB_TOPGEN   3392
#define XCD_BAR_WORDS 3456
#define XB_SPIN_CAP (1u << 18)

__device__ __forceinline__ unsigned xb_ld(unsigned* p)              { return __hip_atomic_load(p, __ATOMIC_RELAXED, __HIP_MEMORY_SCOPE_AGENT); }
__device__ __forceinline__ unsigned xb_add(unsigned* p, unsigned v) { return __hip_atomic_fetch_add(p, v, __ATOMIC_RELAXED, __HIP_MEMORY_SCOPE_AGENT); }
__device__ __forceinline__ unsigned xb_xcc_id() { return (unsigned)__builtin_amdgcn_s_getreg((3 << 11) | 20) & 0xFu; }
#define XB_SPIN(cond, bar) do { unsigned _sp = 0; while (cond) { __builtin_amdgcn_s_sleep(1); \
    if ((++_sp & 255u) == 0u) { if (xb_ld(&(bar)[XB_TMO])) break; if (_sp > XB_SPIN_CAP) { atomicAdd(&(bar)[XB_TMO], 1u); break; } } } } while (0)

struct XcdBarrier {
    unsigned* bar; unsigned x;
    volatile LAS unsigned* st;
};

__device__ __forceinline__ XcdBarrier xcd_barrier_post(unsigned* bar, volatile LAS unsigned* st) {
    XcdBarrier b; b.bar = bar; b.x = xb_xcc_id(); b.st = st;
    if (threadIdx.x == 0) (void)xb_add(&bar[XB_XCNT(b.x)], 1u);
    return b;
}
__device__ __forceinline__ void xcd_barrier_complete(unsigned* bar, unsigned x, unsigned& nloc, unsigned& nx) {
    const unsigned G = gridDim.x * gridDim.y * gridDim.z;
    unsigned sum, cnt, mine, sp = 0u;
    for (;;) {
        sum = 0u; cnt = 0u; mine = 0u;
#pragma unroll
        for (unsigned j = 0; j < 16; ++j) { const unsigned c = xb_ld(&bar[XB_XCNT(j)]); sum += c; cnt += (c > 0u) ? 1u : 0u; mine = (j == x) ? c : mine; }
        if (sum == G) break;
        __builtin_amdgcn_s_sleep(1);
        if ((++sp & 255u) == 0u) { if (xb_ld(&bar[XB_TMO])) break; if (sp > XB_SPIN_CAP) { atomicAdd(&bar[XB_TMO], 1u); break; } }
    }
    nloc = mine > 0u ? mine : 1u; nx = cnt > 0u ? cnt : 1u;
}

__device__ __forceinline__ void xcd_barrier(const XcdBarrier& b) {
    asm volatile("s_waitcnt vmcnt(0)" ::: "memory");
    __syncthreads();
    if (threadIdx.x == 0) {
        unsigned* bar = b.bar;
        __builtin_amdgcn_s_waitcnt(0);
        unsigned nloc = b.st[0], nx = b.st[1];
        if (nloc == 0u) { xcd_barrier_complete(bar, b.x, nloc, nx); b.st[0] = nloc; b.st[1] = nx; }
        const unsigned old = xb_add(&bar[XB_XSUB(b.x)], 1u);
        const unsigned gen = old / nloc;
        if (old + 1u == (gen + 1u) * nloc) {
            __builtin_amdgcn_fence(__ATOMIC_RELEASE, "agent");
            asm volatile("s_waitcnt vmcnt(0)" ::: "memory");
            const unsigned og = xb_add(&bar[XB_TOP], 1u);
            const unsigned tg = og / nx;
            if (og + 1u == (tg + 1u) * nx) xb_add(&bar[XB_TOPGEN], 1u);
            else XB_SPIN(xb_ld(&bar[XB_TOPGEN]) == tg, bar);
            __builtin_amdgcn_fence(__ATOMIC_ACQUIRE, "agent");
            xb_add(&bar[XB_XGEN(b.x)], 1u);
            asm volatile("s_waitcnt vmcnt(0)" ::: "memory");
        } else {
            XB_SPIN(xb_ld(&bar[XB_XGEN(b.x)]) == gen, bar);
            __builtin_amdgcn_fence(__ATOMIC_ACQUIRE, "agent");
            asm volatile("s_waitcnt vmcnt(0)" ::: "memory");
        }
    }
    __syncthreads();
}

constexpr int NPHASE = 1 + 7 * DEPTH;
#define PHASE_ENTER() int tid_ = threadIdx.x; asm volatile("" : "+v"(tid_)); const int tid = tid_, lane = tid & 63, wave = __builtin_amdgcn_readfirstlane(tid >> 6); \
    const __attribute__((address_space(4))) Args* ka_ = (const __attribute__((address_space(4))) Args*)__builtin_amdgcn_kernarg_segment_ptr(); asm volatile("" : "+s"(ka_)); Args A; __builtin_memcpy(&A, ka_, sizeof(Args)); \
    const int G = gridDim.x, gw = blockIdx.x * 8 + wave, NGW = G * 8; LAS float* scr = (LAS float*)(lds + wave * 16640); (void)tid; (void)lane; (void)gw; (void)NGW; (void)scr; (void)G;
__global__ void __launch_bounds__(512, 2) fwd_megakernel(Args args) {
    extern __shared__ __attribute__((aligned(16))) unsigned char lds_raw[];
    LAS unsigned char* lds = (LAS unsigned char*)lds_raw;
    cg::grid_group grid = cg::this_grid();
    const int lo = args.ph_lo, hi = args.ph_hi;
    volatile LAS unsigned* bst = (volatile LAS unsigned*)(lds + LDS_BYTES - 64);
    if (threadIdx.x < 16) bst[threadIdx.x] = 0u;
    __syncthreads();
    XcdBarrier bar = xcd_barrier_post((unsigned*)(args.ws + WS_CTL), bst);
#if !MK_SPLIT
    grid.sync();
#endif
#define IN(k) (lo <= (k) && (k) < hi)
#define SEAM(k) do { if (IN(k) && IN((k) + 1)) xcd_barrier(bar); } while (0)
    int k = 0;
    for (int rep = 0; rep < ((PROBE_DUP & 1) ? 2 : 1); ++rep) if (IN(k)) { if (rep) xcd_barrier(bar); PHASE_ENTER(); convert_p0_weights(A, scr, gw, NGW, lane); init_rows(A, gw, NGW, lane); }
    SEAM(k); ++k;
    for (int l = 0; l < DEPTH; ++l) {
        for (int rep = 0; rep < ((PROBE_DUP & 4) ? 2 : 1); ++rep) if (IN(k)) { if (rep) xcd_barrier(bar); PHASE_ENTER(); unsigned char* wsb = gptr(A.ws);
            pg8::Gemm g{(const bf16*)(wsb + WS_U), (const bf16*)(wsb + WS_WIN) + (size_t)l * DIN * DM, MR, DIN, DM}; pg8::StaticOrder S; S.init(MR, DIN, G, (int)blockIdx.x);
            pg8::EpiBf16<0> E{(bf16*)(wsb + WS_PROJ), DIN, nullptr, 1024, 1024, 0.125f};
            pg8::gemm_phase<pg8::EpiBf16<0>, pg8::StaticOrder, PG8_ALIGN, PG8_SP2>(lds, g, S, E);
            __syncthreads();
            { const int ex = ((MR / 256) * (DIN / 256)) % G, c = (int)blockIdx.x;
                if (ex == 0 || c >= ex) { const int c0 = ex == 0 ? 0 : ex, gw2 = (c - c0) * 8 + wave, n2 = (G - c0) * 8; convert_ffn_weights(A, l, scr, gw2, n2, lane); if (l == 0) convert_wout(A, 0, scr, gw2, n2, lane); } }
            __syncthreads(); skinny_gemm<0>((const bf16*)(wsb + WS_U) + (size_t)MR * DM, (const bf16*)(wsb + WS_WIN) + (size_t)l * DIN * DM, DIN, DM, (void*)(wsb + WS_PROJ), DIN, lds, lane, wave);
        }
        SEAM(k); ++k;
        for (int rep = 0; rep < ((PROBE_DUP & 2) ? 2 : 1); ++rep) if (IN(k)) { if (rep) xcd_barrier(bar); PHASE_ENTER(); mixer_phase(A, l, lds, tid, wave); }
        SEAM(k); ++k;
        for (int rep = 0; rep < ((PROBE_DUP & 16) ? 2 : 1); ++rep) if (IN(k)) { if (rep) xcd_barrier(bar); PHASE_ENTER(); unsigned char* wsb = gptr(A.ws);
            pg8::Gemm g{(const bf16*)(wsb + WS_MERGED), (const bf16*)(wsb + WS_WOUT) + (size_t)l * DM * DM, MR, DM, DM}; pg8::StaticOrder S; S.init(MR, DM, G, (int)blockIdx.x);
            pg8::EpiF32 E{(float*)(wsb + WS_OUT), DM};
            pg8::gemm_phase<pg8::EpiF32, pg8::StaticOrder, PG8_ALIGN, PG8_SP2>(lds, g, S, E);
            __syncthreads(); if (l + 1 < DEPTH) skinny_gemm<1>((const bf16*)(wsb + WS_MERGED) + (size_t)MR * DM, (const bf16*)(wsb + WS_WOUT) + (size_t)l * DM * DM, DM, DM, (void*)(wsb + WS_OUT), DM, lds, lane, wave);
        }
        SEAM(k); ++k;
        for (int rep = 0; rep < ((PROBE_DUP & 512) ? 2 : 1); ++rep) if (IN(k)) { PHASE_ENTER(); row_phase(A, A.post_mix_g + (size_t)l * DM, A.pre_ffn_g + (size_t)l * DM, nullptr, (l + 1 < DEPTH) ? MV : MR, gw, NGW, lane, rep ? 0.0f : 1.0f, l == 0 && rep == 0); }
        SEAM(k); ++k;
        for (int rep = 0; rep < ((PROBE_DUP & 32) ? 2 : 1); ++rep) if (IN(k)) { if (rep) xcd_barrier(bar); PHASE_ENTER(); unsigned char* wsb = gptr(A.ws);
            pg8::Gemm g{(const bf16*)(wsb + WS_U), (const bf16*)(wsb + WS_WGU), MR, 2 * DFF, DM}; pg8::StaticOrder S; S.init(MR, 2 * DFF, G, (int)blockIdx.x);
            pg8::EpiSwiGLU E{(bf16*)(wsb + WS_ACT), DFF};
            pg8::gemm_phase<pg8::EpiSwiGLU, pg8::StaticOrder, PG8_ALIGN, PG8_SP2>(lds, g, S, E);
            __syncthreads();
            if (l + 1 < DEPTH) { const int ex = ((MR / 256) * (2 * DFF / 256)) % G, c = (int)blockIdx.x;
                if (ex == 0 || c >= ex) { const int c0 = ex == 0 ? 0 : ex, gw2 = (c - c0) * 8 + wave, n2 = (G - c0) * 8; convert_win(A, l + 1, scr, gw2, n2, lane); convert_wout(A, l + 1, scr, gw2, n2, lane); } }
            __syncthreads(); if (l + 1 < DEPTH) skinny_gemm<2>((const bf16*)(wsb + WS_U) + (size_t)MR * DM, (const bf16*)(wsb + WS_WGU), 2 * DFF, DM, (void*)(wsb + WS_ACT), DFF, lds, lane, wave);
        }
        SEAM(k); ++k;
        for (int rep = 0; rep < ((PROBE_DUP & 8) ? 2 : 1); ++rep) if (IN(k)) { if (rep) xcd_barrier(bar); PHASE_ENTER(); unsigned char* wsb = gptr(A.ws);
            pg8::Gemm g{(const bf16*)(wsb + WS_ACT), (const bf16*)(wsb + WS_WD), MR, DM, DFF}; pg8::StaticOrder S; S.init(MR, DM, G, (int)blockIdx.x);
            pg8::EpiF32 E{(float*)(wsb + WS_OUT), DM};
            pg8::gemm_phase<pg8::EpiF32, pg8::StaticOrder, PG8_ALIGN, PG8_SP2>(lds, g, S, E);
            __syncthreads(); if (l + 1 < DEPTH) skinny_gemm<1>((const bf16*)(wsb + WS_ACT) + (size_t)MR * DFF, (const bf16*)(wsb + WS_WD), DM, DFF, (void*)(wsb + WS_OUT), DM, lds, lane, wave);
        }
        SEAM(k); ++k;
        if (IN(k)) { PHASE_ENTER();
            if (l + 1 < DEPTH) { row_phase(A, A.post_ffn_g + (size_t)l * DM, A.pre_mix_g + (size_t)(l + 1) * DM, nullptr, MV, gw, NGW, lane); }
            else row_phase(A, A.post_ffn_g + (size_t)l * DM, nullptr, A.out, MR, gw, NGW, lane);
        }
        if (l + 1 < DEPTH) { SEAM(k); } ++k;
    }
#undef IN
#undef SEAM
}

extern "C" void kernel_launch(void* const* d_in, const int* in_sizes, int n_in, void* d_out, int out_size, void* d_ws, size_t ws_size, hipStream_t stream) {
    static int grid = 0;
    if (grid == 0) {
        if (n_in != 19 || in_sizes[0] != MR * DM || out_size != MR * DM || ws_size < WS_END) { fprintf(stderr, "kernel_launch: unexpected problem (n_in %d, in0 %d, out %d, ws %zu, need %zu)\n", n_in, n_in > 0 ? in_sizes[0] : -1, out_size, ws_size, (size_t)WS_END); grid = -1; return; }
        int dev = 0, cus = 0, per_cu = 0;
        if (hipGetDevice(&dev) != hipSuccess || hipDeviceGetAttribute(&cus, hipDeviceAttributeMultiprocessorCount, dev) != hipSuccess) { grid = -1; return; }
        if (hipFuncSetAttribute((const void*)fwd_megakernel, hipFuncAttributeMaxDynamicSharedMemorySize, LDS_BYTES) != hipSuccess) { fprintf(stderr, "kernel_launch: hipFuncSetAttribute failed\n"); grid = -1; return; }
        if (hipOccupancyMaxActiveBlocksPerMultiprocessor(&per_cu, (const void*)fwd_megakernel, 512, LDS_BYTES) != hipSuccess || per_cu < 1) { fprintf(stderr, "kernel_launch: occupancy query says %d blocks per CU\n", per_cu); per_cu = 1; }
        (void)hipGetLastError();
        grid = cus;
    }
    if (grid < 0) return;
    if (hipMemsetAsync((unsigned char*)d_ws + WS_CTL, 0, CTL_BYTES, stream) != hipSuccess) { fprintf(stderr, "kernel_launch: hipMemsetAsync failed\n"); return; }
    Args a{};
    const float** ap = (const float**)&a;
    for (int i = 0; i < 19; ++i) ap[i] = (const float*)d_in[i];
    a.out = (float*)d_out; a.ws = (unsigned char*)d_ws;
#if MK_SPLIT
    for (int ph = 0; ph < NPHASE; ++ph) { a.ph_lo = ph; a.ph_hi = ph + 1; hipLaunchKernelGGL(fwd_megakernel, dim3(grid), dim3(512), LDS_BYTES, stream, a); }
#else
    a.ph_lo = 0; a.ph_hi = NPHASE;
    void* kargs[] = {(void*)&a};
    const hipError_t e = hipLaunchCooperativeKernel((const void*)fwd_megakernel, dim3(grid), dim3(512), kargs, LDS_BYTES, stream);
    if (e != hipSuccess) fprintf(stderr, "kernel_launch: cooperative launch failed: %s (grid %d)\n", hipGetErrorString(e), grid);
#endif
}
```
